# Optimizing an MI355X kernel written in HIP

```python
import jax
import jax.numpy as jnp
from jax import lax
import numpy as np


D_MODEL = 1024
BATCH = 8
SEQ = 4096
DEPTH = 4

GRID_W = 64
CTX_LEN = 256
N_MIXERS = 4
EPS = 1e-6
POOL_WINDOWS = (2, 4, 8, 16)
POOL_GROUPS = 4
POOL_GW = D_MODEL // POOL_GROUPS
LRU_WIDTH = D_MODEL
LRU_BLOCKS = 8
LRU_BW = LRU_WIDTH // LRU_BLOCKS
CONV_W = 4
LRU_C = 8.0
HEAD_DIM = 64
N_Q_HEADS = D_MODEL // HEAD_DIM
N_KV_HEADS = 4
Q_BLOCK = 128
ROPE_THETA = 10000.0
GMLP_HALF = 3 * D_MODEL
GMLP_GROUPS = 4
GMLP_GW = GMLP_HALF // GMLP_GROUPS
GMLP_CHUNK = 128
N_EXPERTS = 16
EXPERT_FF = D_MODEL
CAPACITY_FACTOR = 2

kernel_name = 'hybrid_interleaved_diffusion_block'


def _n_slots(m):
    return (DEPTH - m + N_MIXERS - 1) // N_MIXERS


def rms_norm(x, gain=None):
    xf = x.astype(jnp.float32)
    y = xf * lax.rsqrt(jnp.mean(xf * xf, axis=-1, keepdims=True) + EPS)
    if gain is not None:
        y = y * gain.astype(jnp.float32)
    return y.astype(x.dtype)


def layer_norm(x, g, b):
    xf = x.astype(jnp.float32)
    mu = jnp.mean(xf, axis=-1, keepdims=True)
    xc = xf - mu
    var = jnp.mean(xc * xc, axis=-1, keepdims=True)
    return (xc * lax.rsqrt(var + EPS) * g.astype(jnp.float32) + b.astype(jnp.float32)).astype(x.dtype)


def modulate(x, shift, scale):
    return rms_norm(x) * (1 + scale) + shift


def centred_window_mean(h, w):
    n = h.shape[1]
    cs = jnp.pad(jnp.cumsum(h.astype(jnp.float32), axis=1), ((0, 0), (1, 0), (0, 0)))
    t = jnp.arange(n)
    lo = jnp.clip(t - w // 2, 0, n)
    hi = jnp.clip(t + w - w // 2, 0, n)
    mean = (cs[:, hi] - cs[:, lo]) / (hi - lo).astype(jnp.float32)[None, :, None]
    return mean.astype(h.dtype)


def pool_mixer(h, w_pool, scale):
    b, n, d = h.shape
    hg = h.reshape(b, n, POOL_GROUPS, POOL_GW)
    pooled = jnp.stack([centred_window_mean(hg[:, :, g], w) for g, w in enumerate(POOL_WINDOWS)], axis=2) - hg
    y = jnp.einsum('bngc,gcd->bngd', pooled, w_pool).reshape(b, n, d)
    return y * scale


def centred_depthwise_conv(x, w, bias):
    n = x.shape[1]
    left = CONV_W // 2
    right = CONV_W - 1 - left
    xp = jnp.pad(x, ((0, 0), (left, right), (0, 0)))
    return sum(xp[:, k:k + n] * w[k] for k in range(CONV_W)) + bias


def _lin_combine(left, right):
    a1, b1 = left
    a2, b2 = right
    return a1 * a2, a2 * b1 + b2


def linear_scan(a, u, h0):
    a_cum, h = lax.associative_scan(_lin_combine, (a, u), axis=1)
    return h + a_cum * h0[:, None, :]


def rglru_gates(x, wa, ba, wx, bx, lam):
    b, n, w = x.shape
    xb = x.reshape(b, n, LRU_BLOCKS, LRU_BW)
    r = jax.nn.sigmoid((jnp.einsum('bnhi,hij->bnhj', xb, wa).reshape(b, n, w) + ba).astype(jnp.float32))
    i = jax.nn.sigmoid((jnp.einsum('bnhi,hij->bnhj', xb, wx).reshape(b, n, w) + bx).astype(jnp.float32))
    log_a = -LRU_C * r * jax.nn.softplus(-lam.astype(jnp.float32))
    a = jnp.exp(log_a)
    mult = jnp.sqrt(-jnp.expm1(2.0 * log_a))
    u = x.astype(jnp.float32) * i * mult
    return a, u


def rglru_mixer(h_lat, h_ctx, w_in, conv_w, conv_b, wa, ba, wx, bx, lam, w_out):
    def branches(h):
        z = h @ w_in
        y = jax.nn.gelu(z[..., :LRU_WIDTH])
        xr = centred_depthwise_conv(z[..., LRU_WIDTH:], conv_w, conv_b)
        return y, xr
    y_l, x_l = branches(h_lat)
    y_c, x_c = branches(h_ctx)
    zero = jnp.zeros((h_lat.shape[0], LRU_WIDTH), jnp.float32)
    out_l = 0.0
    out_c = 0.0
    for d in range(2):
        a_c, u_c = rglru_gates(x_c, wa[d], ba[d], wx[d], bx[d], lam[d])
        a_l, u_l = rglru_gates(x_l, wa[d], ba[d], wx[d], bx[d], lam[d])
        if d == 1:
            a_c, u_c, a_l, u_l = (jnp.flip(t, axis=1) for t in (a_c, u_c, a_l, u_l))
        hc = linear_scan(a_c, u_c, zero)
        hl = linear_scan(a_l, u_l, hc[:, -1])
        if d == 1:
            hc, hl = jnp.flip(hc, axis=1), jnp.flip(hl, axis=1)
        out_c = out_c + hc
        out_l = out_l + hl
    o_l = (out_l.astype(h_lat.dtype) * y_l) @ w_out
    o_c = (out_c.astype(h_ctx.dtype) * y_c) @ w_out
    return o_l, o_c


def rope_2d_tables(n):
    rows = n // GRID_W
    row = jnp.repeat(jnp.arange(rows), GRID_W).astype(jnp.float32)
    col = jnp.tile(jnp.arange(GRID_W), rows).astype(jnp.float32)
    n_freq = HEAD_DIM // 4
    inv = ROPE_THETA ** (-jnp.arange(n_freq, dtype=jnp.float32) / n_freq)
    ang = jnp.concatenate([row[:, None] * inv, col[:, None] * inv], axis=-1)
    return jnp.cos(ang), jnp.sin(ang)


def apply_rope(x, cos, sin):
    b, n, h, d = x.shape
    xp = x.astype(jnp.float32).reshape(b, n, h, d // 2, 2)
    x1, x2 = xp[..., 0], xp[..., 1]
    cs = cos[None, :, None, :]
    sn = sin[None, :, None, :]
    out = jnp.stack([x1 * cs - x2 * sn, x1 * sn + x2 * cs], axis=-1)
    return out.reshape(b, n, h, d).astype(x.dtype)


def attend(q, k, v):
    s = jnp.einsum('bqkgd,bskd->bkgqs', q, k, preferred_element_type=jnp.float32) * (HEAD_DIM ** -0.5)
    p = jax.nn.softmax(s, axis=-1).astype(v.dtype)
    return jnp.einsum('bkgqs,bskd->bqkgd', p, v)


def gqa_mixer(h_lat, h_ctx, w_qkv, q_gain, k_gain, w_o):
    b, n, _ = h_lat.shape
    n_ctx = h_ctx.shape[1]
    grp = N_Q_HEADS // N_KV_HEADS
    qd = N_Q_HEADS * HEAD_DIM
    kd = N_KV_HEADS * HEAD_DIM

    def project(h):
        t = h.shape[1]
        qkv = h @ w_qkv
        q = qkv[..., :qd].reshape(b, t, N_Q_HEADS, HEAD_DIM)
        k = qkv[..., qd:qd + kd].reshape(b, t, N_KV_HEADS, HEAD_DIM)
        v = qkv[..., qd + kd:].reshape(b, t, N_KV_HEADS, HEAD_DIM)
        return rms_norm(q, q_gain), rms_norm(k, k_gain), v

    q_l, k_l, v_l = project(h_lat)
    q_c, k_c, v_c = project(h_ctx)
    cos, sin = rope_2d_tables(n)
    q_l = apply_rope(q_l, cos, sin)
    k_l = apply_rope(k_l, cos, sin)
    k_all = jnp.concatenate([k_c, k_l], axis=1)
    v_all = jnp.concatenate([v_c, v_l], axis=1)
    q_blocks = q_l.reshape(b, n // Q_BLOCK, Q_BLOCK, N_KV_HEADS, grp, HEAD_DIM).transpose(1, 0, 2, 3, 4, 5)
    o_l = lax.map(lambda qb: attend(qb, k_all, v_all), q_blocks)
    o_l = o_l.transpose(1, 0, 2, 3, 4, 5).reshape(b, n, qd)
    o_c = attend(q_c.reshape(b, n_ctx, N_KV_HEADS, grp, HEAD_DIM), k_c, v_c).reshape(b, n_ctx, qd)
    return o_l @ w_o, o_c @ w_o


def gmlp_mixer(h, w_in, ln_g, ln_b, w_s, b_s, w_out):
    b, n, _ = h.shape
    z = jax.nn.gelu(h @ w_in)
    u, v = z[..., :GMLP_HALF], z[..., GMLP_HALF:]
    v = layer_norm(v, ln_g, ln_b).reshape(b, n // GMLP_CHUNK, GMLP_CHUNK, GMLP_GROUPS, GMLP_GW)
    v = jnp.einsum('gpq,bcqgf->bcpgf', w_s, v) + b_s.T[None, None, :, :, None]
    return (u * v.reshape(b, n, GMLP_HALF)) @ w_out


def expert_choice_ffn(h, w_router, w_gate, w_up, w_down):
    b, n, d = h.shape
    cap = CAPACITY_FACTOR * n // N_EXPERTS
    aff = jax.nn.softmax((h @ w_router).astype(jnp.float32), axis=-1)
    gates, idx = lax.top_k(jnp.swapaxes(aff, 1, 2), cap)
    xs = jax.vmap(lambda hb, ib: hb[ib])(h, idx)
    a = jnp.einsum('becd,edf->becf', xs, w_gate)
    up = jnp.einsum('becd,edf->becf', xs, w_up)
    y = jnp.einsum('becf,efd->becd', jax.nn.silu(a) * up, w_down) * gates.astype(h.dtype)[..., None]
    return jax.vmap(lambda ib, yb: jnp.zeros((n, d), yb.dtype).at[ib.reshape(-1)].add(yb.reshape(-1, d)))(idx, y)


def setup_inputs(seed: int = 0) -> dict:
    key = jax.random.key(seed)
    ks = iter(jax.random.split(key, 40))
    f32 = jnp.float32
    D = D_MODEL

    def nrm(shape, scale):
        return jax.random.normal(next(ks), shape, f32) * scale

    L0, L1, L2, L3 = (_n_slots(m) for m in range(N_MIXERS))
    u = jax.random.uniform(next(ks), (L1, 2, LRU_WIDTH), f32, 0.9, 0.999)
    a0 = u ** (1.0 / LRU_C)
    lru_lam = jnp.log(a0) - jnp.log1p(-a0)
    qkv_out = (N_Q_HEADS + 2 * N_KV_HEADS) * HEAD_DIM
    return {
        'x': nrm((BATCH, SEQ, D), 1.0),
        'c': nrm((BATCH, D), 1.0),
        'ctx': nrm((BATCH, CTX_LEN, D), 1.0),
        'c_ctx': nrm((D,), 1.0),
        'mod_w': nrm((DEPTH, D, 6 * D), 0.5 * D ** -0.5),
        'mod_b': nrm((DEPTH, 6 * D), 0.02),
        'pool_w': nrm((L0, POOL_GROUPS, POOL_GW, POOL_GW), POOL_GW ** -0.5),
        'pool_scale': 1.0 + nrm((L0, D), 0.02),
        'lru_w_in': nrm((L1, D, 2 * LRU_WIDTH), D ** -0.5),
        'lru_conv_w': nrm((L1, CONV_W, LRU_WIDTH), CONV_W ** -0.5),
        'lru_conv_b': nrm((L1, LRU_WIDTH), 0.02),
        'lru_wa': nrm((L1, 2, LRU_BLOCKS, LRU_BW, LRU_BW), LRU_BW ** -0.5),
        'lru_ba': nrm((L1, 2, LRU_WIDTH), 0.02),
        'lru_wx': nrm((L1, 2, LRU_BLOCKS, LRU_BW, LRU_BW), LRU_BW ** -0.5),
        'lru_bx': nrm((L1, 2, LRU_WIDTH), 0.02),
        'lru_lam': lru_lam,
        'lru_w_out': nrm((L1, LRU_WIDTH, D), LRU_WIDTH ** -0.5),
        'attn_w_qkv': nrm((L2, D, qkv_out), D ** -0.5),
        'attn_q_gain': 1.0 + nrm((L2, HEAD_DIM), 0.02),
        'attn_k_gain': 1.0 + nrm((L2, HEAD_DIM), 0.02),
        'attn_w_o': nrm((L2, N_Q_HEADS * HEAD_DIM, D), (N_Q_HEADS * HEAD_DIM) ** -0.5),
        'gmlp_w_in': nrm((L3, D, 2 * GMLP_HALF), D ** -0.5),
        'gmlp_ln_g': 1.0 + nrm((L3, GMLP_HALF), 0.02),
        'gmlp_ln_b': nrm((L3, GMLP_HALF), 0.02),
        'gmlp_w_s': nrm((L3, GMLP_GROUPS, GMLP_CHUNK, GMLP_CHUNK), GMLP_CHUNK ** -0.5),
        'gmlp_b_s': 1.0 + nrm((L3, GMLP_GROUPS, GMLP_CHUNK), 0.02),
        'gmlp_w_out': nrm((L3, GMLP_HALF, D), GMLP_HALF ** -0.5),
        'moe_router': nrm((DEPTH, D, N_EXPERTS), D ** -0.5),
        'moe_w_gate': nrm((DEPTH, N_EXPERTS, D, EXPERT_FF), D ** -0.5),
        'moe_w_up': nrm((DEPTH, N_EXPERTS, D, EXPERT_FF), D ** -0.5),
        'moe_w_down': nrm((DEPTH, N_EXPERTS, EXPERT_FF, D), EXPERT_FF ** -0.5),
        'final_gain': 1.0 + nrm((D,), 0.02),
    }


def reference(x, c, ctx, c_ctx, mod_w, mod_b, pool_w, pool_scale, lru_w_in, lru_conv_w, lru_conv_b,
              lru_wa, lru_ba, lru_wx, lru_bx, lru_lam, lru_w_out, attn_w_qkv, attn_q_gain, attn_k_gain,
              attn_w_o, gmlp_w_in, gmlp_ln_g, gmlp_ln_b, gmlp_w_s, gmlp_b_s, gmlp_w_out,
              moe_router, moe_w_gate, moe_w_up, moe_w_down, final_gain):
    xc = ctx
    silu_c = jax.nn.silu(c)
    silu_cc = jax.nn.silu(c_ctx)
    for i in range(DEPTH):
        m, j = i % N_MIXERS, i // N_MIXERS
        last = i == DEPTH - 1
        mod_l = (silu_c @ mod_w[i] + mod_b[i])[:, None, :]
        mod_c = (silu_cc @ mod_w[i] + mod_b[i])[None, None, :]
        sh1_l, sc1_l, g1_l, sh2_l, sc2_l, g2_l = jnp.split(mod_l, 6, axis=-1)
        sh1_c, sc1_c, g1_c, sh2_c, sc2_c, g2_c = jnp.split(mod_c, 6, axis=-1)
        h_l = modulate(x, sh1_l, sc1_l)
        need_ctx = (not last) or m in (1, 2)
        h_c = modulate(xc, sh1_c, sc1_c) if need_ctx else None
        o_c = None
        if m == 0:
            o_l = pool_mixer(h_l, pool_w[j], pool_scale[j])
            if not last:
                o_c = pool_mixer(h_c, pool_w[j], pool_scale[j])
        elif m == 1:
            o_l, o_c = rglru_mixer(h_l, h_c, lru_w_in[j], lru_conv_w[j], lru_conv_b[j], lru_wa[j], lru_ba[j],
                                   lru_wx[j], lru_bx[j], lru_lam[j], lru_w_out[j])
        elif m == 2:
            o_l, o_c = gqa_mixer(h_l, h_c, attn_w_qkv[j], attn_q_gain[j], attn_k_gain[j], attn_w_o[j])
        else:
            o_l = gmlp_mixer(h_l, gmlp_w_in[j], gmlp_ln_g[j], gmlp_ln_b[j], gmlp_w_s[j], gmlp_b_s[j], gmlp_w_out[j])
            if not last:
                o_c = gmlp_mixer(h_c, gmlp_w_in[j], gmlp_ln_g[j], gmlp_ln_b[j], gmlp_w_s[j], gmlp_b_s[j], gmlp_w_out[j])
        x = x + g1_l * o_l
        x = x + g2_l * expert_choice_ffn(modulate(x, sh2_l, sc2_l), moe_router[i], moe_w_gate[i], moe_w_up[i], moe_w_down[i])
        if not last:
            xc = xc + g1_c * o_c
            xc = xc + g2_c * expert_choice_ffn(modulate(xc, sh2_c, sc2_c), moe_router[i], moe_w_gate[i], moe_w_up[i], moe_w_down[i])
    return rms_norm(x, final_gain)
```

```cpp
#include <hip/hip_runtime.h>
#include <hip/hip_bf16.h>
#include <cstdio>
#include <cstdint>
#include <cmath>

#ifndef MK_PER_PHASE
#define MK_PER_PHASE 1
#endif

#define GAS __attribute__((address_space(1)))
#define LAS __attribute__((address_space(3)))
typedef unsigned short bf16;
typedef unsigned v4u __attribute__((ext_vector_type(4)));
typedef unsigned v2u __attribute__((ext_vector_type(2)));
typedef float f32x4 __attribute__((ext_vector_type(4)));
typedef float f32x2 __attribute__((ext_vector_type(2)));
typedef short bf16x8 __attribute__((ext_vector_type(8)));
typedef GAS unsigned gu32;
#define RLX_AGENT __ATOMIC_RELAXED, __HIP_MEMORY_SCOPE_AGENT
#define LDS_WAIT() asm volatile("s_waitcnt lgkmcnt(0)" ::: "memory")
#define VM_WAIT() asm volatile("s_waitcnt vmcnt(0)" ::: "memory")

constexpr int D = 1024, NB = 8, SEQ = 4096, CTX = 256;
constexpr int RL = NB * SEQ, RC = NB * CTX, RT = RL + RC;
constexpr int KVLEN = CTX + SEQ;
constexpr int NYL = 65536, NYC = 4096, NY = NYL + NYC;
constexpr float EPS = 1e-6f;
constexpr int NWAVES = 8;

constexpr size_t MiB = 1u << 20;
constexpr size_t WS_CTL = 0, CTL_ZERO_BYTES = 1 * MiB;
constexpr size_t WS_MOD = 1 * MiB;
constexpr size_t WS_ROPE = WS_MOD + 900 * 1024;
constexpr size_t WS_PW = 2 * MiB;
constexpr size_t WS_LIN = WS_PW + 512 * 1024;
constexpr size_t WS_LG = WS_LIN + 4 * MiB;
constexpr size_t WS_LOUT = WS_LG + 1 * MiB;
constexpr size_t WS_QKV = WS_LOUT + 2 * MiB;
constexpr size_t WS_WO = WS_QKV + 3 * MiB;
constexpr size_t WS_GIN = WS_WO + 2 * MiB;
constexpr size_t WS_GS = WS_GIN + 12 * MiB;
constexpr size_t WS_GOUT = WS_GS + 128 * 1024;
constexpr size_t WS_WGU = 34 * MiB;
constexpr size_t WS_WD = WS_WGU + 64 * MiB;
constexpr size_t WS_XS = 130 * MiB;
constexpr size_t WS_H = 266 * MiB;
constexpr size_t WS_AFF = 334 * MiB;
constexpr size_t WS_INV = WS_AFF + (size_t)RT * 16 * 4;
constexpr size_t WS_IDX = WS_INV + (size_t)RT * 16 * 4;
constexpr size_t WS_GATE = WS_IDX + (size_t)NY * 4;
constexpr size_t WS_AGG = 340 * MiB;
constexpr size_t WS_CARRY = WS_AGG + (size_t)2 * 544 * 1024 * 8;
constexpr size_t WS_SCR = 354 * MiB;
static_assert(WS_GOUT + 6 * MiB <= WS_WGU && WS_GATE + (size_t)NY * 4 <= WS_AGG && WS_CARRY + (size_t)2 * 544 * 1024 * 4 <= WS_SCR, "ws map");
constexpr size_t SC_ACT = WS_SCR, SC_Y = WS_SCR + 136 * MiB;
constexpr size_t SC_P = WS_SCR;
constexpr size_t SC_YG = WS_SCR, SC_ZX = WS_SCR + 68 * MiB, SC_XR = WS_SCR + 136 * MiB;
constexpr size_t SC_HL0 = WS_SCR + 204 * MiB, SC_HL1 = WS_SCR + 272 * MiB, SC_AC0 = WS_SCR + 340 * MiB, SC_AC1 = WS_SCR + 408 * MiB;
constexpr size_t SC_G = SC_ZX;
constexpr size_t SC_Q = WS_SCR, SC_KA = WS_SCR + 68 * MiB, SC_VA = WS_SCR + 85 * MiB;
constexpr size_t SC_U = WS_SCR, SC_V = WS_SCR + 192 * MiB, SC_PSUM = WS_SCR + 384 * MiB;
constexpr size_t WS_END = WS_SCR + 476 * MiB;
constexpr int CW_BAR = 4096;

constexpr int RING_BYTES = 131072;
constexpr int LDSCTL_OFF = RING_BYTES, MISC_OFF = LDSCTL_OFF + 320;
constexpr int LDS_BYTES = 147456;

__device__ __forceinline__ unsigned f2bf(float f) { unsigned u = __builtin_bit_cast(unsigned, f); return (u + 0x7fffu + ((u >> 16) & 1u)) >> 16; }
__device__ __forceinline__ unsigned pk2(float lo, float hi) { return f2bf(lo) | (f2bf(hi) << 16); }
__device__ __forceinline__ float bflo(unsigned w) { return __builtin_bit_cast(float, w << 16); }
__device__ __forceinline__ float bfhi(unsigned w) { return __builtin_bit_cast(float, w & 0xffff0000u); }
__device__ __forceinline__ int opaque_tid() { int t = threadIdx.x; asm volatile("" : "+v"(t)); return t; }
__device__ __forceinline__ float wave_sum(float v) {
#pragma unroll
    for (int o = 1; o < 64; o <<= 1) v += __shfl_xor(v, o);
    return v;
}
__device__ __forceinline__ float gelu_tanh(float x) {
    const float t = x * (1.0f + 0.044715f * x * x);
    return x * __builtin_amdgcn_rcpf(1.0f + __builtin_amdgcn_exp2f(-2.3022082f * t));
}
__device__ __forceinline__ float sigmoid_f(float x) { return __builtin_amdgcn_rcpf(1.0f + __builtin_amdgcn_exp2f(-1.4426950409f * x)); }

#define XB_TMO      128
#define XB_XCNT(j)  (256  + 64 * (j))
#define XB_XSUB(j)  (1280 + 64 * (j))
#define XB_XGEN(j)  (2304 + 64 * (j))
#define XB_TOP      3328
#define XB_TOPGEN   3392
#define XCD_BAR_WORDS 3456
#define XB_SPIN_CAP (1u << 18)
__device__ __forceinline__ unsigned xb_ld(unsigned* p)              { return __hip_atomic_load(p, __ATOMIC_RELAXED, __HIP_MEMORY_SCOPE_AGENT); }
__device__ __forceinline__ unsigned xb_add(unsigned* p, unsigned v) { return __hip_atomic_fetch_add(p, v, __ATOMIC_RELAXED, __HIP_MEMORY_SCOPE_AGENT); }
__device__ __forceinline__ unsigned xb_xcc_id() { return (unsigned)__builtin_amdgcn_s_getreg((3 << 11) | 20) & 0xFu; }
#define XB_SPIN(cond, bar) do { unsigned _sp = 0; while (cond) { __builtin_amdgcn_s_sleep(1); \
    if ((++_sp & 255u) == 0u) { if (xb_ld(&(bar)[XB_TMO])) break; if (_sp > XB_SPIN_CAP) { atomicAdd(&(bar)[XB_TMO], 1u); break; } } } } while (0)
struct XcdBarrier { unsigned* bar; unsigned x; volatile LAS unsigned* st; };
__device__ __forceinline__ XcdBarrier xcd_barrier_post(unsigned* bar, volatile LAS unsigned* st) {
    XcdBarrier b; b.bar = bar; b.x = xb_xcc_id(); b.st = st;
    if (threadIdx.x == 0) (void)xb_add(&bar[XB_XCNT(b.x)], 1u);
    return b;
}
__device__ __forceinline__ void xcd_barrier_complete(unsigned* bar, unsigned x, unsigned& nloc, unsigned& nx) {
    const unsigned G = gridDim.x * gridDim.y * gridDim.z;
    unsigned sum, cnt, mine, sp = 0u;
    for (;;) {
        sum = 0u; cnt = 0u; mine = 0u;
#pragma unroll
        for (unsigned j = 0; j < 16; ++j) { const unsigned c = xb_ld(&bar[XB_XCNT(j)]); sum += c; cnt += (c > 0u) ? 1u : 0u; mine = (j == x) ? c : mine; }
        if (sum == G) break;
        __builtin_amdgcn_s_sleep(1);
        if ((++sp & 255u) == 0u) { if (xb_ld(&bar[XB_TMO])) break; if (sp > XB_SPIN_CAP) { atomicAdd(&bar[XB_TMO], 1u); break; } }
    }
    nloc = mine > 0u ? mine : 1u; nx = cnt > 0u ? cnt : 1u;
}
__device__ __forceinline__ void xcd_barrier(const XcdBarrier& b) {
    asm volatile("s_waitcnt vmcnt(0)" ::: "memory");
    __syncthreads();
    if (threadIdx.x == 0) {
        unsigned* bar = b.bar;
        __builtin_amdgcn_s_waitcnt(0);
        unsigned nloc = b.st[0], nx = b.st[1];
        if (nloc == 0u) { xcd_barrier_complete(bar, b.x, nloc, nx); b.st[0] = nloc; b.st[1] = nx; }
        const unsigned old = xb_add(&bar[XB_XSUB(b.x)], 1u);
        const unsigned gen = old / nloc;
        if (old + 1u == (gen + 1u) * nloc) {
            __builtin_amdgcn_fence(__ATOMIC_RELEASE, "agent");
            asm volatile("s_waitcnt vmcnt(0)" ::: "memory");
            const unsigned og = xb_add(&bar[XB_TOP], 1u);
            const unsigned tg = og / nx;
            if (og + 1u == (tg + 1u) * nx) xb_add(&bar[XB_TOPGEN], 1u);
            else XB_SPIN(xb_ld(&bar[XB_TOPGEN]) == tg, bar);
            __builtin_amdgcn_fence(__ATOMIC_ACQUIRE, "agent");
            xb_add(&bar[XB_XGEN(b.x)], 1u);
            asm volatile("s_waitcnt vmcnt(0)" ::: "memory");
        } else {
            XB_SPIN(xb_ld(&bar[XB_XGEN(b.x)]) == gen, bar);
            __builtin_amdgcn_fence(__ATOMIC_ACQUIRE, "agent");
            asm volatile("s_waitcnt vmcnt(0)" ::: "memory");
        }
    }
    __syncthreads();
}

namespace pg8 {
constexpr int BM = 256, BK = 64, HALF = 128, HTB = HALF * BK * 2, STAGE_BYTES = 8 * HTB, NXCD = 8, WGM = 8;
__host__ __device__ __forceinline__ int lds_byte(int r, int c) { const int st = (r >> 4) * 2 + (c >> 5), rr = r & 15, cc = c & 31, ob = rr * 64 + cc * 2; return st * 1024 + (ob ^ (((ob >> 9) & 1) << 5)); }
__host__ __device__ __forceinline__ void stage_rc(int b, int& R, int& C) { const int st = b / 1024, sb = b % 1024, swz = sb ^ (((sb >> 9) & 1) << 5); R = (st >> 1) * 16 + swz / 64; C = (st & 1) * 32 + (swz % 64) / 2; }
__host__ __device__ __forceinline__ int perm32(int rho) { const int n = rho >> 4, i = rho & 15; return 8 * (i >> 2) + 4 * n + (i & 3); }

struct Unit { const char* A; const char* B; const int* rows; int pm, pn; };

__device__ __forceinline__ bool static_order(int i, int G, int c, int nM, int nN, int& pm, int& pn) {
    const int nwg = nM * nN; const long L = (long)i * G + c; if (L >= nwg) return false;
    int wgid = (int)L; { const int q = nwg / NXCD, r = nwg % NXCD, xcd = wgid % NXCD, off = wgid / NXCD; wgid = (xcd < r ? xcd * (q + 1) : r * (q + 1) + (xcd - r) * q) + off; }
    const int nig = WGM * nN, gid = wgid / nig, fm = gid * WGM, gsz = (nM - fm) < WGM ? (nM - fm) : WGM;
    pm = fm + ((wgid % nig) % gsz); pn = (wgid % nig) / gsz; return true;
}

template <class Epi, class Sched, int PERM, bool GATHER>
__device__ __forceinline__ void gemm_phase(LAS unsigned char* lds, const int K, const int lda  , const int ldb  , const Sched& S, const Epi& E) {
    const int tid = opaque_tid(), wid = __builtin_amdgcn_readfirstlane(tid >> 6), lane = tid & 63, wr = wid >> 2, wc = wid & 3, fr = lane & 15, fq = lane >> 4;
    int nt = K / BK; asm volatile("" : "+s"(nt));
    int Rs[2], Cs[2]; unsigned voffB[2];
#pragma unroll
    for (int i = 0; i < 2; ++i) { int R, C; stage_rc(tid * 16 + i * 8192, R, C); Rs[i] = R; Cs[i] = C;
        const int Rb = (PERM == 0) ? R : (PERM == 1) ? ((R & ~31) + perm32(R & 31)) : (64 * (R >> 5) + perm32(R & 31));
        voffB[i] = (unsigned)(Rb * ldb + C * 2); }
    const unsigned hstepB = (unsigned)((PERM == 2 ? 32 : 128) * ldb);
    const size_t kstep = (size_t)(BK * 2);
    const unsigned ldsw = (unsigned)wid * 1024u;
    const int aoff = lds_byte(wr * 64 + fr, fq * 8), boff = lds_byte(wc * 32 + fr, fq * 8);
#define PG8_SA(b, h) (((b) * 2 + (h)) * HTB)
#define PG8_SB(b, h) ((4 + (b) * 2 + (h)) * HTB)
#define PG8_STAGE2(bufoff, gbase, o0, o1) do { \
        __builtin_amdgcn_global_load_lds((const unsigned*)((const char*)(gbase) + (o0)), (LAS unsigned*)(lds + (bufoff) + ldsw), 16, 0, 0); \
        __builtin_amdgcn_global_load_lds((const unsigned*)((const char*)(gbase) + (o1)), (LAS unsigned*)(lds + (bufoff) + ldsw + 8192), 16, 0, 0); } while (0)
#define PG8_STAGEB(bufoff, gbase, h) PG8_STAGE2(bufoff, gbase, voffB[0] + (h) * hstepB, voffB[1] + (h) * hstepB)
#define PG8_LDA(dst, b, h) do { _Pragma("unroll") for (int m = 0; m < 4; ++m) _Pragma("unroll") for (int k = 0; k < 2; ++k) dst[m][k] = *(const LAS bf16x8*)(lds + PG8_SA(b, h) + aoff + m * 2048 + k * 1024); } while (0)
#define PG8_LDB(dst, b, h) do { _Pragma("unroll") for (int n = 0; n < 2; ++n) _Pragma("unroll") for (int k = 0; k < 2; ++k) dst[n][k] = *(const LAS bf16x8*)(lds + PG8_SB(b, h) + boff + n * 2048 + k * 1024); } while (0)
#define PG8_MMA(ai, bj, At, Bt) do { __builtin_amdgcn_s_setprio(1); _Pragma("unroll") for (int m = 0; m < 4; ++m) _Pragma("unroll") for (int n = 0; n < 2; ++n) _Pragma("unroll") for (int k = 0; k < 2; ++k) \
        acc[ai][bj][m][n] = __builtin_amdgcn_mfma_f32_16x16x32_bf16(Bt[n][k], At[m][k], acc[ai][bj][m][n], 0, 0, 0); __builtin_amdgcn_s_setprio(0); } while (0)
#define PG8_WAIT_V(n) asm volatile("s_waitcnt vmcnt(" #n ")" ::: "memory")
#define PG8_WAIT_L(n) asm volatile("s_waitcnt lgkmcnt(" #n ")" ::: "memory")
#define PG8_BAR __builtin_amdgcn_s_barrier()
#define PG8_SCHED __builtin_amdgcn_sched_barrier(0)
#define PG8_AOFFS(dst, u) do { _Pragma("unroll") for (int h = 0; h < 2; ++h) _Pragma("unroll") for (int i = 0; i < 2; ++i) { \
        if (GATHER) dst[h * 2 + i] = (unsigned)((u).rows[h * 128 + Rs[i]]) * (unsigned)lda + (unsigned)(Cs[i] * 2); \
        else dst[h * 2 + i] = (unsigned)((h * 128 + Rs[i]) * lda + Cs[i] * 2); } } while (0)
    Unit cur, nxt; int ui = 0;
    if (!S.next(0, cur)) return;
    f32x4 acc[2][2][4][2];
#pragma unroll
    for (int a = 0; a < 2; ++a)
#pragma unroll
        for (int b = 0; b < 2; ++b)
#pragma unroll
            for (int m = 0; m < 4; ++m)
#pragma unroll
                for (int n = 0; n < 2; ++n) acc[a][b][m][n] = (f32x4){0.f, 0.f, 0.f, 0.f};
    bf16x8 At[4][2], B0[2][2], B1[2][2];
    const char* cA = cur.A; const char* cB = cur.B;
    unsigned cO[4], nO[4];
    PG8_AOFFS(cO, cur);
    PG8_STAGEB(PG8_SB(0, 0), cB, 0); PG8_STAGEB(PG8_SB(0, 1), cB, 1); PG8_STAGE2(PG8_SA(0, 0), cA, cO[0], cO[1]); PG8_STAGE2(PG8_SA(0, 1), cA, cO[2], cO[3]);
    if (wr == 1) PG8_BAR;
    PG8_WAIT_V(2); PG8_BAR;
    PG8_STAGEB(PG8_SB(1, 0), cB + kstep, 0); PG8_STAGE2(PG8_SA(1, 0), cA + kstep, cO[0], cO[1]); PG8_STAGEB(PG8_SB(1, 1), cB + kstep, 1);
    PG8_WAIT_V(6); PG8_BAR;
    for (;;) {
        const bool has_next = S.next(ui + 1, nxt);
        const char* nA = has_next ? nxt.A : cA; const char* nB = has_next ? nxt.B : cB;
        if (GATHER) { if (has_next) { PG8_AOFFS(nO, nxt); } else {
#pragma unroll
            for (int q = 0; q < 4; ++q) nO[q] = cO[q]; } }
#pragma unroll 1
        for (int t = 0; t < nt; t += 2) {
            const bool last = (t == nt - 2);
            const char* a1 = cA + (size_t)(t + 1) * kstep;
            const char* a2 = last ? nA : cA + (size_t)(t + 2) * kstep; const char* b2 = last ? nB : cB + (size_t)(t + 2) * kstep;
            const char* a3 = a2 + kstep; const char* b3 = b2 + kstep;
            unsigned x0, x1, x2, x3;
            if (GATHER) { x0 = last ? nO[0] : cO[0]; x1 = last ? nO[1] : cO[1]; x2 = last ? nO[2] : cO[2]; x3 = last ? nO[3] : cO[3]; }
            else { x0 = cO[0]; x1 = cO[1]; x2 = cO[2]; x3 = cO[3]; }
            PG8_LDB(B0, 0, 0); PG8_LDB(B1, 0, 1); PG8_SCHED; PG8_LDA(At, 0, 0); PG8_STAGE2(PG8_SA(1, 1), a1, cO[2], cO[3]);
            PG8_WAIT_V(8); PG8_WAIT_L(0); PG8_BAR; PG8_MMA(0, 0, At, B0); PG8_MMA(0, 1, At, B1); PG8_BAR; PG8_SCHED;
            PG8_LDA(At, 0, 1); PG8_STAGEB(PG8_SB(0, 0), b2, 0); PG8_STAGEB(PG8_SB(0, 1), b2, 1); PG8_STAGE2(PG8_SA(0, 0), a2, x0, x1);
            PG8_WAIT_V(8); PG8_WAIT_L(0); PG8_BAR; PG8_MMA(1, 0, At, B0); PG8_MMA(1, 1, At, B1); PG8_BAR; PG8_SCHED;
            PG8_LDB(B0, 1, 0); PG8_LDB(B1, 1, 1); PG8_SCHED; PG8_LDA(At, 1, 0); PG8_STAGE2(PG8_SA(0, 1), a2, x2, x3);
            PG8_WAIT_V(8); PG8_WAIT_L(0); PG8_BAR; PG8_MMA(0, 0, At, B0); PG8_MMA(0, 1, At, B1); PG8_BAR; PG8_SCHED;
            PG8_LDA(At, 1, 1); PG8_STAGEB(PG8_SB(1, 0), b3, 0); PG8_STAGEB(PG8_SB(1, 1), b3, 1); PG8_STAGE2(PG8_SA(1, 0), a3, x0, x1);
            PG8_WAIT_V(8); PG8_WAIT_L(0); PG8_BAR; PG8_MMA(1, 0, At, B0); PG8_MMA(1, 1, At, B1); PG8_BAR; PG8_SCHED;
        }
        if (wr == 0) PG8_BAR;
        { const int tz = opaque_tid(), lz = tz & 63; E(acc, cur, wr, wc, lz & 15, lz >> 4); }
        if (!has_next) break;
#pragma unroll
        for (int a = 0; a < 2; ++a)
#pragma unroll
            for (int b = 0; b < 2; ++b)
#pragma unroll
                for (int m = 0; m < 4; ++m)
#pragma unroll
                    for (int n = 0; n < 2; ++n) acc[a][b][m][n] = (f32x4){0.f, 0.f, 0.f, 0.f};
        cur = nxt; cA = nA; cB = nB; ++ui;
        if (GATHER) {
#pragma unroll
            for (int q = 0; q < 4; ++q) cO[q] = nO[q]; }
        if (wr == 1) PG8_BAR;
    }
    PG8_WAIT_V(0);
    PG8_BAR;
#undef PG8_SA
#undef PG8_SB
#undef PG8_STAGE2
#undef PG8_STAGEB
#undef PG8_LDA
#undef PG8_LDB
#undef PG8_MMA
#undef PG8_WAIT_V
#undef PG8_WAIT_L
#undef PG8_BAR
#undef PG8_SCHED
#undef PG8_AOFFS
}
}

namespace attn_body {
using bf16=__hip_bfloat16;
using bf16x8=__attribute__((ext_vector_type(8)))short;
using s16x4=__attribute__((ext_vector_type(4)))short;
using f32x16=__attribute__((ext_vector_type(16)))float;
using u32x4=__attribute__((ext_vector_type(4)))unsigned;
constexpr int D=64,DMQ=1024,DMK=256;
constexpr int NW=8,QBLK=32,QB=QBLK*NW,KVBLK=64;
__device__ __forceinline__ int crow(int r,int hi){return (r&3)+8*(r>>2)+4*hi;}
#define SBAR() __builtin_amdgcn_sched_barrier(0)
constexpr int NSLOT=3, SLOTB=8192;
constexpr int LDS_K=0, LDS_V=NSLOT*SLOTB, LDS_WS=2*NSLOT*SLOTB, LDS_OST=LDS_WS+NW*64*4, LDS_BYTES=LDS_OST+NW*4096;
constexpr float C2=0.125f*1.4426950408889634f;
__device__ __forceinline__ void glds16(const void*gsrc,unsigned lds_dst){unsigned keep;
  asm volatile("s_mov_b32 %0, m0\n\ts_mov_b32 m0, %2\n\ts_nop 0\n\tglobal_load_lds_dwordx4 %1, off\n\ts_mov_b32 m0, %0":"=&s"(keep):"v"(gsrc),"s"(lds_dst):"memory");}
__device__ __forceinline__ float max3f(float a,float b,float c){float r;asm("v_max3_f32 %0, %1, %2, %3":"=v"(r):"v"(a),"v"(b),"v"(c));return r;}
__device__ __forceinline__ float max2f(float a,float b){float r;asm("v_max_f32_e32 %0, %1, %2":"=v"(r):"v"(a),"v"(b));return r;}
__device__ __forceinline__ float fadd_s(float a,float b){float r;asm("v_add_f32_e32 %0, %1, %2":"=v"(r):"v"(a),"v"(b));return r;}
__device__ __forceinline__ float fsub_s(float a,float b){float r;asm("v_sub_f32_e32 %0, %1, %2":"=v"(r):"v"(a),"v"(b));return r;}
typedef float f32x2_t __attribute__((ext_vector_type(2))); typedef __bf16 bf16x2_t __attribute__((ext_vector_type(2)));
__device__ __forceinline__ unsigned cvtpk_s(float lo,float hi){f32x2_t v={lo,hi};bf16x2_t b=__builtin_convertvector(v,bf16x2_t);return __builtin_bit_cast(unsigned,b);}
#define WAIT_BAR(N) asm volatile("s_waitcnt vmcnt(" #N ") lgkmcnt(0)\n\ts_barrier":::"memory")

__device__ __forceinline__ void qkt(f32x16&p0,f32x16&p1,const char*Kslot,const bf16x8*qr,const f32x16&negm,int r32,int hi){
  const char*kb=Kslot+hi*1024+r32*16;
  #pragma unroll
  for(int d0=0;d0<4;++d0){
    const bf16x8 b0=*reinterpret_cast<const bf16x8*>(kb+d0*2048);
    const bf16x8 b1=*reinterpret_cast<const bf16x8*>(kb+d0*2048+512);
    if(d0==0){p0=__builtin_amdgcn_mfma_f32_32x32x16_bf16(b0,qr[0],negm,0,0,0);p1=__builtin_amdgcn_mfma_f32_32x32x16_bf16(b1,qr[0],negm,0,0,0);}
    else{p0=__builtin_amdgcn_mfma_f32_32x32x16_bf16(b0,qr[d0],p0,0,0,0);p1=__builtin_amdgcn_mfma_f32_32x32x16_bf16(b1,qr[d0],p1,0,0,0);}}
}
typedef __attribute__((address_space(3))) const char* lds_cptr;
typedef short v4i16_t __attribute__((ext_vector_type(4)));
__device__ __forceinline__ void kload8(bf16x8*kf,lds_cptr kp){
  kf[0]=*(const __attribute__((address_space(3))) bf16x8*)(kp);      kf[1]=*(const __attribute__((address_space(3))) bf16x8*)(kp+512);
  kf[2]=*(const __attribute__((address_space(3))) bf16x8*)(kp+2048); kf[3]=*(const __attribute__((address_space(3))) bf16x8*)(kp+2560);
  kf[4]=*(const __attribute__((address_space(3))) bf16x8*)(kp+4096); kf[5]=*(const __attribute__((address_space(3))) bf16x8*)(kp+4608);
  kf[6]=*(const __attribute__((address_space(3))) bf16x8*)(kp+6144); kf[7]=*(const __attribute__((address_space(3))) bf16x8*)(kp+6656);
}
__device__ __forceinline__ void kload2(bf16x8*kf,lds_cptr kp,int j){ kf[2*j]=*(const __attribute__((address_space(3))) bf16x8*)(kp+j*2048); kf[2*j+1]=*(const __attribute__((address_space(3))) bf16x8*)(kp+j*2048+512); }
__device__ __forceinline__ s16x4 vtr(lds_cptr p){ return __builtin_bit_cast(s16x4,__builtin_amdgcn_ds_read_tr16_b64_v4i16((__attribute__((address_space(3))) v4i16_t*)p)); }
__device__ __forceinline__ float rowmax(const f32x16&p0,const f32x16&p1){
  float a=max3f(p0[0],p0[1],p1[0]),b=max3f(p0[2],p0[3],p1[1]);a=max3f(a,p1[2],p1[3]);
  #pragma unroll
  for(int r=4;r<16;r+=4){a=max3f(a,p0[r],p0[r+1]);b=max3f(b,p0[r+2],p0[r+3]);a=max3f(a,p1[r],p1[r+1]);b=max3f(b,p1[r+2],p1[r+3]);}
  const float m=max2f(a,b);
  auto rr=__builtin_amdgcn_permlane32_swap(__float_as_uint(m),__float_as_uint(m),false,false);
  return max2f(__uint_as_float(rr[0]),__uint_as_float(rr[1]));
}
__device__ __forceinline__ void pv(f32x16*o,int vb,bf16x8 pa0,bf16x8 pa1,bf16x8 pa2,bf16x8 pa3){
  #pragma unroll
  for(int d0=0;d0<2;++d0){s16x4 lo[4],hi[4];
    #pragma unroll
    for(int ks=0;ks<4;++ks){
      asm volatile("ds_read_b64_tr_b16 %0,%1 offset:%c2":"=&v"(lo[ks]):"v"(vb),"i"(d0*4096+ks*1024):"memory");
      asm volatile("ds_read_b64_tr_b16 %0,%1 offset:%c2":"=&v"(hi[ks]):"v"(vb),"i"(d0*4096+ks*1024+512):"memory");}
    asm volatile("s_waitcnt lgkmcnt(0)":::"memory");SBAR();
    #define PK(k) (bf16x8){lo[k][0],lo[k][1],lo[k][2],lo[k][3],hi[k][0],hi[k][1],hi[k][2],hi[k][3]}
    o[d0]=__builtin_amdgcn_mfma_f32_32x32x16_bf16(pa0,PK(0),o[d0],0,0,0);
    o[d0]=__builtin_amdgcn_mfma_f32_32x32x16_bf16(pa1,PK(1),o[d0],0,0,0);
    o[d0]=__builtin_amdgcn_mfma_f32_32x32x16_bf16(pa2,PK(2),o[d0],0,0,0);
    o[d0]=__builtin_amdgcn_mfma_f32_32x32x16_bf16(pa3,PK(3),o[d0],0,0,0);
    #undef PK
  }
}

#ifndef ATTN_STORE16
#define ATTN_STORE16(p,v) (*(u32x4*)(p)=(v))
#endif
template<int THRL> __device__ __forceinline__ void attn_unit(const bf16*Qw0,const bf16*__restrict__ Kh,const bf16*__restrict__ Vh,bf16*Ow0,const int NT,char*shm){
  int tid=threadIdx.x; asm volatile("":"+v"(tid)); const int lane=tid&63,r32=lane&31,hi=lane>>5; const int wid=__builtin_amdgcn_readfirstlane(tid>>6);
  const bf16*Qw=Qw0+(long)(wid*QBLK)*DMQ;
  const unsigned lds0=(unsigned)(uintptr_t)shm;
  float*wsf=(float*)(shm+LDS_WS)+wid*64;
  const bf16*ksrc=Kh+(long)lane*DMK+wid*8;
  const bf16*vsrc=Vh+(long)(16*(wid&3)+(lane>>2))*DMK+(wid>>2)*32+(lane&3)*8;
  const unsigned kdst=lds0+LDS_K+wid*1024, vdst=lds0+LDS_V+wid*1024;
  #define DMA_K(t,slot) glds16(ksrc+(long)(t)*KVBLK*DMK,(unsigned)__builtin_amdgcn_readfirstlane(kdst+(slot)))
  #define DMA_V(t,slot) glds16(vsrc+(long)(t)*KVBLK*DMK,(unsigned)__builtin_amdgcn_readfirstlane(vdst+(slot)))
  const int vb0=(int)(lds0+LDS_V)+((lane>>4)&1)*32+(lane&3)*8+(4*hi+((lane&15)>>2))*64;
  const char*Kbase=shm+LDS_K; bf16x8 kf[8];
  const lds_cptr shm3=(lds_cptr)shm; const lds_cptr kp0=shm3+LDS_K+hi*1024+r32*16; const lds_cptr vp0=shm3+LDS_V+((lane>>4)&1)*32+(lane&3)*8+(4*hi+((lane&15)>>2))*64;
  DMA_K(0,0);DMA_V(0,0);DMA_K(1,SLOTB);
  bf16x8 qr[4];
  #pragma unroll
  for(int d0=0;d0<4;++d0)qr[d0]=*reinterpret_cast<const bf16x8*>(&Qw[(long)r32*DMQ+d0*16+hi*8]);
  float mhat=0.f,l_reg=0.f;f32x16 o[2];o[0]=f32x16{};o[1]=f32x16{};f32x16 negm=f32x16{};asm volatile("":"+v"(negm));
  #define CMASK(P0,P1,t) do{}while(0)
  bool resc=false;
  #define START(P0,P1) do{ const float rm=rowmax(P0,P1); resc=false; \
    { const float dl=rm; mhat=fadd_s(mhat,dl); \
      _Pragma("unroll") for(int r=0;r<16;++r){P0[r]=fsub_s(P0[r],dl);P1[r]=fsub_s(P1[r],dl);} \
      _Pragma("unroll") for(int r=0;r<16;++r)negm[r]=-mhat; asm volatile("":"+v"(negm)); } \
    _Pragma("unroll") for(int r=0;r<16;++r)P0[r]=__builtin_amdgcn_exp2f(P0[r]); }while(0)
  #define RESC() do{ if(resc){ asm volatile("s_waitcnt lgkmcnt(0)":::"memory"); \
      _Pragma("unroll") for(int d_=0;d_<2;++d_) _Pragma("unroll") for(int r=0;r<16;++r)o[d_][r]*=wsf[crow(r,hi)]; } }while(0)
  f32x16 pA0,pA1,pB0,pB1;
  int sl_prev=0,sl_cur=0,sl_next=SLOTB;
  #define ROT() do{sl_prev=sl_cur;sl_cur=sl_next;sl_next=(sl_next==(NSLOT-1)*SLOTB)?0:sl_next+SLOTB;}while(0)
  DMA_K(2,2*SLOTB);
  WAIT_BAR(3);
  qkt(pA0,pA1,Kbase,qr,negm,r32,hi);asm volatile("s_nop 15\n\ts_nop 7":"+v"(pA0),"+v"(pA1));CMASK(pA0,pA1,0);
  START(pA0,pA1);
  _Pragma("unroll") for(int r=0;r<16;++r)pA1[r]=__builtin_amdgcn_exp2f(pA1[r]);
  WAIT_BAR(0);
  DMA_K(3,0);DMA_V(1,SLOTB);
  ROT();
  kload8(kf,kp0+sl_cur);
  WAIT_BAR(2);
  s16x4 vlo[8],vhi[8]; u32x4 pw0,pw1,pw2,pw3;
  #define PKW(P,B) cvtpk_s(P[B],P[B+1])
  #define PAF(k) __builtin_bit_cast(bf16x8,pw##k)
  #define VFR(i) (bf16x8){vlo[i][0],vlo[i][1],vlo[i][2],vlo[i][3],vhi[i][0],vhi[i][1],vhi[i][2],vhi[i][3]}
  #define PIN(x) asm volatile("":"+v"(x))
  #define MX3(a,b,c) __builtin_fmaxf(__builtin_fmaxf((a),(b)),(c))
  #define GAPA(MF,A0,A1,A2,A3,W0,W1,PW) do{ MF; sacc+=A0; sacc+=A1; sacc+=A2; sacc+=A3; PIN(sacc); W0; W1; PIN(PW); SBAR(); }while(0)
  #define EX(v) __builtin_amdgcn_exp2f(v)
  #define GAPB(MF,X,B) do{ MF; X[B]=EX(X[B]); X[B+1]=EX(X[B+1]); X[B+2]=EX(X[B+2]); X[B+3]=EX(X[B+3]); PIN(X); SBAR(); }while(0)
  #define VRD(i) do{ vlo[i]=vtr(vp_+(((i)>>2)*4096+((i)&3)*1024)); vhi[i]=vtr(vp_+(((i)>>2)*4096+((i)&3)*1024+512)); }while(0)
  #define KRD(G,j) do{ if(G){ kload2(kf,kp0+sl_next,j); SBAR(); } }while(0)
  #define STEP(C0,C1,P0,P1,t,GK,GV,GL) do{ SBAR(); \
    const lds_cptr vp_=vp0+sl_prev; \
    VRD(0); SBAR(); float sacc=(P0[0]+P0[1]); \
    GAPA(C0=__builtin_amdgcn_mfma_f32_32x32x16_bf16(kf[0],qr[0],negm,0,0,0), P0[2],P0[3],P0[4],P0[5],     pw0[0]=PKW(P0,0), pw0[1]=PKW(P0,2), pw0); \
    VRD(4); SBAR(); GAPA(C1=__builtin_amdgcn_mfma_f32_32x32x16_bf16(kf[1],qr[0],negm,0,0,0), P0[6],P0[7],P0[8],P0[9],     pw0[2]=PKW(P0,4), pw0[3]=PKW(P0,6), pw0); \
    VRD(1); SBAR(); GAPA(C0=__builtin_amdgcn_mfma_f32_32x32x16_bf16(kf[2],qr[1],C0,0,0,0),   P0[10],P0[11],P0[12],P0[13], pw1[0]=PKW(P0,8), pw1[1]=PKW(P0,10), pw1); \
    VRD(5); SBAR(); GAPA(C1=__builtin_amdgcn_mfma_f32_32x32x16_bf16(kf[3],qr[1],C1,0,0,0),   P0[14],P0[15],P1[0],P1[1],   pw1[2]=PKW(P0,12),pw1[3]=PKW(P0,14), pw1); \
    VRD(2); SBAR(); GAPA(C0=__builtin_amdgcn_mfma_f32_32x32x16_bf16(kf[4],qr[2],C0,0,0,0),   P1[2],P1[3],P1[4],P1[5],     pw2[0]=PKW(P1,0), pw2[1]=PKW(P1,2), pw2); \
    VRD(6); SBAR(); GAPA(C1=__builtin_amdgcn_mfma_f32_32x32x16_bf16(kf[5],qr[2],C1,0,0,0),   P1[6],P1[7],P1[8],P1[9],     pw2[2]=PKW(P1,4), pw2[3]=PKW(P1,6), pw2); \
    VRD(3); SBAR(); GAPA(C0=__builtin_amdgcn_mfma_f32_32x32x16_bf16(kf[6],qr[3],C0,0,0,0),   P1[10],P1[11],P1[12],P1[13], pw3[0]=PKW(P1,8), pw3[1]=PKW(P1,10), pw3); \
    VRD(7); SBAR(); GAPA(C1=__builtin_amdgcn_mfma_f32_32x32x16_bf16(kf[7],qr[3],C1,0,0,0),   P1[14],P1[15],0.f,0.f,       pw3[2]=PKW(P1,12),pw3[3]=PKW(P1,14), pw3); \
    l_reg+=sacc; \
    if(GK){DMA_K((t)+3,sl_cur);} if(GV){DMA_V((t)+1,sl_next);} \
    CMASK(C0,C1,t); \
    { float a=MX3(C0[0],C0[1],C1[0]),b=MX3(C0[2],C0[3],C1[1]); a=MX3(a,C1[2],C1[3]); \
      _Pragma("unroll") for(int r=4;r<16;r+=4){a=MX3(a,C0[r],C0[r+1]);b=MX3(b,C0[r+2],C0[r+3]);a=MX3(a,C1[r],C1[r+1]);b=MX3(b,C1[r+2],C1[r+3]);} \
      float rm=__builtin_fmaxf(a,b); { auto rr=__builtin_amdgcn_permlane32_swap(__float_as_uint(rm),__float_as_uint(rm),false,false); rm=__builtin_fmaxf(__uint_as_float(rr[0]),__uint_as_float(rr[1])); } \
      resc=false; \
      if(__builtin_expect(__any(rm>(float)THRL),0)){ const float dl=__builtin_fmaxf(rm,0.f); mhat+=dl; \
        _Pragma("unroll") for(int r=0;r<16;++r){C0[r]-=dl;C1[r]-=dl;} \
        _Pragma("unroll") for(int r=0;r<16;++r)negm[r]=-mhat; asm volatile("":"+v"(negm)); \
        const float f=__builtin_amdgcn_exp2f(-dl); l_reg*=f; if(hi==0)wsf[r32]=f; resc=true; } } \
    SBAR(); \
    GAPB(o[0]=__builtin_amdgcn_mfma_f32_32x32x16_bf16(PAF(0),VFR(0),o[0],0,0,0), C0,0); \
    GAPB(o[1]=__builtin_amdgcn_mfma_f32_32x32x16_bf16(PAF(0),VFR(4),o[1],0,0,0), C0,4); \
    KRD(GL,0); GAPB(o[0]=__builtin_amdgcn_mfma_f32_32x32x16_bf16(PAF(1),VFR(1),o[0],0,0,0), C0,8); \
    KRD(GL,1); GAPB(o[1]=__builtin_amdgcn_mfma_f32_32x32x16_bf16(PAF(1),VFR(5),o[1],0,0,0), C0,12); \
    KRD(GL,2); GAPB(o[0]=__builtin_amdgcn_mfma_f32_32x32x16_bf16(PAF(2),VFR(2),o[0],0,0,0), C1,0); \
    KRD(GL,3); GAPB(o[1]=__builtin_amdgcn_mfma_f32_32x32x16_bf16(PAF(2),VFR(6),o[1],0,0,0), C1,4); \
    GAPB(o[0]=__builtin_amdgcn_mfma_f32_32x32x16_bf16(PAF(3),VFR(3),o[0],0,0,0), C1,8); \
    GAPB(o[1]=__builtin_amdgcn_mfma_f32_32x32x16_bf16(PAF(3),VFR(7),o[1],0,0,0), C1,12); \
    }while(0)
  int t=1;
  #undef CMASK
  #define CMASK(P0,P1,t) do{}while(0)
  for(;t+5<NT;t+=2){
    STEP(pB0,pB1,pA0,pA1,t,true,true,true);     WAIT_BAR(2); RESC(); ROT();
    STEP(pA0,pA1,pB0,pB1,t+1,true,true,true);   WAIT_BAR(2); RESC(); ROT();
  }
  #undef CMASK
  #define CMASK(P0,P1,t) do{}while(0)
  #define ENDW(tt) do{ if((tt)+3<NT){WAIT_BAR(2);} else if((tt)+2<NT){WAIT_BAR(1);} else {WAIT_BAR(0);} }while(0)
  for(;t+1<NT;t+=2){
    STEP(pB0,pB1,pA0,pA1,t,(t+3<NT),(t+1<NT),(t+1<NT));       ENDW(t);   RESC(); ROT();
    STEP(pA0,pA1,pB0,pB1,t+1,(t+4<NT),(t+2<NT),(t+2<NT));     ENDW(t+1); RESC(); ROT();
  }
  STEP(pB0,pB1,pA0,pA1,NT-1,false,false,false); RESC();
  { float sacc=pB0[0]+pB0[1]; _Pragma("unroll") for(int r=2;r<16;++r)sacc+=pB0[r]; _Pragma("unroll") for(int r=0;r<16;++r)sacc+=pB1[r]; l_reg+=sacc;
    pw0=(u32x4){PKW(pB0,0),PKW(pB0,2),PKW(pB0,4),PKW(pB0,6)};pw1=(u32x4){PKW(pB0,8),PKW(pB0,10),PKW(pB0,12),PKW(pB0,14)};pw2=(u32x4){PKW(pB1,0),PKW(pB1,2),PKW(pB1,4),PKW(pB1,6)};pw3=(u32x4){PKW(pB1,8),PKW(pB1,10),PKW(pB1,12),PKW(pB1,14)};
    SBAR(); pv(o,vb0+sl_cur,PAF(0),PAF(1),PAF(2),PAF(3)); }
  #undef PKW
  #undef PAF
  #undef VFR
  #undef PIN
  #undef MX3
  #undef GAPA
  #undef GAPB
  #undef EX
  #undef VRD
  #undef KRD
  #undef STEP
  #undef ENDW
  {auto rr=__builtin_amdgcn_permlane32_swap(__float_as_uint(l_reg),__float_as_uint(l_reg),false,false);l_reg=__uint_as_float(rr[0])+__uint_as_float(rr[1]);}
  if(hi==0)wsf[32+r32]=l_reg;asm volatile("s_waitcnt lgkmcnt(0)":::"memory");
  float rli[16];
  #pragma unroll
  for(int r=0;r<16;++r)rli[r]=__builtin_amdgcn_rcpf(wsf[32+crow(r,hi)]);
  bf16*Ow=Ow0+(long)(wid*QBLK)*DMQ;
  { bf16*stg=(bf16*)(shm+LDS_OST)+wid*2048;
    #pragma unroll
    for(int r=0;r<16;++r){const int orow=crow(r,hi);
      #pragma unroll
      for(int d0=0;d0<2;++d0)stg[orow*64+d0*32+r32]=__float2bfloat16(o[d0][r]*rli[r]);}
    asm volatile("s_waitcnt lgkmcnt(0)":::"memory");
    #pragma unroll
    for(int i=0;i<4;++i){const int row=i*8+(lane>>3),ch=lane&7; const u32x4 v=*(const u32x4*)(stg+row*64+ch*8); ATTN_STORE16(Ow+(long)row*DMQ+ch*8,v);} }
  asm volatile("s_waitcnt lgkmcnt(0)\n\ts_barrier":::"memory");
  #undef DMA_K
  #undef DMA_V
  #undef CMASK
  #undef START
  #undef RESC
  #undef ROT
}
constexpr int ATTN_LDS_BYTES=LDS_BYTES;
#undef SBAR
#undef WAIT_BAR
}

struct Frame {
    LAS unsigned char* lds;
    volatile LAS unsigned* MISC;
    gu32* ctl;
    int vcu, G;
    const float* const* in;
    unsigned char* ws;
    float* out;
};
#define WSP(T, off) ((T*)(F.ws + (off)))
#define INP(i) (F.in[i])
enum { I_X = 0, I_C, I_CTX, I_CCTX, I_MODW, I_MODB, I_POOLW, I_POOLS, I_LIN, I_CONVW, I_CONVB, I_WA, I_BA, I_WX, I_BX, I_LAM, I_LOUT, I_QKV, I_QG, I_KG, I_WO,
       I_GIN, I_LNG, I_LNB, I_WS, I_BS, I_GOUT, I_ROUTER, I_WG, I_WU, I_WDN, I_FG, N_IN };

__device__ __forceinline__ void tr_item(const float* W, int ldw, bf16* WT, int ldt, int k0, int n0, int drow0, LAS float* scr, int lane) {
#pragma unroll 8
    for (int i = 0; i < 32; ++i) { const int kk = 2 * i + (lane >> 5); scr[kk * 33 + (lane & 31)] = W[(size_t)(k0 + kk) * ldw + n0 + (lane & 31)]; }
    LDS_WAIT(); asm volatile("" ::: "memory");
    const int c = lane & 7;
#pragma unroll
    for (int j = 0; j < 4; ++j) { const int n = (lane >> 3) + 8 * j; const LAS float* s = scr + (8 * c) * 33 + n;
        v4u o; o.x = pk2(s[0 * 33], s[1 * 33]); o.y = pk2(s[2 * 33], s[3 * 33]); o.z = pk2(s[4 * 33], s[5 * 33]); o.w = pk2(s[6 * 33], s[7 * 33]);
        *(v4u*)(WT + (size_t)(drow0 + n) * ldt + k0 + 8 * c) = o; }
    LDS_WAIT(); asm volatile("" ::: "memory");
}
template <int MODE>
__device__ __forceinline__ void tr_job(Frame& F, const float* W, int K, int N, int nb, bf16* WT) {
    const int tid_ = opaque_tid(), lane_ = tid_ & 63, wave_ = __builtin_amdgcn_readfirstlane(tid_ >> 6); (void)lane_; (void)wave_;
    LAS float* scr = (LAS float*)(F.lds + wave_ * 16384);
    const int gw = F.vcu * NWAVES + wave_, NGW = F.G * NWAVES;
    const int nblk = N / 32, per = (K / 64) * nblk, total = per * nb;
    for (int it = gw; it < total; it += NGW) {
        const int bb = it / per, r = it - bb * per, kb = r / nblk, nbk = r - kb * nblk, k0 = 64 * kb, n0 = 32 * nbk;
        const float* Wb = W + (size_t)bb * K * N;
        bf16* dst; int drow0;
        if (MODE == 0) { dst = WT + (size_t)bb * N * K; drow0 = n0; }
        else if (MODE == 1 || MODE == 2) { dst = WT + (size_t)bb * 2048 * K; drow0 = 256 * (n0 >> 7) + (n0 & 127) + (MODE == 2 ? 128 : 0); }
        else { const int d = bb >> 3, h = bb & 7; dst = WT + (size_t)((h * 2 + d) * 256 + (MODE == 4 ? 128 : 0)) * K; drow0 = n0; }
        tr_item(Wb, N, dst, K, k0, n0, drow0, scr, lane_);
    }
}
__device__ __forceinline__ void convert_moe(Frame& F, int L) {
    tr_job<1>(F, INP(I_WG) + (size_t)L * 16 * 1024 * 1024, 1024, 1024, 16, WSP(bf16, WS_WGU));
    tr_job<2>(F, INP(I_WU) + (size_t)L * 16 * 1024 * 1024, 1024, 1024, 16, WSP(bf16, WS_WGU));
    tr_job<0>(F, INP(I_WDN) + (size_t)L * 16 * 1024 * 1024, 1024, 1024, 16, WSP(bf16, WS_WD));
}

__device__ __forceinline__ void phase_prologue(Frame& F) {
    const int tid_ = opaque_tid(), lane_ = tid_ & 63, wave_ = __builtin_amdgcn_readfirstlane(tid_ >> 6); (void)lane_; (void)wave_;
    tr_job<0>(F, INP(I_POOLW), 256, 256, 4, WSP(bf16, WS_PW));
    tr_job<0>(F, INP(I_LIN), 1024, 2048, 1, WSP(bf16, WS_LIN));
    tr_job<3>(F, INP(I_WA), 128, 128, 16, WSP(bf16, WS_LG));
    tr_job<4>(F, INP(I_WX), 128, 128, 16, WSP(bf16, WS_LG));
    tr_job<0>(F, INP(I_LOUT), 1024, 1024, 1, WSP(bf16, WS_LOUT));
    tr_job<0>(F, INP(I_QKV), 1024, 1536, 1, WSP(bf16, WS_QKV));
    tr_job<0>(F, INP(I_WO), 1024, 1024, 1, WSP(bf16, WS_WO));
    tr_job<0>(F, INP(I_GIN), 1024, 6144, 1, WSP(bf16, WS_GIN));
    tr_job<0>(F, INP(I_GOUT), 3072, 1024, 1, WSP(bf16, WS_GOUT));
    convert_moe(F, 0);
    {
        const float* s = INP(I_WS); bf16* d = WSP(bf16, WS_GS);
        for (int i = (int)blockIdx.x * 512 + tid_; i < 4 * 128 * 128 / 2; i += F.G * 512) ((unsigned*)d)[i] = pk2(s[2 * i], s[2 * i + 1]);
    }
    if (blockIdx.x == 0) {
        float* rt = WSP(float, WS_ROPE);
        for (int i = tid_; i < 1024; i += 512) { const int pos = i >> 4, f = i & 15; const float inv = powf(10000.0f, -(float)f / 16.0f); const float ang = (float)pos * inv;
            rt[2 * i] = cosf(ang); rt[2 * i + 1] = sinf(ang); }
    }
    __syncthreads();
    LAS float* S = (LAS float*)F.lds;
    LAS float* RED = (LAS float*)(F.lds + 40960);
    for (int i = tid_; i < 9 * 1024; i += 512) { const int r = i >> 10, k = i & 1023; const float c = (r < 8) ? INP(I_C)[r * 1024 + k] : INP(I_CCTX)[k]; S[i] = c * sigmoid_f(c); }
    __syncthreads();
    for (int u = (int)blockIdx.x; u < 4 * 96; u += F.G) {
        const int l = u / 96, n0 = (u % 96) * 64;
        const float* Wl = INP(I_MODW) + (size_t)l * 1024 * 6144 + n0 + lane_;
        float a[9];
#pragma unroll
        for (int r = 0; r < 9; ++r) a[r] = 0.f;
        const int kb = wave_ * 128;
        for (int k = 0; k < 128; k += 4) {
            float w[4];
#pragma unroll
            for (int q = 0; q < 4; ++q) w[q] = Wl[(size_t)(kb + k + q) * 6144];
#pragma unroll
            for (int r = 0; r < 9; ++r) { const f32x4 s = *(const LAS f32x4*)(S + r * 1024 + kb + k); a[r] += s.x * w[0] + s.y * w[1] + s.z * w[2] + s.w * w[3]; }
        }
#pragma unroll
        for (int r = 0; r < 9; ++r) RED[(wave_ * 9 + r) * 64 + lane_] = a[r];
        __syncthreads();
        for (int i = tid_; i < 9 * 64; i += 512) { const int r = i >> 6, c = i & 63; float s = 0.f;
#pragma unroll
            for (int w8 = 0; w8 < 8; ++w8) s += RED[(w8 * 9 + r) * 64 + c];
            WSP(float, WS_MOD)[((size_t)l * 9 + r) * 6144 + n0 + c] = s + INP(I_MODB)[l * 6144 + n0 + c]; }
        __syncthreads();
    }
}

template <int L>
__device__ __forceinline__ void phase_n1(Frame& F) {
    const int tid_ = opaque_tid(), lane_ = tid_ & 63, wave_ = __builtin_amdgcn_readfirstlane(tid_ >> 6); (void)lane_; (void)wave_;
    const int gw = F.vcu * NWAVES + wave_, NGW = F.G * NWAVES;
    constexpr int nrows = (L >= 3) ? RL : RT;
    float* XS = WSP(float, WS_XS); bf16* H = WSP(bf16, WS_H); const int* INV = WSP(int, WS_INV); const bf16* Y = WSP(bf16, SC_Y);
    const float* MOD = WSP(float, WS_MOD);
    for (int row = gw; row < nrows; row += NGW) {
        const int b = row < RL ? (row >> 12) : 8;
        const float* src;
        if (L == 0) src = row < RL ? INP(I_X) + (size_t)row * D : INP(I_CTX) + (size_t)(row - RL) * D; else src = XS + (size_t)row * D;
        const f32x4* xr = (const f32x4*)src + lane_;
        f32x4 v[4];
#pragma unroll
        for (int j = 0; j < 4; ++j) v[j] = xr[64 * j];
        if (L > 0) {
            const int inv = (lane_ < 16) ? INV[row * 16 + lane_] : -1;
            f32x4 a[4];
#pragma unroll
            for (int j = 0; j < 4; ++j) a[j] = (f32x4){0.f, 0.f, 0.f, 0.f};
#pragma unroll
            for (int e = 0; e < 16; ++e) {
                const int yr = __builtin_amdgcn_readlane(inv, e);
                if (yr >= 0) { const v2u* yp = (const v2u*)(Y + (size_t)yr * D) + lane_;
#pragma unroll
                    for (int j = 0; j < 4; ++j) { const v2u w = yp[64 * j]; a[j].x += bflo(w.x); a[j].y += bfhi(w.x); a[j].z += bflo(w.y); a[j].w += bfhi(w.y); } }
            }
            const float* g2 = MOD + ((size_t)(L - 1) * 9 + b) * 6144 + 5120;
#pragma unroll
            for (int j = 0; j < 4; ++j) { const f32x4 g = *((const f32x4*)g2 + 64 * j + lane_); v[j] = v[j] + g * a[j]; }
            if (L < 4) { f32x4* xo = (f32x4*)(XS + (size_t)row * D) + lane_;
#pragma unroll
                for (int j = 0; j < 4; ++j) xo[64 * j] = v[j]; }
        }
        float ss = 0.f;
#pragma unroll
        for (int j = 0; j < 4; ++j) ss += (v[j].x * v[j].x + v[j].y * v[j].y) + (v[j].z * v[j].z + v[j].w * v[j].w);
        const float rstd = 1.0f / sqrtf(wave_sum(ss) * (1.0f / D) + EPS);
        if (L < 4) {
            const float* sh = MOD + ((size_t)L * 9 + b) * 6144; const float* sc = sh + 1024;
            v2u* ho = (v2u*)(H + (size_t)row * D) + lane_;
#pragma unroll
            for (int j = 0; j < 4; ++j) { const f32x4 s = *((const f32x4*)sc + 64 * j + lane_), t = *((const f32x4*)sh + 64 * j + lane_);
                const f32x4 h = v[j] * rstd * (s + 1.0f) + t; v2u w; w.x = pk2(h.x, h.y); w.y = pk2(h.z, h.w); ho[64 * j] = w; }
        } else {
            f32x4* oo = (f32x4*)(F.out + (size_t)row * D) + lane_;
#pragma unroll
            for (int j = 0; j < 4; ++j) { const f32x4 g = *((const f32x4*)INP(I_FG) + 64 * j + lane_); oo[64 * j] = v[j] * rstd * g; }
        }
    }
}

template <int L>
__device__ __forceinline__ void phase_n2(Frame& F) {
    const int tid_ = opaque_tid(), lane_ = tid_ & 63, wave_ = __builtin_amdgcn_readfirstlane(tid_ >> 6); (void)lane_; (void)wave_;
    const int gw = F.vcu * NWAVES + wave_, NGW = F.G * NWAVES;
    constexpr int nrows = (L >= 3) ? RL : RT;
    LAS float* RW = (LAS float*)F.lds;
    { const float* router = INP(I_ROUTER) + (size_t)L * 1024 * 16;
      for (int i = tid_; i < 16384; i += 512) { const int k = i >> 4, e = i & 15; RW[e * 1024 + k] = router[i]; } }
    __syncthreads();
    const float* XS = WSP(float, WS_XS); bf16* H = WSP(bf16, WS_H); float* AFF = WSP(float, WS_AFF); const float* MOD = WSP(float, WS_MOD);
    const int lane = lane_;
    for (int row = gw; row < nrows; row += NGW) {
        const int b = row < RL ? (row >> 12) : 8;
        const f32x4* xr = (const f32x4*)(XS + (size_t)row * D) + lane;
        f32x4 v[4];
#pragma unroll
        for (int j = 0; j < 4; ++j) v[j] = xr[64 * j];
        float ss = 0.f;
#pragma unroll
        for (int j = 0; j < 4; ++j) ss += (v[j].x * v[j].x + v[j].y * v[j].y) + (v[j].z * v[j].z + v[j].w * v[j].w);
        const float rstd = 1.0f / sqrtf(wave_sum(ss) * (1.0f / D) + EPS);
        const float* sh = MOD + ((size_t)L * 9 + b) * 6144 + 3072; const float* sc = sh + 1024;
        v2u* ho = (v2u*)(H + (size_t)row * D) + lane;
#pragma unroll
        for (int j = 0; j < 4; ++j) { const f32x4 s = *((const f32x4*)sc + 64 * j + lane), t = *((const f32x4*)sh + 64 * j + lane);
            v[j] = v[j] * rstd * (s + 1.0f) + t; v2u w; w.x = pk2(v[j].x, v[j].y); w.y = pk2(v[j].z, v[j].w); ho[64 * j] = w; }
        float p[16];
#pragma unroll
        for (int e = 0; e < 16; ++e) { float s = 0.f;
#pragma unroll
            for (int j = 0; j < 4; ++j) { const f32x4 w = *(const LAS f32x4*)(RW + e * 1024 + 256 * j + 4 * lane); s += (v[j].x * w.x + v[j].y * w.y) + (v[j].z * w.z + v[j].w * w.w); }
            p[e] = s; __builtin_amdgcn_sched_barrier(0); }
#pragma unroll
        for (int i = 0; i < 8; ++i) { const bool hi = (lane & 32) != 0; const float send = hi ? p[i] : p[i + 8], keep = hi ? p[i + 8] : p[i]; p[i] = keep + __shfl_xor(send, 32); }
#pragma unroll
        for (int i = 0; i < 4; ++i) { const bool hi = (lane & 16) != 0; const float send = hi ? p[i] : p[i + 4], keep = hi ? p[i + 4] : p[i]; p[i] = keep + __shfl_xor(send, 16); }
#pragma unroll
        for (int i = 0; i < 2; ++i) { const bool hi = (lane & 8) != 0; const float send = hi ? p[i] : p[i + 2], keep = hi ? p[i + 2] : p[i]; p[i] = keep + __shfl_xor(send, 8); }
        { const bool hi = (lane & 4) != 0; const float send = hi ? p[0] : p[1], keep = hi ? p[1] : p[0]; p[0] = keep + __shfl_xor(send, 4); }
        float lg = p[0]; lg += __shfl_xor(lg, 1); lg += __shfl_xor(lg, 2);
        float mx = lg;
#pragma unroll
        for (int o = 4; o < 64; o <<= 1) mx = fmaxf(mx, __shfl_xor(mx, o));
        const float ex = __expf(lg - mx); float sm = ex;
#pragma unroll
        for (int o = 4; o < 64; o <<= 1) sm += __shfl_xor(sm, o);
        if ((lane & 3) == 0) { const int e = ((lane >> 5) & 1) * 8 + ((lane >> 4) & 1) * 4 + ((lane >> 3) & 1) * 2 + ((lane >> 2) & 1); AFF[(size_t)row * 16 + e] = ex / sm; }
    }
    __syncthreads();
}

__device__ __forceinline__ unsigned block_excl_scan(unsigned v, LAS unsigned* tmp, int tid, unsigned& total) {
    const int lane = tid & 63, w = tid >> 6; unsigned inc = v;
#pragma unroll
    for (int o = 1; o < 64; o <<= 1) { const unsigned t = __shfl_up(inc, o); if (lane >= o) inc += t; }
    if (lane == 63) tmp[w] = inc;
    __syncthreads();
    unsigned pre = 0, tot = 0;
#pragma unroll
    for (int i = 0; i < 8; ++i) { const unsigned t = tmp[i]; if (i < w) pre += t; tot += t; }
    __syncthreads();
    total = tot; return pre + inc - v;
}
template <int NPT>
__device__ __forceinline__ void topk_problem(Frame& F, const float* aff  , int n, int k, int row0  , int e, int ybase) {
    const int tid_ = opaque_tid(), lane_ = tid_ & 63, wave_ = __builtin_amdgcn_readfirstlane(tid_ >> 6); (void)lane_; (void)wave_;
    LAS unsigned* hist = (LAS unsigned*)F.lds;
    LAS unsigned* sel = hist + 256;
    LAS unsigned* tmp = hist + 272;
    const int tid = tid_;
    unsigned key[NPT];
#pragma unroll
    for (int i = 0; i < NPT; ++i) { const int t = tid * NPT + i; key[i] = (t < n) ? __builtin_bit_cast(unsigned, aff[(size_t)t * 16]) : 0u; }
    unsigned prefix = 0, kk = (unsigned)k;
#pragma unroll
    for (int pass = 0; pass < 4; ++pass) {
        const int shift = 24 - 8 * pass;
        if (tid < 256) hist[tid] = 0u;
        __syncthreads();
#pragma unroll
        for (int i = 0; i < NPT; ++i) { const int t = tid * NPT + i; const bool in = (t < n) && (pass == 0 || (key[i] >> (shift + 8)) == prefix); if (in) __hip_atomic_fetch_add(&hist[(key[i] >> shift) & 255u], 1u, __ATOMIC_RELAXED, __HIP_MEMORY_SCOPE_WORKGROUP); }
        __syncthreads();
        if (tid < 64) {
            unsigned c[4]; unsigned s = 0;
#pragma unroll
            for (int q = 0; q < 4; ++q) { c[q] = hist[255 - 4 * tid - q]; s += c[q]; }
            unsigned inc = s;
#pragma unroll
            for (int o = 1; o < 64; o <<= 1) { const unsigned t = __shfl_up(inc, o); if (tid >= o) inc += t; }
            const unsigned long long m = __ballot(inc >= kk);
            const int first = __ffsll((long long)m) - 1;
            if (tid == first) { unsigned before = inc - s; int q = 0; for (; q < 3; ++q) { if (before + c[q] >= kk) break; before += c[q]; }
                sel[0] = (unsigned)(255 - 4 * tid - q); sel[1] = kk - before; }
        }
        __syncthreads();
        prefix = (prefix << 8) | sel[0]; kk = sel[1];
        __syncthreads();
    }
    const unsigned T = prefix, need_eq = kk;
    unsigned cg = 0, ce = 0;
#pragma unroll
    for (int i = 0; i < NPT; ++i) { const int t = tid * NPT + i; if (t < n) { cg += key[i] > T; ce += key[i] == T; } }
    unsigned total; const unsigned pre = block_excl_scan((ce << 16) | cg, tmp, tid, total);
    unsigned gb = pre & 0xffffu, eb = pre >> 16;
    int* INV = WSP(int, WS_INV); int* IDX = WSP(int, WS_IDX); float* GATE = WSP(float, WS_GATE);
#pragma unroll
    for (int i = 0; i < NPT; ++i) { const int t = tid * NPT + i; if (t < n) {
        const bool g = key[i] > T, q = key[i] == T; const bool s = g || (q && eb < need_eq);
        const int slot = (int)(gb + (eb < need_eq ? eb : need_eq));
        const int row = row0 + t;
        if (s) { IDX[ybase + slot] = row; GATE[ybase + slot] = __builtin_bit_cast(float, key[i]); }
        INV[(size_t)row * 16 + e] = s ? (ybase + slot) : -1;
        gb += g; eb += q; } }
    __syncthreads();
}
template <int L>
__device__ __forceinline__ void phase_topk(Frame& F) {
    constexpr int nprob = (L >= 3) ? 128 : 256;
    const float* AFF = WSP(float, WS_AFF);
    for (int p = (int)blockIdx.x; p < nprob; p += F.G) {
        if (p < 128) { const int b = p >> 4, e = p & 15; topk_problem<8>(F, AFF + (size_t)b * SEQ * 16 + e, SEQ, SEQ / 8, b * SEQ, e, p * 512); }
        else { const int q = p - 128, e = q >> 3, b = q & 7; topk_problem<1>(F, AFF + (size_t)(RL + b * CTX) * 16 + e, CTX, CTX / 8, RL + b * CTX, e, NYL + e * 256 + b * 32); }
    }
}

__device__ __forceinline__ void seq_pos(int row, int& pos, int& len) { if (row < RL) { pos = row & (SEQ - 1); len = SEQ; } else { pos = (row - RL) & (CTX - 1); len = CTX; } }
__device__ __forceinline__ void phase_pool(Frame& F) {
    const int tid_ = opaque_tid(), lane_ = tid_ & 63, wave_ = __builtin_amdgcn_readfirstlane(tid_ >> 6); (void)lane_; (void)wave_;
    const bf16* H = WSP(bf16, WS_H); bf16* P = WSP(bf16, SC_P);
    for (int idx = (int)blockIdx.x * 512 + tid_; idx < RT * 128; idx += F.G * 512) {
        const int row = idx >> 7, c8 = idx & 127, g = c8 >> 5, half = 1 << g;
        int pos, len; seq_pos(row, pos, len);
        const int lo = max(pos - half, 0), hi = min(pos + half, len);
        float s[8];
#pragma unroll
        for (int q = 0; q < 8; ++q) s[q] = 0.f;
        for (int p = lo; p < hi; ++p) { const v4u w = *(const v4u*)(H + (size_t)(row + p - pos) * D + c8 * 8);
            s[0] += bflo(w.x); s[1] += bfhi(w.x); s[2] += bflo(w.y); s[3] += bfhi(w.y); s[4] += bflo(w.z); s[5] += bfhi(w.z); s[6] += bflo(w.w); s[7] += bfhi(w.w); }
        const float inv = 1.0f / (float)(hi - lo);
        const v4u c = *(const v4u*)(H + (size_t)row * D + c8 * 8);
        v4u o; o.x = pk2(s[0] * inv - bflo(c.x), s[1] * inv - bfhi(c.x)); o.y = pk2(s[2] * inv - bflo(c.y), s[3] * inv - bfhi(c.y));
        o.z = pk2(s[4] * inv - bflo(c.z), s[5] * inv - bfhi(c.z)); o.w = pk2(s[6] * inv - bflo(c.w), s[7] * inv - bfhi(c.w));
        *(v4u*)(P + (size_t)row * D + c8 * 8) = o;
    }
}
__device__ __forceinline__ void phase_conv(Frame& F) {
    const int tid_ = opaque_tid(), lane_ = tid_ & 63, wave_ = __builtin_amdgcn_readfirstlane(tid_ >> 6); (void)lane_; (void)wave_;
    const bf16* ZX = WSP(bf16, SC_ZX); bf16* XR = WSP(bf16, SC_XR); const float* cw = INP(I_CONVW); const float* cb = INP(I_CONVB);
    for (int idx = (int)blockIdx.x * 512 + tid_; idx < RT * 128; idx += F.G * 512) {
        const int row = idx >> 7, c8 = idx & 127;
        int pos, len; seq_pos(row, pos, len);
        float s[8];
        { const f32x4 b0 = *(const f32x4*)(cb + c8 * 8), b1 = *(const f32x4*)(cb + c8 * 8 + 4); s[0] = b0.x; s[1] = b0.y; s[2] = b0.z; s[3] = b0.w; s[4] = b1.x; s[5] = b1.y; s[6] = b1.z; s[7] = b1.w; }
#pragma unroll
        for (int k = 0; k < 4; ++k) { const int p = pos + k - 2; if (p >= 0 && p < len) {
            const v4u w = *(const v4u*)(ZX + (size_t)(row + k - 2) * D + c8 * 8);
            const f32x4 w0 = *(const f32x4*)(cw + k * 1024 + c8 * 8), w1 = *(const f32x4*)(cw + k * 1024 + c8 * 8 + 4);
            s[0] += bflo(w.x) * w0.x; s[1] += bfhi(w.x) * w0.y; s[2] += bflo(w.y) * w0.z; s[3] += bfhi(w.y) * w0.w;
            s[4] += bflo(w.z) * w1.x; s[5] += bfhi(w.z) * w1.y; s[6] += bflo(w.w) * w1.z; s[7] += bfhi(w.w) * w1.w; } }
        v4u o; o.x = pk2(s[0], s[1]); o.y = pk2(s[2], s[3]); o.z = pk2(s[4], s[5]); o.w = pk2(s[6], s[7]);
        *(v4u*)(XR + (size_t)row * D + c8 * 8) = o;
    }
}
__device__ __forceinline__ int scan_chunk(int d, int b, int s) { return d == 0 ? (s < 4 ? 512 + b * 4 + s : b * 64 + (s - 4)) : (s < 4 ? 512 + b * 4 + (3 - s) : b * 64 + (63 - (s - 4))); }
__device__ __forceinline__ void phase_carry(Frame& F) {
    const int tid_ = opaque_tid(), lane_ = tid_ & 63, wave_ = __builtin_amdgcn_readfirstlane(tid_ >> 6); (void)lane_; (void)wave_;
    const f32x2* AGG = WSP(f32x2, WS_AGG); float* CARRY = WSP(float, WS_CARRY);
    for (int gid = (int)blockIdx.x * 512 + tid_; gid < 2 * 8 * 1024; gid += F.G * 512) {
        const int d = gid >> 13, b = (gid >> 10) & 7, ch = gid & 1023;
        float st = 0.f;
#pragma unroll 4
        for (int s = 0; s < 68; ++s) { const int c = scan_chunk(d, b, s); const size_t o = ((size_t)d * 544 + c) * 1024 + ch;
            const f32x2 ah = AGG[o]; CARRY[o] = st; st = ah.x * st + ah.y; }
    }
}
__device__ __forceinline__ void phase_lruc(Frame& F) {
    const int tid_ = opaque_tid(), lane_ = tid_ & 63, wave_ = __builtin_amdgcn_readfirstlane(tid_ >> 6); (void)lane_; (void)wave_;
    const bf16 *HL0 = WSP(bf16, SC_HL0), *HL1 = WSP(bf16, SC_HL1), *AC0 = WSP(bf16, SC_AC0), *AC1 = WSP(bf16, SC_AC1), *YG = WSP(bf16, SC_YG); bf16* G = WSP(bf16, SC_G);
    const float* CARRY = WSP(float, WS_CARRY);
    for (int idx = (int)blockIdx.x * 512 + tid_; idx < RT * 128; idx += F.G * 512) {
        const int row = idx >> 7, c8 = idx & 127, chunk = row >> 6; const size_t o = (size_t)row * D + c8 * 8;
        const v4u h0 = *(const v4u*)(HL0 + o), h1 = *(const v4u*)(HL1 + o), a0 = *(const v4u*)(AC0 + o), a1 = *(const v4u*)(AC1 + o), y = *(const v4u*)(YG + o);
        const float* c0 = CARRY + ((size_t)chunk) * 1024 + c8 * 8; const float* c1 = CARRY + ((size_t)544 + chunk) * 1024 + c8 * 8;
        const f32x4 p0 = *(const f32x4*)c0, p1 = *(const f32x4*)(c0 + 4), q0 = *(const f32x4*)c1, q1 = *(const f32x4*)(c1 + 4);
        float r[8];
        r[0] = (bflo(h0.x) + bflo(a0.x) * p0.x + bflo(h1.x) + bflo(a1.x) * q0.x) * bflo(y.x); r[1] = (bfhi(h0.x) + bfhi(a0.x) * p0.y + bfhi(h1.x) + bfhi(a1.x) * q0.y) * bfhi(y.x);
        r[2] = (bflo(h0.y) + bflo(a0.y) * p0.z + bflo(h1.y) + bflo(a1.y) * q0.z) * bflo(y.y); r[3] = (bfhi(h0.y) + bfhi(a0.y) * p0.w + bfhi(h1.y) + bfhi(a1.y) * q0.w) * bfhi(y.y);
        r[4] = (bflo(h0.z) + bflo(a0.z) * p1.x + bflo(h1.z) + bflo(a1.z) * q1.x) * bflo(y.z); r[5] = (bfhi(h0.z) + bfhi(a0.z) * p1.y + bfhi(h1.z) + bfhi(a1.z) * q1.y) * bfhi(y.z);
        r[6] = (bflo(h0.w) + bflo(a0.w) * p1.z + bflo(h1.w) + bflo(a1.w) * q1.z) * bflo(y.w); r[7] = (bfhi(h0.w) + bfhi(a0.w) * p1.w + bfhi(h1.w) + bfhi(a1.w) * q1.w) * bfhi(y.w);
        v4u w; w.x = pk2(r[0], r[1]); w.y = pk2(r[2], r[3]); w.z = pk2(r[4], r[5]); w.w = pk2(r[6], r[7]);
        *(v4u*)(G + o) = w;
    }
}

using pg8::Unit;
struct SchedMN {
    int nM, nN, G, c, ash; const char* A; const char* B; size_t a_tile, a_pn, b_tile;
    __device__ __forceinline__ bool next(int i, Unit& u) const {
        int pm, pn; if (!pg8::static_order(i, G, c, nM, nN, pm, pn)) return false;
        u.pm = pm; u.pn = pn; u.rows = nullptr; u.A = A + (size_t)pm * a_tile + (size_t)(pn >> ash) * a_pn; u.B = B + (size_t)pn * b_tile; return true;
    }
};
__device__ __forceinline__ int moe_expert(int t) { return t < 256 ? ((t >> 1) & 15) : (t - 256); }
struct SchedMoeUp {
    int G, c, nct; const char* Hb; const char* W; const int* IDX;
    __device__ __forceinline__ bool next(int i, Unit& u) const {
        int t, pn;
        if (G == 256) {
            const int x = c & 7, j = c >> 3;
            if (i < 8) { const int e = 2 * x + (i >> 2), a = (i & 3) * 4 + (j >> 3); pn = j & 7; t = ((a >> 1) * 16 + e) * 2 + (a & 1); }
            else if (i == 8 && c < nct) { t = 256 + (c >> 3); pn = c & 7; }
            else return false;
        } else { const int L = i * G + c; const int tot = 2048 + nct; if (L >= tot) return false; t = L >> 3; pn = L & 7; }
        u.pm = t; u.pn = pn; u.rows = IDX + t * 256; u.A = Hb; u.B = W + ((size_t)moe_expert(t) * 2048 + (size_t)pn * 256) * 2048; return true;
    }
};
struct SchedMoeDown {
    int G, c, ntile; const char* ACT; const char* W;
    __device__ __forceinline__ bool next(int i, Unit& u) const {
        int pm, pn; if (!pg8::static_order(i, G, c, ntile, 4, pm, pn)) return false;
        u.pm = pm; u.pn = pn; u.rows = nullptr; u.A = ACT + (size_t)pm * 256 * 2048; u.B = W + ((size_t)moe_expert(pm) * 1024 + (size_t)pn * 256) * 2048; return true;
    }
};

using f32x4_t = f32x4;
typedef const f32x4 (&AccRef)[2][2][4][2];
template <bool LAYER0, bool SCALE>
struct EpiRes {
    float* XS; const float* x_in; const float* ctx_in; const float* g1base  ; const float* scale;
    __device__ __forceinline__ void operator()(AccRef acc, const Unit& u, int wr, int wc, int fr, int fq) const {
        asm volatile("" : "+v"(fr), "+v"(fq));
        const int b = u.pm < 128 ? (u.pm >> 4) : 8; const float* g1 = g1base + (size_t)b * 6144;
        const int col0 = u.pn * 256 + wc * 32 + 4 * fq;
        f32x4 gv[2][2];
#pragma unroll
        for (int bj = 0; bj < 2; ++bj)
#pragma unroll
            for (int n = 0; n < 2; ++n) { gv[bj][n] = *(const f32x4*)(g1 + col0 + bj * 128 + n * 16); if (SCALE) gv[bj][n] = gv[bj][n] * *(const f32x4*)(scale + col0 + bj * 128 + n * 16); }
#pragma unroll
        for (int ai = 0; ai < 2; ++ai)
#pragma unroll
            for (int m = 0; m < 4; ++m) {
                const int row = u.pm * 256 + ai * 128 + wr * 64 + m * 16 + fr;
                const float* src = LAYER0 ? (row < RL ? x_in + (size_t)row * D : ctx_in + (size_t)(row - RL) * D) : XS + (size_t)row * D;
                float* dst = XS + (size_t)row * D;
#pragma unroll
                for (int bj = 0; bj < 2; ++bj)
#pragma unroll
                    for (int n = 0; n < 2; ++n) { const int c = col0 + bj * 128 + n * 16; const f32x4 xv = *(const f32x4*)(src + c); *(f32x4*)(dst + c) = xv + gv[bj][n] * acc[ai][bj][m][n]; }
                __builtin_amdgcn_sched_barrier(0);
            }
    }
};
__device__ __forceinline__ v4u pack8(const f32x4& v0, const f32x4& v1) { v4u w; w.x = pk2(v0.x, v0.y); w.y = pk2(v0.z, v0.w); w.z = pk2(v1.x, v1.y); w.w = pk2(v1.z, v1.w); return w; }
struct EpiLruIn {
    bf16* YG; bf16* ZX;
    __device__ __forceinline__ void operator()(AccRef acc, const Unit& u, int wr, int wc, int fr, int fq) const {
        asm volatile("" : "+v"(fr), "+v"(fq));
        const bool isy = u.pn < 4; bf16* base = isy ? YG + u.pn * 256 : ZX + (u.pn - 4) * 256;
#pragma unroll
        for (int ai = 0; ai < 2; ++ai)
#pragma unroll
            for (int m = 0; m < 4; ++m) { const int row = u.pm * 256 + ai * 128 + wr * 64 + m * 16 + fr;
#pragma unroll
                for (int bj = 0; bj < 2; ++bj) { f32x4 v0 = acc[ai][bj][m][0], v1 = acc[ai][bj][m][1];
                    if (isy) {
#pragma unroll
                        for (int e = 0; e < 4; ++e) { v0[e] = gelu_tanh(v0[e]); v1[e] = gelu_tanh(v1[e]); } }
                    *(v4u*)(base + (size_t)row * D + bj * 128 + wc * 32 + 8 * fq) = pack8(v0, v1); } }
    }
};
struct EpiGates {
    const bf16* XR; bf16 *HL0, *HL1, *AC0, *AC1; f32x2* AGG; const float *ba, *bx, *lam;
    __device__ __forceinline__ void operator()(AccRef acc, const Unit& u, int wr, int wc, int fr, int fq) const {
        asm volatile("" : "+v"(fr), "+v"(fq));
        body<0>(acc, u, wr, wc, fr, fq); body<1>(acc, u, wr, wc, fr, fq);
    }
    template <int n>
    __device__ __forceinline__ void body(AccRef acc, const Unit& u, int wr, int wc, int fr, int fq) const {
        asm volatile("" : "+v"(fr), "+v"(fq));
        const int h = u.pn >> 1, d = u.pn & 1;
        bf16* HL = d ? HL1 : HL0; bf16* AC = d ? AC1 : AC0;
        {
            const int chb = h * 128 + wc * 32 + n * 16 + 4 * fq;
            const f32x4 bav = *(const f32x4*)(ba + d * 1024 + chb), bxv = *(const f32x4*)(bx + d * 1024 + chb), lmv = *(const f32x4*)(lam + d * 1024 + chb);
            float sp[4];
#pragma unroll
            for (int e = 0; e < 4; ++e) sp[e] = log1pf(__expf(-lmv[e]));
#pragma unroll
            for (int ai = 0; ai < 2; ++ai) {
                float av[4][4], uv[4][4];
#pragma unroll
                for (int m = 0; m < 4; ++m) { const int row = u.pm * 256 + ai * 128 + wr * 64 + m * 16 + fr;
                    const v2u xw = *(const v2u*)(XR + (size_t)row * D + chb);
                    const float xr[4] = {bflo(xw.x), bfhi(xw.x), bflo(xw.y), bfhi(xw.y)};
#pragma unroll
                    for (int e = 0; e < 4; ++e) { const float r = sigmoid_f(acc[ai][0][m][n][e] + bav[e]), ig = sigmoid_f(acc[ai][1][m][n][e] + bxv[e]);
                        const float la = -8.0f * r * sp[e]; const float a = __expf(la); const float mult = sqrtf(-expm1f(2.0f * la));
                        av[m][e] = a; uv[m][e] = xr[e] * ig * mult; } __builtin_amdgcn_sched_barrier(0); }
                float Ac[4], Hc[4];
#pragma unroll
                for (int e = 0; e < 4; ++e) { Ac[e] = 1.f; Hc[e] = 0.f; }
#pragma unroll
                for (int mm = 0; mm < 4; ++mm) { const int m = d ? 3 - mm : mm;
#pragma unroll
                    for (int e = 0; e < 4; ++e) {
                        float a = d ? av[3 - mm][e] : av[mm][e], hh = d ? uv[3 - mm][e] : uv[mm][e];
#pragma unroll
                        for (int dl = 1; dl < 16; dl <<= 1) {
                            const float ao = d ? __shfl_down(a, dl, 16) : __shfl_up(a, dl, 16), ho = d ? __shfl_down(hh, dl, 16) : __shfl_up(hh, dl, 16);
                            const bool valid = d ? (fr + dl < 16) : (fr >= dl);
                            if (valid) { hh = a * ho + hh; a = a * ao; } }
                        const float fa = __shfl(a, d ? 0 : 15, 16), fh = __shfl(hh, d ? 0 : 15, 16);
                        const float hl = hh + a * Hc[e], ac = a * Ac[e];
                        Hc[e] = fa * Hc[e] + fh; Ac[e] = fa * Ac[e];
                        if (d) { av[3 - mm][e] = ac; uv[3 - mm][e] = hl; } else { av[mm][e] = ac; uv[mm][e] = hl; }
                        __builtin_amdgcn_sched_barrier(0);
                    }
                    (void)m; }
#pragma unroll
                for (int m = 0; m < 4; ++m) { const int row = u.pm * 256 + ai * 128 + wr * 64 + m * 16 + fr;
                    v2u w; w.x = pk2(uv[m][0], uv[m][1]); w.y = pk2(uv[m][2], uv[m][3]); *(v2u*)(HL + (size_t)row * D + chb) = w;
                    v2u q; q.x = pk2(av[m][0], av[m][1]); q.y = pk2(av[m][2], av[m][3]); *(v2u*)(AC + (size_t)row * D + chb) = q; }
                if (fr == 0) { const int chunk = u.pm * 4 + ai * 2 + wr; f32x2* ag = AGG + ((size_t)d * 544 + chunk) * 1024 + chb;
#pragma unroll
                    for (int e = 0; e < 4; ++e) ag[e] = (f32x2){Ac[e], Hc[e]}; }
            }
        }
    }
};
struct EpiQKV {
    bf16 *Q, *KA, *VA; const float *qg, *kg; const f32x2* rope;
    __device__ __forceinline__ void operator()(AccRef acc, const Unit& u, int wr, int wc, int fr, int fq) const {
        asm volatile("" : "+v"(fr), "+v"(fq));
        const int kind = u.pn < 4 ? 0 : (u.pn == 4 ? 1 : 2);
        const float* gp = kind == 0 ? qg : kg;
        f32x4 g[2][2];
#pragma unroll
        for (int bj = 0; bj < 2; ++bj)
#pragma unroll
            for (int n = 0; n < 2; ++n) g[bj][n] = (kind == 2) ? (f32x4){1.f, 1.f, 1.f, 1.f} : *(const f32x4*)(gp + bj * 32 + 8 * fq + 4 * n);
        const float post = kind == 0 ? attn_body::C2 : 1.0f;
#pragma unroll
        for (int ai = 0; ai < 2; ++ai)
#pragma unroll
            for (int m = 0; m < 4; ++m) {
                const int row = u.pm * 256 + ai * 128 + wr * 64 + m * 16 + fr;
                const bool lat = row < RL; const int bb = lat ? (row >> 12) : ((row - RL) >> 8), nn = lat ? (row & (SEQ - 1)) : ((row - RL) & (CTX - 1));
                f32x4 v[2][2];
#pragma unroll
                for (int bj = 0; bj < 2; ++bj)
#pragma unroll
                    for (int n = 0; n < 2; ++n) v[bj][n] = acc[ai][bj][m][n];
                if (kind != 2) {
                    float ss = 0.f;
#pragma unroll
                    for (int bj = 0; bj < 2; ++bj)
#pragma unroll
                        for (int n = 0; n < 2; ++n) ss += (v[bj][n].x * v[bj][n].x + v[bj][n].y * v[bj][n].y) + (v[bj][n].z * v[bj][n].z + v[bj][n].w * v[bj][n].w);
                    ss += __shfl_xor(ss, 16); ss += __shfl_xor(ss, 32);
                    const float rstd = 1.0f / sqrtf(ss * (1.0f / 64.0f) + EPS);
#pragma unroll
                    for (int bj = 0; bj < 2; ++bj)
#pragma unroll
                        for (int n = 0; n < 2; ++n) v[bj][n] = v[bj][n] * rstd * g[bj][n];
                    if (lat) {
#pragma unroll
                        for (int bj = 0; bj < 2; ++bj) { const int pos = bj ? (nn & 63) : (nn >> 6);
#pragma unroll
                            for (int n = 0; n < 2; ++n) { const f32x2 cs0 = rope[pos * 16 + 4 * fq + 2 * n], cs1 = rope[pos * 16 + 4 * fq + 2 * n + 1];
                                const f32x4 t = v[bj][n];
                                v[bj][n].x = t.x * cs0.x - t.y * cs0.y; v[bj][n].y = t.x * cs0.y + t.y * cs0.x;
                                v[bj][n].z = t.z * cs1.x - t.w * cs1.y; v[bj][n].w = t.z * cs1.y + t.w * cs1.x; } }
                    }
                }
                if (kind == 0) {
                    bf16* dst = Q + (size_t)row * D + (u.pn * 4 + wc) * 64 + 8 * fq;
#pragma unroll
                    for (int bj = 0; bj < 2; ++bj) *(v4u*)(dst + bj * 32) = pack8(v[bj][0] * post, v[bj][1] * post);
                } else {
                    const size_t krow = (size_t)bb * KVLEN + (lat ? CTX + nn : nn);
                    bf16* dst = (kind == 1 ? KA : VA) + krow * 256 + wc * 64 + 8 * fq;
#pragma unroll
                    for (int bj = 0; bj < 2; ++bj) *(v4u*)(dst + bj * 32) = pack8(v[bj][0], v[bj][1]);
                }
                __builtin_amdgcn_sched_barrier(0);
            }
    }
};
struct EpiGmlpIn {
    bf16 *U, *V; f32x2* PSUM;
    __device__ __forceinline__ void operator()(AccRef acc, const Unit& u, int wr, int wc, int fr, int fq) const {
        asm volatile("" : "+v"(fr), "+v"(fq));
        const bool isu = u.pn < 12; bf16* base = isu ? U + u.pn * 256 : V + (u.pn - 12) * 256;
#pragma unroll
        for (int ai = 0; ai < 2; ++ai)
#pragma unroll
            for (int m = 0; m < 4; ++m) { const int row = u.pm * 256 + ai * 128 + wr * 64 + m * 16 + fr; float s1 = 0.f, s2 = 0.f;
#pragma unroll
                for (int bj = 0; bj < 2; ++bj) { f32x4 v0 = acc[ai][bj][m][0], v1 = acc[ai][bj][m][1];
#pragma unroll
                    for (int e = 0; e < 4; ++e) { v0[e] = gelu_tanh(v0[e]); v1[e] = gelu_tanh(v1[e]); s1 += v0[e] + v1[e]; s2 += v0[e] * v0[e] + v1[e] * v1[e]; }
                    *(v4u*)(base + (size_t)row * 3072 + bj * 128 + wc * 32 + 8 * fq) = pack8(v0, v1); }
                if (!isu) { s1 += __shfl_xor(s1, 16); s1 += __shfl_xor(s1, 32); s2 += __shfl_xor(s2, 16); s2 += __shfl_xor(s2, 32);
                    if (fq == 0) PSUM[(size_t)row * 48 + (u.pn - 12) * 4 + wc] = (f32x2){s1, s2}; } }
    }
};
struct EpiMoeUp {
    bf16* ACT;
    __device__ __forceinline__ void operator()(AccRef acc, const Unit& u, int wr, int wc, int fr, int fq) const {
        asm volatile("" : "+v"(fr), "+v"(fq));
#pragma unroll
        for (int ai = 0; ai < 2; ++ai)
#pragma unroll
            for (int m = 0; m < 4; ++m) { const size_t yrow = (size_t)u.pm * 256 + ai * 128 + wr * 64 + m * 16 + fr;
                f32x4 o[2];
#pragma unroll
                for (int n = 0; n < 2; ++n)
#pragma unroll
                    for (int e = 0; e < 4; ++e) { const float gt = acc[ai][0][m][n][e], up = acc[ai][1][m][n][e]; o[n][e] = gt * sigmoid_f(gt) * up; }
                *(v4u*)(ACT + yrow * D + u.pn * 128 + wc * 32 + 8 * fq) = pack8(o[0], o[1]); }
    }
};
struct EpiMoeDown {
    bf16* Y; const float* GATE;
    __device__ __forceinline__ void operator()(AccRef acc, const Unit& u, int wr, int wc, int fr, int fq) const {
        asm volatile("" : "+v"(fr), "+v"(fq));
#pragma unroll
        for (int ai = 0; ai < 2; ++ai)
#pragma unroll
            for (int m = 0; m < 4; ++m) { const size_t yrow = (size_t)u.pm * 256 + ai * 128 + wr * 64 + m * 16 + fr; const float gt = GATE[yrow];
#pragma unroll
                for (int bj = 0; bj < 2; ++bj) *(v4u*)(Y + yrow * D + u.pn * 256 + bj * 128 + wc * 32 + 8 * fq) = pack8(acc[ai][bj][m][0] * gt, acc[ai][bj][m][1] * gt); }
    }
};

__device__ __forceinline__ void phase_spatial(Frame& F) {
    const int tid_ = opaque_tid(), lane_ = tid_ & 63, wave_ = __builtin_amdgcn_readfirstlane(tid_ >> 6); (void)lane_; (void)wave_;
    constexpr int WLS = 136;
    LAS bf16* WL = (LAS bf16*)F.lds;
    LAS bf16* BT = (LAS bf16*)(F.lds + 128 * WLS * 2);
    LAS float* ST = (LAS float*)(F.lds + 128 * WLS * 2 + 2 * 64 * WLS * 2);
    const int tid = tid_, lane = lane_, wave = wave_, fr = lane & 15, fq = lane >> 4;
    bf16* U = WSP(bf16, SC_U); const bf16* V = WSP(bf16, SC_V); const f32x2* PSUM = WSP(f32x2, SC_PSUM);
    const bf16* WS = WSP(bf16, WS_GS); const float* lng = INP(I_LNG); const float* lnb = INP(I_LNB); const float* bs = INP(I_BS);
    for (int unit = (int)blockIdx.x; unit < 8 * 32 * 4; unit += F.G) {
        const int g = unit & 3, ck = unit >> 2;
        const size_t row0 = (size_t)ck * 128;
        __syncthreads();
        { const int q = tid >> 2, part = tid & 3; float s1 = 0.f, s2 = 0.f;
#pragma unroll
          for (int i = 0; i < 12; ++i) { const f32x2 p = PSUM[(row0 + q) * 48 + part * 12 + i]; s1 += p.x; s2 += p.y; }
          s1 += __shfl_xor(s1, 1); s1 += __shfl_xor(s1, 2); s2 += __shfl_xor(s2, 1); s2 += __shfl_xor(s2, 2);
          const float mean = s1 * (1.0f / 3072.0f); const float var = fmaxf(s2 * (1.0f / 3072.0f) - mean * mean, 0.f);
          if (part == 0) { ST[2 * q] = mean; ST[2 * q + 1] = 1.0f / sqrtf(var + EPS); } }
        for (int i = tid; i < 128 * 16; i += 512) { const int p = i >> 4, c = i & 15; *(LAS v4u*)(WL + p * WLS + c * 8) = *(const v4u*)(WS + (size_t)g * 16384 + p * 128 + c * 8); }
        __syncthreads();
        const float bsp = bs[g * 128 + wave * 16 + fr];
        for (int s = 0; s < 12; ++s) {
            const int f0 = g * 768 + s * 64;
            LAS bf16* bt = BT + (s & 1) * 64 * WLS;
#pragma unroll
            for (int pass = 0; pass < 2; ++pass) { const int q = (tid >> 3) + 64 * pass, f8 = (tid & 7) * 8;
                const v4u w = *(const v4u*)(V + (row0 + q) * 3072 + f0 + f8);
                const float mean = ST[2 * q], rstd = ST[2 * q + 1];
                const f32x4 g0 = *(const f32x4*)(lng + f0 + f8), g1 = *(const f32x4*)(lng + f0 + f8 + 4), b0 = *(const f32x4*)(lnb + f0 + f8), b1 = *(const f32x4*)(lnb + f0 + f8 + 4);
                float x[8] = {bflo(w.x), bfhi(w.x), bflo(w.y), bfhi(w.y), bflo(w.z), bfhi(w.z), bflo(w.w), bfhi(w.w)};
                const float gg[8] = {g0.x, g0.y, g0.z, g0.w, g1.x, g1.y, g1.z, g1.w}, bb[8] = {b0.x, b0.y, b0.z, b0.w, b1.x, b1.y, b1.z, b1.w};
#pragma unroll
                for (int i = 0; i < 8; ++i) bt[(f8 + i) * WLS + q] = (bf16)f2bf((x[i] - mean) * rstd * gg[i] + bb[i]); }
            __syncthreads();
            f32x4 acc[4];
#pragma unroll
            for (int nf = 0; nf < 4; ++nf) acc[nf] = (f32x4){0.f, 0.f, 0.f, 0.f};
#pragma unroll
            for (int ks = 0; ks < 4; ++ks) {
                const bf16x8 wfrag = *(const LAS bf16x8*)(WL + (wave * 16 + fr) * WLS + ks * 32 + fq * 8);
#pragma unroll
                for (int nf = 0; nf < 4; ++nf) { const bf16x8 vfrag = *(const LAS bf16x8*)(bt + (nf * 16 + fr) * WLS + ks * 32 + fq * 8);
                    acc[nf] = __builtin_amdgcn_mfma_f32_16x16x32_bf16(vfrag, wfrag, acc[nf], 0, 0, 0); }
            }
            bf16* urow = U + (row0 + wave * 16 + fr) * 3072 + f0 + 4 * fq;
#pragma unroll
            for (int nf = 0; nf < 4; ++nf) { const v2u uw = *(const v2u*)(urow + nf * 16);
                v2u o; o.x = pk2(bflo(uw.x) * (acc[nf].x + bsp), bfhi(uw.x) * (acc[nf].y + bsp)); o.y = pk2(bflo(uw.y) * (acc[nf].z + bsp), bfhi(uw.y) * (acc[nf].w + bsp));
                *(v2u*)(urow + nf * 16) = o; }
        }
    }
    __syncthreads();
}

__device__ __forceinline__ void phase_attn(Frame& F, char* lds) {
    const attn_body::bf16* Q = (const attn_body::bf16*)WSP(bf16, SC_Q); const attn_body::bf16* KA = (const attn_body::bf16*)WSP(bf16, SC_KA); const attn_body::bf16* VA = (const attn_body::bf16*)WSP(bf16, SC_VA);
    attn_body::bf16* O = (attn_body::bf16*)WSP(bf16, SC_Q);
    for (int un = F.vcu; un < 2048 + 128; un += F.G) {
        int b, h, NT; size_t qrow;
        if (un < 2048) { const int bh = un >> 4, qb = un & 15; b = bh >> 4; h = bh & 15; qrow = (size_t)b * SEQ + qb * 256; NT = KVLEN / 64; }
        else { const int q = un - 2048; b = q >> 4; h = q & 15; qrow = (size_t)RL + b * CTX; NT = CTX / 64; }
        const size_t kvoff = (size_t)b * KVLEN * 256 + (h >> 2) * 64;
        attn_body::attn_unit<8>(Q + qrow * D + h * 64, KA + kvoff, VA + kvoff, O + qrow * D + h * 64, NT, lds);
    }
}

struct Args { const float* in[N_IN]; float* out; unsigned char* ws; int ph_lo, ph_hi; };
constexpr int N_PHASES = 36;
__global__ void __launch_bounds__(NWAVES * 64, 2) hyb_fwd(Args args) {
    extern __shared__ __attribute__((aligned(16))) unsigned char lds[];
    Frame F;
    F.lds = (LAS unsigned char*)lds;
    F.MISC = (volatile LAS unsigned*)(F.lds + MISC_OFF);
    F.G = gridDim.x; { const int bx = blockIdx.x; F.vcu = (F.G % 8 == 0) ? (bx % 8) * (F.G / 8) + bx / 8 : bx; }
    F.in = args.in; F.ws = args.ws; F.out = args.out; F.ctl = (gu32*)(args.ws + WS_CTL);
    for (int u = threadIdx.x; u < (LDS_BYTES - LDSCTL_OFF) / 4; u += NWAVES * 64) ((LAS unsigned*)(F.lds + LDSCTL_OFF))[u] = 0u;
    __syncthreads();
    XcdBarrier bar; bar.bar = (unsigned*)(F.ctl + CW_BAR); bar.x = 0; bar.st = nullptr;
    const int lo = args.ph_lo, hi = args.ph_hi;
    if (hi - lo > 1) bar = xcd_barrier_post((unsigned*)(F.ctl + CW_BAR), F.MISC + 8);
#ifndef PH_LO
#define PH_LO 0
#define PH_HI 99
#endif
#define IN(k) ((k) >= PH_LO && (k) <= PH_HI && lo <= (k) && (k) < hi)
#define SEAM(k) do { if (IN(k) && IN((k) + 1)) xcd_barrier(bar); } while (0)
    LAS unsigned char* ring = F.lds;
    const int cblk = (int)blockIdx.x;
    float* XS = WSP(float, WS_XS); const float* MOD = WSP(float, WS_MOD);
    const char* Hb = (const char*)WSP(bf16, WS_H);

#define MOE_PHASES(L, base) \
    if (IN(base)) { phase_n2<L>(F); } SEAM(base); \
    if (IN((base) + 1)) { phase_topk<L>(F); } SEAM((base) + 1); \
    if (IN((base) + 2)) { SchedMoeUp S{F.G, cblk, (L) >= 3 ? 0 : 128, Hb, (const char*)WSP(bf16, WS_WGU), WSP(int, WS_IDX)}; EpiMoeUp E{WSP(bf16, SC_ACT)}; \
        pg8::gemm_phase<EpiMoeUp, SchedMoeUp, 1, true>(ring, 1024, 2048, 2048, S, E); } SEAM((base) + 2); \
    if (IN((base) + 3)) { SchedMoeDown S{F.G, cblk, (L) >= 3 ? 256 : 272, (const char*)WSP(bf16, SC_ACT), (const char*)WSP(bf16, WS_WD)}; EpiMoeDown E{WSP(bf16, SC_Y), WSP(float, WS_GATE)}; \
        pg8::gemm_phase<EpiMoeDown, SchedMoeDown, 1, false>(ring, 1024, 2048, 2048, S, E); } SEAM((base) + 3);

    if (IN(0)) { phase_prologue(F); } SEAM(0);
    if (IN(1)) { phase_n1<0>(F); } SEAM(1);
    if (IN(2)) { phase_pool(F); } SEAM(2);
    if (IN(3)) { SchedMN S{136, 4, F.G, cblk, 0, (const char*)WSP(bf16, SC_P), (const char*)WSP(bf16, WS_PW), (size_t)256 * 2048, 512, (size_t)65536 * 2};
        EpiRes<true, true> E{XS, INP(I_X), INP(I_CTX), MOD + 0 * 9 * 6144 + 2048, INP(I_POOLS)};
        pg8::gemm_phase<EpiRes<true, true>, SchedMN, 0, false>(ring, 256, 2048, 512, S, E); } SEAM(3);
    MOE_PHASES(0, 4)
    if (IN(8)) { phase_n1<1>(F); convert_moe(F, 1); } SEAM(8);
    if (IN(9)) { SchedMN S{136, 8, F.G, cblk, 0, Hb, (const char*)WSP(bf16, WS_LIN), (size_t)256 * 2048, 0, (size_t)256 * 2048};
        EpiLruIn E{WSP(bf16, SC_YG), WSP(bf16, SC_ZX)};
        pg8::gemm_phase<EpiLruIn, SchedMN, 1, false>(ring, 1024, 2048, 2048, S, E); } SEAM(9);
    if (IN(10)) { phase_conv(F); } SEAM(10);
    if (IN(11)) { SchedMN S{136, 16, F.G, cblk, 1, (const char*)WSP(bf16, SC_XR), (const char*)WSP(bf16, WS_LG), (size_t)256 * 2048, 256, (size_t)256 * 256};
        EpiGates E{WSP(bf16, SC_XR), WSP(bf16, SC_HL0), WSP(bf16, SC_HL1), WSP(bf16, SC_AC0), WSP(bf16, SC_AC1), WSP(f32x2, WS_AGG), INP(I_BA), INP(I_BX), INP(I_LAM)};
        pg8::gemm_phase<EpiGates, SchedMN, 0, false>(ring, 128, 2048, 256, S, E); } SEAM(11);
    if (IN(12)) { phase_carry(F); } SEAM(12);
    if (IN(13)) { phase_lruc(F); } SEAM(13);
    if (IN(14)) { SchedMN S{136, 4, F.G, cblk, 0, (const char*)WSP(bf16, SC_G), (const char*)WSP(bf16, WS_LOUT), (size_t)256 * 2048, 0, (size_t)256 * 2048};
        EpiRes<false, false> E{XS, nullptr, nullptr, MOD + 1 * 9 * 6144 + 2048, nullptr};
        pg8::gemm_phase<EpiRes<false, false>, SchedMN, 0, false>(ring, 1024, 2048, 2048, S, E); } SEAM(14);
    MOE_PHASES(1, 15)
    if (IN(19)) { phase_n1<2>(F); convert_moe(F, 2); } SEAM(19);
    if (IN(20)) { SchedMN S{136, 6, F.G, cblk, 0, Hb, (const char*)WSP(bf16, WS_QKV), (size_t)256 * 2048, 0, (size_t)256 * 2048};
        EpiQKV E{WSP(bf16, SC_Q), WSP(bf16, SC_KA), WSP(bf16, SC_VA), INP(I_QG), INP(I_KG), WSP(f32x2, WS_ROPE)};
        pg8::gemm_phase<EpiQKV, SchedMN, 2, false>(ring, 1024, 2048, 2048, S, E); } SEAM(20);
    if (IN(21)) { phase_attn(F, (char*)lds); } SEAM(21);
    if (IN(22)) { SchedMN S{136, 4, F.G, cblk, 0, (const char*)WSP(bf16, SC_Q), (const char*)WSP(bf16, WS_WO), (size_t)256 * 2048, 0, (size_t)256 * 2048};
        EpiRes<false, false> E{XS, nullptr, nullptr, MOD + 2 * 9 * 6144 + 2048, nullptr};
        pg8::gemm_phase<EpiRes<false, false>, SchedMN, 0, false>(ring, 1024, 2048, 2048, S, E); } SEAM(22);
    MOE_PHASES(2, 23)
    if (IN(27)) { phase_n1<3>(F); convert_moe(F, 3); } SEAM(27);
    if (IN(28)) { SchedMN S{128, 24, F.G, cblk, 0, Hb, (const char*)WSP(bf16, WS_GIN), (size_t)256 * 2048, 0, (size_t)256 * 2048};
        EpiGmlpIn E{WSP(bf16, SC_U), WSP(bf16, SC_V), WSP(f32x2, SC_PSUM)};
        pg8::gemm_phase<EpiGmlpIn, SchedMN, 1, false>(ring, 1024, 2048, 2048, S, E); } SEAM(28);
    if (IN(29)) { phase_spatial(F); } SEAM(29);
    if (IN(30)) { SchedMN S{128, 4, F.G, cblk, 0, (const char*)WSP(bf16, SC_U), (const char*)WSP(bf16, WS_GOUT), (size_t)256 * 6144, 0, (size_t)256 * 6144};
        EpiRes<false, false> E{XS, nullptr, nullptr, MOD + 3 * 9 * 6144 + 2048, nullptr};
        pg8::gemm_phase<EpiRes<false, false>, SchedMN, 0, false>(ring, 3072, 6144, 6144, S, E); } SEAM(30);
    MOE_PHASES(3, 31)
    if (IN(35)) { phase_n1<4>(F); }
#undef IN
#undef SEAM
#undef MOE_PHASES
}

extern "C" void kernel_launch(void* const* d_in, const int* in_sizes, int n_in, void* d_out, int out_size, void* d_ws, size_t ws_size, hipStream_t stream) {
    static int grid = 0;
    if (grid == 0) {
        if (n_in != N_IN || out_size != RL * D || ws_size < WS_END) { fprintf(stderr, "kernel_launch: unexpected shapes (n_in %d out %d ws %zu need %zu)\n", n_in, out_size, ws_size, (size_t)WS_END); grid = -1; return; }
        int dev = 0, cus = 0, per_cu = 0;
        if (hipGetDevice(&dev) != hipSuccess || hipDeviceGetAttribute(&cus, hipDeviceAttributeMultiprocessorCount, dev) != hipSuccess) { grid = -1; return; }
        if (hipFuncSetAttribute((const void*)hyb_fwd, hipFuncAttributeMaxDynamicSharedMemorySize, LDS_BYTES) != hipSuccess) { fprintf(stderr, "kernel_launch: hipFuncSetAttribute failed\n"); grid = -1; return; }
        if (hipOccupancyMaxActiveBlocksPerMultiprocessor(&per_cu, (const void*)hyb_fwd, NWAVES * 64, LDS_BYTES) != hipSuccess || per_cu < 1) { fprintf(stderr, "kernel_launch: occupancy query reports %d\n", per_cu); }
        (void)hipGetLastError();
        grid = cus;
    }
    if (grid < 0) return;
    (void)hipMemsetAsync((char*)d_ws + WS_CTL, 0, CTL_ZERO_BYTES, stream);
    Args a{};
    for (int i = 0; i < N_IN; ++i) a.in[i] = (const float*)d_in[i];
    a.out = (float*)d_out; a.ws = (unsigned char*)d_ws;
#if MK_PER_PHASE
    for (int p = 0; p < N_PHASES; ++p) { a.ph_lo = p; a.ph_hi = p + 1; hipLaunchKernelGGL(hyb_fwd, dim3(grid), dim3(NWAVES * 64), LDS_BYTES, stream, a); }
#else
    a.ph_lo = 0; a.ph_hi = N_PHASES;
    hipLaunchKernelGGL(hyb_fwd, dim3(grid), dim3(NWAVES * 64), LDS_BYTES, stream, a);
#endif
    const hipError_t le = hipPeekAtLastError();
    if (le != hipSuccess) fprintf(stderr, "kernel_launch: launch failed: %s\n", hipGetErrorName(le));
}
```

```cpp
#include <hip/hip_runtime.h>
#include <hip/hip_bf16.h>
#include <cstdio>
#include <cstdint>
#include <cmath>

#ifndef MK_PER_PHASE
#define MK_PER_PHASE 0
#endif

#define GAS __attribute__((address_space(1)))
#define LAS __attribute__((address_space(3)))
typedef unsigned short bf16;
typedef unsigned v4u __attribute__((ext_vector_type(4)));
typedef unsigned v2u __attribute__((ext_vector_type(2)));
typedef float f32x4 __attribute__((ext_vector_type(4)));
typedef float f32x2 __attribute__((ext_vector_type(2)));
typedef short bf16x8 __attribute__((ext_vector_type(8)));
typedef GAS unsigned gu32;
#define RLX_AGENT __ATOMIC_RELAXED, __HIP_MEMORY_SCOPE_AGENT
#define LDS_WAIT() asm volatile("s_waitcnt lgkmcnt(0)" ::: "memory")
#define VM_WAIT() asm volatile("s_waitcnt vmcnt(0)" ::: "memory")

constexpr int D = 1024, NB = 8, SEQ = 4096, CTX = 256;
constexpr int RL = NB * SEQ, RC = NB * CTX, RT = RL + RC;
constexpr int KVLEN = CTX + SEQ;
constexpr int NYL = 65536, NYC = 4096, NY = NYL + NYC;
constexpr float EPS = 1e-6f;
constexpr int NWAVES = 8;

constexpr size_t MiB = 1u << 20;
constexpr size_t WS_CTL = 0, CTL_ZERO_BYTES = 1 * MiB;
constexpr size_t WS_MOD = 1 * MiB;
constexpr size_t WS_ROPE = WS_MOD + 900 * 1024;
constexpr size_t WS_PW = 2 * MiB;
constexpr size_t WS_LIN = WS_PW + 512 * 1024;
constexpr size_t WS_LG = WS_LIN + 4 * MiB;
constexpr size_t WS_LOUT = WS_LG + 1 * MiB;
constexpr size_t WS_QKV = WS_LOUT + 2 * MiB;
constexpr size_t WS_WO = WS_QKV + 3 * MiB;
constexpr size_t WS_GIN = WS_WO + 2 * MiB;
constexpr size_t WS_GS = WS_GIN + 12 * MiB;
constexpr size_t WS_GOUT = WS_GS + 128 * 1024;
constexpr size_t WS_WGU = 34 * MiB;
constexpr size_t WS_WD = WS_WGU + 64 * MiB;
constexpr size_t WS_XS = 130 * MiB;
constexpr size_t WS_H = 266 * MiB;
constexpr size_t WS_AFF = 334 * MiB;
constexpr size_t WS_INV = WS_AFF + (size_t)RT * 16 * 4;
constexpr size_t WS_IDX = WS_INV + (size_t)RT * 16 * 4;
constexpr size_t WS_GATE = WS_IDX + (size_t)NY * 4;
constexpr size_t WS_AGG = 340 * MiB;
constexpr size_t WS_CARRY = WS_AGG + (size_t)2 * 544 * 1024 * 8;
constexpr size_t WS_SCR = 354 * MiB;
static_assert(WS_GOUT + 6 * MiB <= WS_WGU && WS_GATE + (size_t)NY * 4 <= WS_AGG && WS_CARRY + (size_t)2 * 544 * 1024 * 4 <= WS_SCR, "ws map");
constexpr size_t SC_ACT = WS_SCR, SC_Y = WS_SCR + 136 * MiB;
constexpr size_t SC_P = WS_SCR;
constexpr size_t SC_YG = WS_SCR, SC_ZX = WS_SCR + 68 * MiB, SC_XR = WS_SCR + 136 * MiB;
constexpr size_t SC_HL0 = WS_SCR + 204 * MiB, SC_HL1 = WS_SCR + 272 * MiB, SC_AC0 = WS_SCR + 340 * MiB, SC_AC1 = WS_SCR + 408 * MiB;
constexpr size_t SC_G = SC_ZX;
constexpr size_t SC_Q = WS_SCR, SC_KA = WS_SCR + 68 * MiB, SC_VA = WS_SCR + 85 * MiB;
constexpr size_t SC_U = WS_SCR, SC_V = WS_SCR + 192 * MiB, SC_PSUM = WS_SCR + 384 * MiB;
constexpr size_t WS_END = WS_SCR + 476 * MiB;
constexpr int CW_BAR = 4096;

constexpr int RING_BYTES = 131072;
constexpr int LDSCTL_OFF = RING_BYTES, MISC_OFF = LDSCTL_OFF + 320;
constexpr int LDS_BYTES = 147456;

__device__ __forceinline__ unsigned f2bf(float f) { unsigned u = __builtin_bit_cast(unsigned, f); return (u + 0x7fffu + ((u >> 16) & 1u)) >> 16; }
__device__ __forceinline__ unsigned pk2(float lo, float hi) { return f2bf(lo) | (f2bf(hi) << 16); }
__device__ __forceinline__ float bflo(unsigned w) { return __builtin_bit_cast(float, w << 16); }
__device__ __forceinline__ float bfhi(unsigned w) { return __builtin_bit_cast(float, w & 0xffff0000u); }
__device__ __forceinline__ int opaque_tid() { int t = threadIdx.x; asm volatile("" : "+v"(t)); return t; }
__device__ __forceinline__ float wave_sum(float v) {
#pragma unroll
    for (int o = 1; o < 64; o <<= 1) v += __shfl_xor(v, o);
    return v;
}
__device__ __forceinline__ float gelu_tanh(float x) {
    const float t = x * (1.0f + 0.044715f * x * x);
    return x * __builtin_amdgcn_rcpf(1.0f + __builtin_amdgcn_exp2f(-2.3022082f * t));
}
__device__ __forceinline__ float sigmoid_f(float x) { return __builtin_amdgcn_rcpf(1.0f + __builtin_amdgcn_exp2f(-1.4426950409f * x)); }

#define XB_TMO      128
#define XB_XCNT(j)  (256  + 64 * (j))
#define XB_XSUB(j)  (1280 + 64 * (j))
#define XB_XGEN(j)  (2304 + 64 * (j))
#define XB_TOP      3328
#define XB_TOPGEN   3392
#define XCD_BAR_WORDS 3456
#define XB_SPIN_CAP (1u << 18)
__device__ __forceinline__ unsigned xb_ld(unsigned* p)              { return __hip_atomic_load(p, __ATOMIC_RELAXED, __HIP_MEMORY_SCOPE_AGENT); }
__device__ __forceinline__ unsigned xb_add(unsigned* p, unsigned v) { return __hip_atomic_fetch_add(p, v, __ATOMIC_RELAXED, __HIP_MEMORY_SCOPE_AGENT); }
__device__ __forceinline__ unsigned xb_xcc_id() { return (unsigned)__builtin_amdgcn_s_getreg((3 << 11) | 20) & 0xFu; }
#define XB_SPIN(cond, bar) do { unsigned _sp = 0; while (cond) { __builtin_amdgcn_s_sleep(1); \
    if ((++_sp & 255u) == 0u) { if (xb_ld(&(bar)[XB_TMO])) break; if (_sp > XB_SPIN_CAP) { atomicAdd(&(bar)[XB_TMO], 1u); break; } } } } while (0)
struct XcdBarrier { unsigned* bar; unsigned x; volatile LAS unsigned* st; };
__device__ __forceinline__ XcdBarrier xcd_barrier_post(unsigned* bar, volatile LAS unsigned* st) {
    XcdBarrier b; b.bar = bar; b.x = xb_xcc_id(); b.st = st;
    if (threadIdx.x == 0) (void)xb_add(&bar[XB_XCNT(b.x)], 1u);
    return b;
}
__device__ __forceinline__ void xcd_barrier_complete(unsigned* bar, unsigned x, unsigned& nloc, unsigned& nx) {
    const unsigned G = gridDim.x * gridDim.y * gridDim.z;
    unsigned sum, cnt, mine, sp = 0u;
    for (;;) {
        sum = 0u; cnt = 0u; mine = 0u;
#pragma unroll
        for (unsigned j = 0; j < 16; ++j) { const unsigned c = xb_ld(&bar[XB_XCNT(j)]); sum += c; cnt += (c > 0u) ? 1u : 0u; mine = (j == x) ? c : mine; }
        if (sum == G) break;
        __builtin_amdgcn_s_sleep(1);
        if ((++sp & 255u) == 0u) { if (xb_ld(&bar[XB_TMO])) break; if (sp > XB_SPIN_CAP) { atomicAdd(&bar[XB_TMO], 1u); break; } }
    }
    nloc = mine > 0u ? mine : 1u; nx = cnt > 0u ? cnt : 1u;
}
__device__ __forceinline__ void xcd_barrier(const XcdBarrier& b) {
    asm volatile("s_waitcnt vmcnt(0)" ::: "memory");
    __syncthreads();
    if (threadIdx.x == 0) {
        unsigned* bar = b.bar;
        __builtin_amdgcn_s_waitcnt(0);
        unsigned nloc = b.st[0], nx = b.st[1];
        if (nloc == 0u) { xcd_barrier_complete(bar, b.x, nloc, nx); b.st[0] = nloc; b.st[1] = nx; }
        const unsigned old = xb_add(&bar[XB_XSUB(b.x)], 1u);
        const unsigned gen = old / nloc;
        if (old + 1u == (gen + 1u) * nloc) {
            __builtin_amdgcn_fence(__ATOMIC_RELEASE, "agent");
            asm volatile("s_waitcnt vmcnt(0)" ::: "memory");
            const unsigned og = xb_add(&bar[XB_TOP], 1u);
            const unsigned tg = og / nx;
            if (og + 1u == (tg + 1u) * nx) xb_add(&bar[XB_TOPGEN], 1u);
            else XB_SPIN(xb_ld(&bar[XB_TOPGEN]) == tg, bar);
            __builtin_amdgcn_fence(__ATOMIC_ACQUIRE, "agent");
            xb_add(&bar[XB_XGEN(b.x)], 1u);
            asm volatile("s_waitcnt vmcnt(0)" ::: "memory");
        } else {
            XB_SPIN(xb_ld(&bar[XB_XGEN(b.x)]) == gen, bar);
            __builtin_amdgcn_fence(__ATOMIC_ACQUIRE, "agent");
            asm volatile("s_waitcnt vmcnt(0)" ::: "memory");
        }
    }
    __syncthreads();
}

namespace pg8 {
constexpr int BM = 256, BK = 64, HALF = 128, HTB = HALF * BK * 2, STAGE_BYTES = 8 * HTB, NXCD = 8, WGM = 8;
__host__ __device__ __forceinline__ int lds_byte(int r, int c) { const int st = (r >> 4) * 2 + (c >> 5), rr = r & 15, cc = c & 31, ob = rr * 64 + cc * 2; return st * 1024 + (ob ^ (((ob >> 9) & 1) << 5)); }
__host__ __device__ __forceinline__ void stage_rc(int b, int& R, int& C) { const int st = b / 1024, sb = b % 1024, swz = sb ^ (((sb >> 9) & 1) << 5); R = (st >> 1) * 16 + swz / 64; C = (st & 1) * 32 + (swz % 64) / 2; }
__host__ __device__ __forceinline__ int perm32(int rho) { const int n = rho >> 4, i = rho & 15; return 8 * (i >> 2) + 4 * n + (i & 3); }

struct Unit { const char* A; const char* B; const int* rows; int pm, pn; };

__device__ __forceinline__ bool static_order(int i, int G, int c, int nM, int nN, int& pm, int& pn) {
    const int nwg = nM * nN; const long L = (long)i * G + c; if (L >= nwg) return false;
    int wgid = (int)L; { const int q = nwg / NXCD, r = nwg % NXCD, xcd = wgid % NXCD, off = wgid / NXCD; wgid = (xcd < r ? xcd * (q + 1) : r * (q + 1) + (xcd - r) * q) + off; }
    const int nig = WGM * nN, gid = wgid / nig, fm = gid * WGM, gsz = (nM - fm) < WGM ? (nM - fm) : WGM;
    pm = fm + ((wgid % nig) % gsz); pn = (wgid % nig) / gsz; return true;
}

template <class Epi, class Sched, int PERM, bool GATHER>
__device__ __forceinline__ void gemm_phase(LAS unsigned char* lds, const int K, const int lda  , const int ldb  , const Sched& S, const Epi& E) {
    const int tid = opaque_tid(), wid = __builtin_amdgcn_readfirstlane(tid >> 6), lane = tid & 63, wr = wid >> 2, wc = wid & 3, fr = lane & 15, fq = lane >> 4;
    int nt = K / BK; asm volatile("" : "+s"(nt));
    int Rs[2], Cs[2]; unsigned voffB[2];
#pragma unroll
    for (int i = 0; i < 2; ++i) { int R, C; stage_rc(tid * 16 + i * 8192, R, C); Rs[i] = R; Cs[i] = C;
        const int Rb = (PERM == 0) ? R : (PERM == 1) ? ((R & ~31) + perm32(R & 31)) : (64 * (R >> 5) + perm32(R & 31));
        voffB[i] = (unsigned)(Rb * ldb + C * 2); }
    const unsigned hstepB = (unsigned)((PERM == 2 ? 32 : 128) * ldb);
    const size_t kstep = (size_t)(BK * 2);
    const unsigned ldsw = (unsigned)wid * 1024u;
    const int aoff = lds_byte(wr * 64 + fr, fq * 8), boff = lds_byte(wc * 32 + fr, fq * 8);
#define PG8_SA(b, h) (((b) * 2 + (h)) * HTB)
#define PG8_SB(b, h) ((4 + (b) * 2 + (h)) * HTB)
#define PG8_STAGE2(bufoff, gbase, o0, o1) do { \
        __builtin_amdgcn_global_load_lds((const unsigned*)((const char*)(gbase) + (o0)), (LAS unsigned*)(lds + (bufoff) + ldsw), 16, 0, 0); \
        __builtin_amdgcn_global_load_lds((const unsigned*)((const char*)(gbase) + (o1)), (LAS unsigned*)(lds + (bufoff) + ldsw + 8192), 16, 0, 0); } while (0)
#define PG8_STAGEB(bufoff, gbase, h) PG8_STAGE2(bufoff, gbase, voffB[0] + (h) * hstepB, voffB[1] + (h) * hstepB)
#define PG8_LDA(dst, b, h) do { _Pragma("unroll") for (int m = 0; m < 4; ++m) _Pragma("unroll") for (int k = 0; k < 2; ++k) dst[m][k] = *(const LAS bf16x8*)(lds + PG8_SA(b, h) + aoff + m * 2048 + k * 1024); } while (0)
#define PG8_LDB(dst, b, h) do { _Pragma("unroll") for (int n = 0; n < 2; ++n) _Pragma("unroll") for (int k = 0; k < 2; ++k) dst[n][k] = *(const LAS bf16x8*)(lds + PG8_SB(b, h) + boff + n * 2048 + k * 1024); } while (0)
#define PG8_MMA(ai, bj, At, Bt) do { __builtin_amdgcn_s_setprio(1); _Pragma("unroll") for (int m = 0; m < 4; ++m) _Pragma("unroll") for (int n = 0; n < 2; ++n) _Pragma("unroll") for (int k = 0; k < 2; ++k) \
        acc[ai][bj][m][n] = __builtin_amdgcn_mfma_f32_16x16x32_bf16(Bt[n][k], At[m][k], acc[ai][bj][m][n], 0, 0, 0); __builtin_amdgcn_s_setprio(0); } while (0)
#define PG8_WAIT_V(n) asm volatile("s_waitcnt vmcnt(" #n ")" ::: "memory")
#define PG8_WAIT_L(n) asm volatile("s_waitcnt lgkmcnt(" #n ")" ::: "memory")
#define PG8_BAR __builtin_amdgcn_s_barrier()
#define PG8_SCHED __builtin_amdgcn_sched_barrier(0)
#define PG8_AOFFS(dst, u) do { _Pragma("unroll") for (int h = 0; h < 2; ++h) _Pragma("unroll") for (int i = 0; i < 2; ++i) { \
        if (GATHER) dst[h * 2 + i] = (unsigned)((u).rows[h * 128 + Rs[i]]) * (unsigned)lda + (unsigned)(Cs[i] * 2); \
        else dst[h * 2 + i] = (unsigned)((h * 128 + Rs[i]) * lda + Cs[i] * 2); } } while (0)
    Unit cur, nxt; int ui = 0;
    if (!S.next(0, cur)) return;
    f32x4 acc[2][2][4][2];
#pragma unroll
    for (int a = 0; a < 2; ++a)
#pragma unroll
        for (int b = 0; b < 2; ++b)
#pragma unroll
            for (int m = 0; m < 4; ++m)
#pragma unroll
                for (int n = 0; n < 2; ++n) acc[a][b][m][n] = (f32x4){0.f, 0.f, 0.f, 0.f};
    bf16x8 At[4][2], B0[2][2], B1[2][2];
    const char* cA = cur.A; const char* cB = cur.B;
    unsigned cO[4], nO[4];
    PG8_AOFFS(cO, cur);
    PG8_STAGEB(PG8_SB(0, 0), cB, 0); PG8_STAGEB(PG8_SB(0, 1), cB, 1); PG8_STAGE2(PG8_SA(0, 0), cA, cO[0], cO[1]); PG8_STAGE2(PG8_SA(0, 1), cA, cO[2], cO[3]);
    if (wr == 1) PG8_BAR;
    PG8_WAIT_V(2); PG8_BAR;
    PG8_STAGEB(PG8_SB(1, 0), cB + kstep, 0); PG8_STAGE2(PG8_SA(1, 0), cA + kstep, cO[0], cO[1]); PG8_STAGEB(PG8_SB(1, 1), cB + kstep, 1);
    PG8_WAIT_V(6); PG8_BAR;
    for (;;) {
        const bool has_next = S.next(ui + 1, nxt);
        const char* nA = has_next ? nxt.A : cA; const char* nB = has_next ? nxt.B : cB;
        if (GATHER) { if (has_next) { PG8_AOFFS(nO, nxt); } else {
#pragma unroll
            for (int q = 0; q < 4; ++q) nO[q] = cO[q]; } }
#pragma unroll 1
        for (int t = 0; t < nt; t += 2) {
            const bool last = (t == nt - 2);
            const char* a1 = cA + (size_t)(t + 1) * kstep;
            const char* a2 = last ? nA : cA + (size_t)(t + 2) * kstep; const char* b2 = last ? nB : cB + (size_t)(t + 2) * kstep;
            const char* a3 = a2 + kstep; const char* b3 = b2 + kstep;
            unsigned x0, x1, x2, x3;
            if (GATHER) { x0 = last ? nO[0] : cO[0]; x1 = last ? nO[1] : cO[1]; x2 = last ? nO[2] : cO[2]; x3 = last ? nO[3] : cO[3]; }
            else { x0 = cO[0]; x1 = cO[1]; x2 = cO[2]; x3 = cO[3]; }
            PG8_LDB(B0, 0, 0); PG8_LDB(B1, 0, 1); PG8_SCHED; PG8_LDA(At, 0, 0); PG8_STAGE2(PG8_SA(1, 1), a1, cO[2], cO[3]);
            PG8_WAIT_V(8); PG8_WAIT_L(0); PG8_BAR; PG8_MMA(0, 0, At, B0); PG8_MMA(0, 1, At, B1); PG8_BAR; PG8_SCHED;
            PG8_LDA(At, 0, 1); PG8_STAGEB(PG8_SB(0, 0), b2, 0); PG8_STAGEB(PG8_SB(0, 1), b2, 1); PG8_STAGE2(PG8_SA(0, 0), a2, x0, x1);
            PG8_WAIT_V(8); PG8_WAIT_L(0); PG8_BAR; PG8_MMA(1, 0, At, B0); PG8_MMA(1, 1, At, B1); PG8_BAR; PG8_SCHED;
            PG8_LDB(B0, 1, 0); PG8_LDB(B1, 1, 1); PG8_SCHED; PG8_LDA(At, 1, 0); PG8_STAGE2(PG8_SA(0, 1), a2, x2, x3);
            PG8_WAIT_V(8); PG8_WAIT_L(0); PG8_BAR; PG8_MMA(0, 0, At, B0); PG8_MMA(0, 1, At, B1); PG8_BAR; PG8_SCHED;
            PG8_LDA(At, 1, 1); PG8_STAGEB(PG8_SB(1, 0), b3, 0); PG8_STAGEB(PG8_SB(1, 1), b3, 1); PG8_STAGE2(PG8_SA(1, 0), a3, x0, x1);
            PG8_WAIT_V(8); PG8_WAIT_L(0); PG8_BAR; PG8_MMA(1, 0, At, B0); PG8_MMA(1, 1, At, B1); PG8_BAR; PG8_SCHED;
        }
        if (wr == 0) PG8_BAR;
        { const int tz = opaque_tid(), lz = tz & 63; E(acc, cur, wr, wc, lz & 15, lz >> 4); }
        if (!has_next) break;
#pragma unroll
        for (int a = 0; a < 2; ++a)
#pragma unroll
            for (int b = 0; b < 2; ++b)
#pragma unroll
                for (int m = 0; m < 4; ++m)
#pragma unroll
                    for (int n = 0; n < 2; ++n) acc[a][b][m][n] = (f32x4){0.f, 0.f, 0.f, 0.f};
        cur = nxt; cA = nA; cB = nB; ++ui;
        if (GATHER) {
#pragma unroll
            for (int q = 0; q < 4; ++q) cO[q] = nO[q]; }
        if (wr == 1) PG8_BAR;
    }
    PG8_WAIT_V(0);
    PG8_BAR;
#undef PG8_SA
#undef PG8_SB
#undef PG8_STAGE2
#undef PG8_STAGEB
#undef PG8_LDA
#undef PG8_LDB
#undef PG8_MMA
#undef PG8_WAIT_V
#undef PG8_WAIT_L
#undef PG8_BAR
#undef PG8_SCHED
#undef PG8_AOFFS
}
}

namespace attn_body {
using bf16=__hip_bfloat16;
using bf16x8=__attribute__((ext_vector_type(8)))short;
using s16x4=__attribute__((ext_vector_type(4)))short;
using f32x16=__attribute__((ext_vector_type(16)))float;
using u32x4=__attribute__((ext_vector_type(4)))unsigned;
constexpr int D=64,DMQ=1024,DMK=256;
constexpr int NW=8,QBLK=32,QB=QBLK*NW,KVBLK=64;
__device__ __forceinline__ int crow(int r,int hi){return (r&3)+8*(r>>2)+4*hi;}
#define SBAR() __builtin_amdgcn_sched_barrier(0)
constexpr int NSLOT=3, SLOTB=8192;
constexpr int LDS_K=0, LDS_V=NSLOT*SLOTB, LDS_WS=2*NSLOT*SLOTB, LDS_OST=LDS_WS+NW*64*4, LDS_BYTES=LDS_OST+NW*4096;
constexpr float C2=0.125f*1.4426950408889634f;
__device__ __forceinline__ void glds16(const void*gsrc,unsigned lds_dst){unsigned keep;
  asm volatile("s_mov_b32 %0, m0\n\ts_mov_b32 m0, %2\n\ts_nop 0\n\tglobal_load_lds_dwordx4 %1, off\n\ts_mov_b32 m0, %0":"=&s"(keep):"v"(gsrc),"s"(lds_dst):"memory");}
__device__ __forceinline__ float max3f(float a,float b,float c){float r;asm("v_max3_f32 %0, %1, %2, %3":"=v"(r):"v"(a),"v"(b),"v"(c));return r;}
__device__ __forceinline__ float max2f(float a,float b){float r;asm("v_max_f32_e32 %0, %1, %2":"=v"(r):"v"(a),"v"(b));return r;}
__device__ __forceinline__ float fadd_s(float a,float b){float r;asm("v_add_f32_e32 %0, %1, %2":"=v"(r):"v"(a),"v"(b));return r;}
__device__ __forceinline__ float fsub_s(float a,float b){float r;asm("v_sub_f32_e32 %0, %1, %2":"=v"(r):"v"(a),"v"(b));return r;}
typedef float f32x2_t __attribute__((ext_vector_type(2))); typedef __bf16 bf16x2_t __attribute__((ext_vector_type(2)));
__device__ __forceinline__ unsigned cvtpk_s(float lo,float hi){f32x2_t v={lo,hi};bf16x2_t b=__builtin_convertvector(v,bf16x2_t);return __builtin_bit_cast(unsigned,b);}
#define WAIT_BAR(N) asm volatile("s_waitcnt vmcnt(" #N ") lgkmcnt(0)\n\ts_barrier":::"memory")

__device__ __forceinline__ void qkt(f32x16&p0,f32x16&p1,const char*Kslot,const bf16x8*qr,const f32x16&negm,int r32,int hi){
  const char*kb=Kslot+hi*1024+r32*16;
  #pragma unroll
  for(int d0=0;d0<4;++d0){
    const bf16x8 b0=*reinterpret_cast<const bf16x8*>(kb+d0*2048);
    const bf16x8 b1=*reinterpret_cast<const bf16x8*>(kb+d0*2048+512);
    if(d0==0){p0=__builtin_amdgcn_mfma_f32_32x32x16_bf16(b0,qr[0],negm,0,0,0);p1=__builtin_amdgcn_mfma_f32_32x32x16_bf16(b1,qr[0],negm,0,0,0);}
    else{p0=__builtin_amdgcn_mfma_f32_32x32x16_bf16(b0,qr[d0],p0,0,0,0);p1=__builtin_amdgcn_mfma_f32_32x32x16_bf16(b1,qr[d0],p1,0,0,0);}}
}
typedef __attribute__((address_space(3))) const char* lds_cptr;
typedef short v4i16_t __attribute__((ext_vector_type(4)));
__device__ __forceinline__ void kload8(bf16x8*kf,lds_cptr kp){
  kf[0]=*(const __attribute__((address_space(3))) bf16x8*)(kp);      kf[1]=*(const __attribute__((address_space(3))) bf16x8*)(kp+512);
  kf[2]=*(const __attribute__((address_space(3))) bf16x8*)(kp+2048); kf[3]=*(const __attribute__((address_space(3))) bf16x8*)(kp+2560);
  kf[4]=*(const __attribute__((address_space(3))) bf16x8*)(kp+4096); kf[5]=*(const __attribute__((address_space(3))) bf16x8*)(kp+4608);
  kf[6]=*(const __attribute__((address_space(3))) bf16x8*)(kp+6144); kf[7]=*(const __attribute__((address_space(3))) bf16x8*)(kp+6656);
}
__device__ __forceinline__ void kload2(bf16x8*kf,lds_cptr kp,int j){ kf[2*j]=*(const __attribute__((address_space(3))) bf16x8*)(kp+j*2048); kf[2*j+1]=*(const __attribute__((address_space(3))) bf16x8*)(kp+j*2048+512); }
__device__ __forceinline__ s16x4 vtr(lds_cptr p){ return __builtin_bit_cast(s16x4,__builtin_amdgcn_ds_read_tr16_b64_v4i16((__attribute__((address_space(3))) v4i16_t*)p)); }
__device__ __forceinline__ float rowmax(const f32x16&p0,const f32x16&p1){
  float a=max3f(p0[0],p0[1],p1[0]),b=max3f(p0[2],p0[3],p1[1]);a=max3f(a,p1[2],p1[3]);
  #pragma unroll
  for(int r=4;r<16;r+=4){a=max3f(a,p0[r],p0[r+1]);b=max3f(b,p0[r+2],p0[r+3]);a=max3f(a,p1[r],p1[r+1]);b=max3f(b,p1[r+2],p1[r+3]);}
  const float m=max2f(a,b);
  auto rr=__builtin_amdgcn_permlane32_swap(__float_as_uint(m),__float_as_uint(m),false,false);
  return max2f(__uint_as_float(rr[0]),__uint_as_float(rr[1]));
}
__device__ __forceinline__ void pv(f32x16*o,int vb,bf16x8 pa0,bf16x8 pa1,bf16x8 pa2,bf16x8 pa3){
  #pragma unroll
  for(int d0=0;d0<2;++d0){s16x4 lo[4],hi[4];
    #pragma unroll
    for(int ks=0;ks<4;++ks){
      asm volatile("ds_read_b64_tr_b16 %0,%1 offset:%c2":"=&v"(lo[ks]):"v"(vb),"i"(d0*4096+ks*1024):"memory");
      asm volatile("ds_read_b64_tr_b16 %0,%1 offset:%c2":"=&v"(hi[ks]):"v"(vb),"i"(d0*4096+ks*1024+512):"memory");}
    asm volatile("s_waitcnt lgkmcnt(0)":::"memory");SBAR();
    #define PK(k) (bf16x8){lo[k][0],lo[k][1],lo[k][2],lo[k][3],hi[k][0],hi[k][1],hi[k][2],hi[k][3]}
    o[d0]=__builtin_amdgcn_mfma_f32_32x32x16_bf16(pa0,PK(0),o[d0],0,0,0);
    o[d0]=__builtin_amdgcn_mfma_f32_32x32x16_bf16(pa1,PK(1),o[d0],0,0,0);
    o[d0]=__builtin_amdgcn_mfma_f32_32x32x16_bf16(pa2,PK(2),o[d0],0,0,0);
    o[d0]=__builtin_amdgcn_mfma_f32_32x32x16_bf16(pa3,PK(3),o[d0],0,0,0);
    #undef PK
  }
}

#ifndef ATTN_STORE16
#define ATTN_STORE16(p,v) (*(u32x4*)(p)=(v))
#endif
template<int THRL> __device__ __forceinline__ void attn_unit(const bf16*Qw0,const bf16*__restrict__ Kh,const bf16*__restrict__ Vh,bf16*Ow0,const int NT,char*shm){
  int tid=threadIdx.x; asm volatile("":"+v"(tid)); const int lane=tid&63,r32=lane&31,hi=lane>>5; const int wid=__builtin_amdgcn_readfirstlane(tid>>6);
  const bf16*Qw=Qw0+(long)(wid*QBLK)*DMQ;
  const unsigned lds0=(unsigned)(uintptr_t)shm;
  float*wsf=(float*)(shm+LDS_WS)+wid*64;
  const bf16*ksrc=Kh+(long)lane*DMK+wid*8;
  const bf16*vsrc=Vh+(long)(16*(wid&3)+(lane>>2))*DMK+(wid>>2)*32+(lane&3)*8;
  const unsigned kdst=lds0+LDS_K+wid*1024, vdst=lds0+LDS_V+wid*1024;
  #define DMA_K(t,slot) glds16(ksrc+(long)(t)*KVBLK*DMK,(unsigned)__builtin_amdgcn_readfirstlane(kdst+(slot)))
  #define DMA_V(t,slot) glds16(vsrc+(long)(t)*KVBLK*DMK,(unsigned)__builtin_amdgcn_readfirstlane(vdst+(slot)))
  const int vb0=(int)(lds0+LDS_V)+((lane>>4)&1)*32+(lane&3)*8+(4*hi+((lane&15)>>2))*64;
  const char*Kbase=shm+LDS_K; bf16x8 kf[8];
  const lds_cptr shm3=(lds_cptr)shm; const lds_cptr kp0=shm3+LDS_K+hi*1024+r32*16; const lds_cptr vp0=shm3+LDS_V+((lane>>4)&1)*32+(lane&3)*8+(4*hi+((lane&15)>>2))*64;
  DMA_K(0,0);DMA_V(0,0);DMA_K(1,SLOTB);
  bf16x8 qr[4];
  #pragma unroll
  for(int d0=0;d0<4;++d0)qr[d0]=*reinterpret_cast<const bf16x8*>(&Qw[(long)r32*DMQ+d0*16+hi*8]);
  float mhat=0.f,l_reg=0.f;f32x16 o[2];o[0]=f32x16{};o[1]=f32x16{};f32x16 negm=f32x16{};asm volatile("":"+v"(negm));
  #define CMASK(P0,P1,t) do{}while(0)
  bool resc=false;
  #define START(P0,P1) do{ const float rm=rowmax(P0,P1); resc=false; \
    { const float dl=rm; mhat=fadd_s(mhat,dl); \
      _Pragma("unroll") for(int r=0;r<16;++r){P0[r]=fsub_s(P0[r],dl);P1[r]=fsub_s(P1[r],dl);} \
      _Pragma("unroll") for(int r=0;r<16;++r)negm[r]=-mhat; asm volatile("":"+v"(negm)); } \
    _Pragma("unroll") for(int r=0;r<16;++r)P0[r]=__builtin_amdgcn_exp2f(P0[r]); }while(0)
  #define RESC() do{ if(resc){ asm volatile("s_waitcnt lgkmcnt(0)":::"memory"); \
      _Pragma("unroll") for(int d_=0;d_<2;++d_) _Pragma("unroll") for(int r=0;r<16;++r)o[d_][r]*=wsf[crow(r,hi)]; } }while(0)
  f32x16 pA0,pA1,pB0,pB1;
  int sl_prev=0,sl_cur=0,sl_next=SLOTB;
  #define ROT() do{sl_prev=sl_cur;sl_cur=sl_next;sl_next=(sl_next==(NSLOT-1)*SLOTB)?0:sl_next+SLOTB;}while(0)
  DMA_K(2,2*SLOTB);
  WAIT_BAR(3);
  qkt(pA0,pA1,Kbase,qr,negm,r32,hi);asm volatile("s_nop 15\n\ts_nop 7":"+v"(pA0),"+v"(pA1));CMASK(pA0,pA1,0);
  START(pA0,pA1);
  _Pragma("unroll") for(int r=0;r<16;++r)pA1[r]=__builtin_amdgcn_exp2f(pA1[r]);
  WAIT_BAR(0);
  DMA_K(3,0);DMA_V(1,SLOTB);
  ROT();
  kload8(kf,kp0+sl_cur);
  WAIT_BAR(2);
  s16x4 vlo[8],vhi[8]; u32x4 pw0,pw1,pw2,pw3;
  #define PKW(P,B) cvtpk_s(P[B],P[B+1])
  #define PAF(k) __builtin_bit_cast(bf16x8,pw##k)
  #define VFR(i) (bf16x8){vlo[i][0],vlo[i][1],vlo[i][2],vlo[i][3],vhi[i][0],vhi[i][1],vhi[i][2],vhi[i][3]}
  #define PIN(x) asm volatile("":"+v"(x))
  #define MX3(a,b,c) __builtin_fmaxf(__builtin_fmaxf((a),(b)),(c))
  #define GAPA(MF,A0,A1,A2,A3,W0,W1,PW) do{ MF; sacc+=A0; sacc+=A1; sacc+=A2; sacc+=A3; PIN(sacc); W0; W1; PIN(PW); SBAR(); }while(0)
  #define EX(v) __builtin_amdgcn_exp2f(v)
  #define GAPB(MF,X,B) do{ MF; X[B]=EX(X[B]); X[B+1]=EX(X[B+1]); X[B+2]=EX(X[B+2]); X[B+3]=EX(X[B+3]); PIN(X); SBAR(); }while(0)
  #define VRD(i) do{ vlo[i]=vtr(vp_+(((i)>>2)*4096+((i)&3)*1024)); vhi[i]=vtr(vp_+(((i)>>2)*4096+((i)&3)*1024+512)); }while(0)
  #define KRD(G,j) do{ if(G){ kload2(kf,kp0+sl_next,j); SBAR(); } }while(0)
  #define STEP(C0,C1,P0,P1,t,GK,GV,GL) do{ SBAR(); \
    const lds_cptr vp_=vp0+sl_prev; \
    VRD(0); SBAR(); float sacc=(P0[0]+P0[1]); \
    GAPA(C0=__builtin_amdgcn_mfma_f32_32x32x16_bf16(kf[0],qr[0],negm,0,0,0), P0[2],P0[3],P0[4],P0[5],     pw0[0]=PKW(P0,0), pw0[1]=PKW(P0,2), pw0); \
    VRD(4); SBAR(); GAPA(C1=__builtin_amdgcn_mfma_f32_32x32x16_bf16(kf[1],qr[0],negm,0,0,0), P0[6],P0[7],P0[8],P0[9],     pw0[2]=PKW(P0,4), pw0[3]=PKW(P0,6), pw0); \
    VRD(1); SBAR(); GAPA(C0=__builtin_amdgcn_mfma_f32_32x32x16_bf16(kf[2],qr[1],C0,0,0,0),   P0[10],P0[11],P0[12],P0[13], pw1[0]=PKW(P0,8), pw1[1]=PKW(P0,10), pw1); \
    VRD(5); SBAR(); GAPA(C1=__builtin_amdgcn_mfma_f32_32x32x16_bf16(kf[3],qr[1],C1,0,0,0),   P0[14],P0[15],P1[0],P1[1],   pw1[2]=PKW(P0,12),pw1[3]=PKW(P0,14), pw1); \
    VRD(2); SBAR(); GAPA(C0=__builtin_amdgcn_mfma_f32_32x32x16_bf16(kf[4],qr[2],C0,0,0,0),   P1[2],P1[3],P1[4],P1[5],     pw2[0]=PKW(P1,0), pw2[1]=PKW(P1,2), pw2); \
    VRD(6); SBAR(); GAPA(C1=__builtin_amdgcn_mfma_f32_32x32x16_bf16(kf[5],qr[2],C1,0,0,0),   P1[6],P1[7],P1[8],P1[9],     pw2[2]=PKW(P1,4), pw2[3]=PKW(P1,6), pw2); \
    VRD(3); SBAR(); GAPA(C0=__builtin_amdgcn_mfma_f32_32x32x16_bf16(kf[6],qr[3],C0,0,0,0),   P1[10],P1[11],P1[12],P1[13], pw3[0]=PKW(P1,8), pw3[1]=PKW(P1,10), pw3); \
    VRD(7); SBAR(); GAPA(C1=__builtin_amdgcn_mfma_f32_32x32x16_bf16(kf[7],qr[3],C1,0,0,0),   P1[14],P1[15],0.f,0.f,       pw3[2]=PKW(P1,12),pw3[3]=PKW(P1,14), pw3); \
    l_reg+=sacc; \
    if(GK){DMA_K((t)+3,sl_cur);} if(GV){DMA_V((t)+1,sl_next);} \
    CMASK(C0,C1,t); \
    { float a=MX3(C0[0],C0[1],C1[0]),b=MX3(C0[2],C0[3],C1[1]); a=MX3(a,C1[2],C1[3]); \
      _Pragma("unroll") for(int r=4;r<16;r+=4){a=MX3(a,C0[r],C0[r+1]);b=MX3(b,C0[r+2],C0[r+3]);a=MX3(a,C1[r],C1[r+1]);b=MX3(b,C1[r+2],C1[r+3]);} \
      float rm=__builtin_fmaxf(a,b); { auto rr=__builtin_amdgcn_permlane32_swap(__float_as_uint(rm),__float_as_uint(rm),false,false); rm=__builtin_fmaxf(__uint_as_float(rr[0]),__uint_as_float(rr[1])); } \
      resc=false; \
      if(__builtin_expect(__any(rm>(float)THRL),0)){ const float dl=__builtin_fmaxf(rm,0.f); mhat+=dl; \
        _Pragma("unroll") for(int r=0;r<16;++r){C0[r]-=dl;C1[r]-=dl;} \
        _Pragma("unroll") for(int r=0;r<16;++r)negm[r]=-mhat; asm volatile("":"+v"(negm)); \
        const float f=__builtin_amdgcn_exp2f(-dl); l_reg*=f; if(hi==0)wsf[r32]=f; resc=true; } } \
    SBAR(); \
    GAPB(o[0]=__builtin_amdgcn_mfma_f32_32x32x16_bf16(PAF(0),VFR(0),o[0],0,0,0), C0,0); \
    GAPB(o[1]=__builtin_amdgcn_mfma_f32_32x32x16_bf16(PAF(0),VFR(4),o[1],0,0,0), C0,4); \
    KRD(GL,0); GAPB(o[0]=__builtin_amdgcn_mfma_f32_32x32x16_bf16(PAF(1),VFR(1),o[0],0,0,0), C0,8); \
    KRD(GL,1); GAPB(o[1]=__builtin_amdgcn_mfma_f32_32x32x16_bf16(PAF(1),VFR(5),o[1],0,0,0), C0,12); \
    KRD(GL,2); GAPB(o[0]=__builtin_amdgcn_mfma_f32_32x32x16_bf16(PAF(2),VFR(2),o[0],0,0,0), C1,0); \
    KRD(GL,3); GAPB(o[1]=__builtin_amdgcn_mfma_f32_32x32x16_bf16(PAF(2),VFR(6),o[1],0,0,0), C1,4); \
    GAPB(o[0]=__builtin_amdgcn_mfma_f32_32x32x16_bf16(PAF(3),VFR(3),o[0],0,0,0), C1,8); \
    GAPB(o[1]=__builtin_amdgcn_mfma_f32_32x32x16_bf16(PAF(3),VFR(7),o[1],0,0,0), C1,12); \
    }while(0)
  int t=1;
  #undef CMASK
  #define CMASK(P0,P1,t) do{}while(0)
  for(;t+5<NT;t+=2){
    STEP(pB0,pB1,pA0,pA1,t,true,true,true);     WAIT_BAR(2); RESC(); ROT();
    STEP(pA0,pA1,pB0,pB1,t+1,true,true,true);   WAIT_BAR(2); RESC(); ROT();
  }
  #undef CMASK
  #define CMASK(P0,P1,t) do{}while(0)
  #define ENDW(tt) do{ if((tt)+3<NT){WAIT_BAR(2);} else if((tt)+2<NT){WAIT_BAR(1);} else {WAIT_BAR(0);} }while(0)
  for(;t+1<NT;t+=2){
    STEP(pB0,pB1,pA0,pA1,t,(t+3<NT),(t+1<NT),(t+1<NT));       ENDW(t);   RESC(); ROT();
    STEP(pA0,pA1,pB0,pB1,t+1,(t+4<NT),(t+2<NT),(t+2<NT));     ENDW(t+1); RESC(); ROT();
  }
  STEP(pB0,pB1,pA0,pA1,NT-1,false,false,false); RESC();
  { float sacc=pB0[0]+pB0[1]; _Pragma("unroll") for(int r=2;r<16;++r)sacc+=pB0[r]; _Pragma("unroll") for(int r=0;r<16;++r)sacc+=pB1[r]; l_reg+=sacc;
    pw0=(u32x4){PKW(pB0,0),PKW(pB0,2),PKW(pB0,4),PKW(pB0,6)};pw1=(u32x4){PKW(pB0,8),PKW(pB0,10),PKW(pB0,12),PKW(pB0,14)};pw2=(u32x4){PKW(pB1,0),PKW(pB1,2),PKW(pB1,4),PKW(pB1,6)};pw3=(u32x4){PKW(pB1,8),PKW(pB1,10),PKW(pB1,12),PKW(pB1,14)};
    SBAR(); pv(o,vb0+sl_cur,PAF(0),PAF(1),PAF(2),PAF(3)); }
  #undef PKW
  #undef PAF
  #undef VFR
  #undef PIN
  #undef MX3
  #undef GAPA
  #undef GAPB
  #undef EX
  #undef VRD
  #undef KRD
  #undef STEP
  #undef ENDW
  {auto rr=__builtin_amdgcn_permlane32_swap(__float_as_uint(l_reg),__float_as_uint(l_reg),false,false);l_reg=__uint_as_float(rr[0])+__uint_as_float(rr[1]);}
  if(hi==0)wsf[32+r32]=l_reg;asm volatile("s_waitcnt lgkmcnt(0)":::"memory");
  float rli[16];
  #pragma unroll
  for(int r=0;r<16;++r)rli[r]=__builtin_amdgcn_rcpf(wsf[32+crow(r,hi)]);
  bf16*Ow=Ow0+(long)(wid*QBLK)*DMQ;
  { bf16*stg=(bf16*)(shm+LDS_OST)+wid*2048;
    #pragma unroll
    for(int r=0;r<16;++r){const int orow=crow(r,hi);
      #pragma unroll
      for(int d0=0;d0<2;++d0)stg[orow*64+d0*32+r32]=__float2bfloat16(o[d0][r]*rli[r]);}
    asm volatile("s_waitcnt lgkmcnt(0)":::"memory");
    #pragma unroll
    for(int i=0;i<4;++i){const int row=i*8+(lane>>3),ch=lane&7; const u32x4 v=*(const u32x4*)(stg+row*64+ch*8); ATTN_STORE16(Ow+(long)row*DMQ+ch*8,v);} }
  asm volatile("s_waitcnt lgkmcnt(0)\n\ts_barrier":::"memory");
  #undef DMA_K
  #undef DMA_V
  #undef CMASK
  #undef START
  #undef RESC
  #undef ROT
}
constexpr int ATTN_LDS_BYTES=LDS_BYTES;
#undef SBAR
#undef WAIT_BAR
}

struct Frame {
    LAS unsigned char* lds;
    volatile LAS unsigned* MISC;
    gu32* ctl;
    int vcu, G;
    const float* const* in;
    unsigned char* ws;
    float* out;
};
#define WSP(T, off) ((T*)(F.ws + (off)))
#define INP(i) (F.in[i])
enum { I_X = 0, I_C, I_CTX, I_CCTX, I_MODW, I_MODB, I_POOLW, I_POOLS, I_LIN, I_CONVW, I_CONVB, I_WA, I_BA, I_WX, I_BX, I_LAM, I_LOUT, I_QKV, I_QG, I_KG, I_WO,
       I_GIN, I_LNG, I_LNB, I_WS, I_BS, I_GOUT, I_ROUTER, I_WG, I_WU, I_WDN, I_FG, N_IN };

__device__ __forceinline__ void tr_item(const float* W, int ldw, bf16* WT, int ldt, int k0, int n0, int drow0, LAS float* scr, int lane) {
#pragma unroll 8
    for (int i = 0; i < 32; ++i) { const int kk = 2 * i + (lane >> 5); scr[kk * 33 + (lane & 31)] = W[(size_t)(k0 + kk) * ldw + n0 + (lane & 31)]; }
    LDS_WAIT(); asm volatile("" ::: "memory");
    const int c = lane & 7;
#pragma unroll
    for (int j = 0; j < 4; ++j) { const int n = (lane >> 3) + 8 * j; const LAS float* s = scr + (8 * c) * 33 + n;
        v4u o; o.x = pk2(s[0 * 33], s[1 * 33]); o.y = pk2(s[2 * 33], s[3 * 33]); o.z = pk2(s[4 * 33], s[5 * 33]); o.w = pk2(s[6 * 33], s[7 * 33]);
        *(v4u*)(WT + (size_t)(drow0 + n) * ldt + k0 + 8 * c) = o; }
    LDS_WAIT(); asm volatile("" ::: "memory");
}
template <int MODE>
__device__ __forceinline__ void tr_job(Frame& F, const float* W, int K, int N, int nb, bf16* WT) {
    const int tid_ = opaque_tid(), lane_ = tid_ & 63, wave_ = __builtin_amdgcn_readfirstlane(tid_ >> 6); (void)lane_; (void)wave_;
    LAS float* scr = (LAS float*)(F.lds + wave_ * 16384);
    const int gw = F.vcu * NWAVES + wave_, NGW = F.G * NWAVES;
    const int nblk = N / 32, per = (K / 64) * nblk, total = per * nb;
    for (int it = gw; it < total; it += NGW) {
        const int bb = it / per, r = it - bb * per, kb = r / nblk, nbk = r - kb * nblk, k0 = 64 * kb, n0 = 32 * nbk;
        const float* Wb = W + (size_t)bb * K * N;
        bf16* dst; int drow0;
        if (MODE == 0) { dst = WT + (size_t)bb * N * K; drow0 = n0; }
        else if (MODE == 1 || MODE == 2) { dst = WT + (size_t)bb * 2048 * K; drow0 = 256 * (n0 >> 7) + (n0 & 127) + (MODE == 2 ? 128 : 0); }
        else { const int d = bb >> 3, h = bb & 7; dst = WT + (size_t)((h * 2 + d) * 256 + (MODE == 4 ? 128 : 0)) * K; drow0 = n0; }
        tr_item(Wb, N, dst, K, k0, n0, drow0, scr, lane_);
    }
}
__device__ __forceinline__ void convert_moe(Frame& F, int L) {
    tr_job<1>(F, INP(I_WG) + (size_t)L * 16 * 1024 * 1024, 1024, 1024, 16, WSP(bf16, WS_WGU));
    tr_job<2>(F, INP(I_WU) + (size_t)L * 16 * 1024 * 1024, 1024, 1024, 16, WSP(bf16, WS_WGU));
    tr_job<0>(F, INP(I_WDN) + (size_t)L * 16 * 1024 * 1024, 1024, 1024, 16, WSP(bf16, WS_WD));
}

__device__ __forceinline__ void phase_prologue(Frame& F) {
    const int tid_ = opaque_tid(), lane_ = tid_ & 63, wave_ = __builtin_amdgcn_readfirstlane(tid_ >> 6); (void)lane_; (void)wave_;
    tr_job<0>(F, INP(I_POOLW), 256, 256, 4, WSP(bf16, WS_PW));
    tr_job<0>(F, INP(I_LIN), 1024, 2048, 1, WSP(bf16, WS_LIN));
    tr_job<3>(F, INP(I_WA), 128, 128, 16, WSP(bf16, WS_LG));
    tr_job<4>(F, INP(I_WX), 128, 128, 16, WSP(bf16, WS_LG));
    tr_job<0>(F, INP(I_LOUT), 1024, 1024, 1, WSP(bf16, WS_LOUT));
    tr_job<0>(F, INP(I_QKV), 1024, 1536, 1, WSP(bf16, WS_QKV));
    tr_job<0>(F, INP(I_WO), 1024, 1024, 1, WSP(bf16, WS_WO));
    tr_job<0>(F, INP(I_GIN), 1024, 6144, 1, WSP(bf16, WS_GIN));
    tr_job<0>(F, INP(I_GOUT), 3072, 1024, 1, WSP(bf16, WS_GOUT));
    convert_moe(F, 0);
    {
        const float* s = INP(I_WS); bf16* d = WSP(bf16, WS_GS);
        for (int i = (int)blockIdx.x * 512 + tid_; i < 4 * 128 * 128 / 2; i += F.G * 512) ((unsigned*)d)[i] = pk2(s[2 * i], s[2 * i + 1]);
    }
    if (blockIdx.x == 0) {
        float* rt = WSP(float, WS_ROPE);
        for (int i = tid_; i < 1024; i += 512) { const int pos = i >> 4, f = i & 15; const float inv = powf(10000.0f, -(float)f / 16.0f); const float ang = (float)pos * inv;
            rt[2 * i] = cosf(ang); rt[2 * i + 1] = sinf(ang); }
    }
    __syncthreads();
    LAS float* S = (LAS float*)F.lds;
    LAS float* RED = (LAS float*)(F.lds + 40960);
    for (int i = tid_; i < 9 * 1024; i += 512) { const int r = i >> 10, k = i & 1023; const float c = (r < 8) ? INP(I_C)[r * 1024 + k] : INP(I_CCTX)[k]; S[i] = c * sigmoid_f(c); }
    __syncthreads();
    for (int u = (int)blockIdx.x; u < 4 * 96; u += F.G) {
        const int l = u / 96, n0 = (u % 96) * 64;
        const float* Wl = INP(I_MODW) + (size_t)l * 1024 * 6144 + n0 + lane_;
        float a[9];
#pragma unroll
        for (int r = 0; r < 9; ++r) a[r] = 0.f;
        const int kb = wave_ * 128;
        for (int k = 0; k < 128; k += 4) {
            float w[4];
#pragma unroll
            for (int q = 0; q < 4; ++q) w[q] = Wl[(size_t)(kb + k + q) * 6144];
#pragma unroll
            for (int r = 0; r < 9; ++r) { const f32x4 s = *(const LAS f32x4*)(S + r * 1024 + kb + k); a[r] += s.x * w[0] + s.y * w[1] + s.z * w[2] + s.w * w[3]; }
        }
#pragma unroll
        for (int r = 0; r < 9; ++r) RED[(wave_ * 9 + r) * 64 + lane_] = a[r];
        __syncthreads();
        for (int i = tid_; i < 9 * 64; i += 512) { const int r = i >> 6, c = i & 63; float s = 0.f;
#pragma unroll
            for (int w8 = 0; w8 < 8; ++w8) s += RED[(w8 * 9 + r) * 64 + c];
            WSP(float, WS_MOD)[((size_t)l * 9 + r) * 6144 + n0 + c] = s + INP(I_MODB)[l * 6144 + n0 + c]; }
        __syncthreads();
    }
}

template <int L>
__device__ __forceinline__ void phase_n1(Frame& F) {
    const int tid_ = opaque_tid(), lane_ = tid_ & 63, wave_ = __builtin_amdgcn_readfirstlane(tid_ >> 6); (void)lane_; (void)wave_;
    const int gw = F.vcu * NWAVES + wave_, NGW = F.G * NWAVES;
    constexpr int nrows = (L >= 3) ? RL : RT;
    float* XS = WSP(float, WS_XS); bf16* H = WSP(bf16, WS_H); const int* INV = WSP(int, WS_INV); const bf16* Y = WSP(bf16, SC_Y);
    const float* MOD = WSP(float, WS_MOD);
    for (int row = gw; row < nrows; row += NGW) {
        const int b = row < RL ? (row >> 12) : 8;
        const float* src;
        if (L == 0) src = row < RL ? INP(I_X) + (size_t)row * D : INP(I_CTX) + (size_t)(row - RL) * D; else src = XS + (size_t)row * D;
        const f32x4* xr = (const f32x4*)src + lane_;
        f32x4 v[4];
#pragma unroll
        for (int j = 0; j < 4; ++j) v[j] = xr[64 * j];
        if (L > 0) {
            const int inv = (lane_ < 16) ? INV[row * 16 + lane_] : -1;
            f32x4 a[4];
#pragma unroll
            for (int j = 0; j < 4; ++j) a[j] = (f32x4){0.f, 0.f, 0.f, 0.f};
#pragma unroll
            for (int e = 0; e < 16; ++e) {
                const int yr = __builtin_amdgcn_readlane(inv, e);
                if (yr >= 0) { const v2u* yp = (const v2u*)(Y + (size_t)yr * D) + lane_;
#pragma unroll
                    for (int j = 0; j < 4; ++j) { const v2u w = yp[64 * j]; a[j].x += bflo(w.x); a[j].y += bfhi(w.x); a[j].z += bflo(w.y); a[j].w += bfhi(w.y); } }
            }
            const float* g2 = MOD + ((size_t)(L - 1) * 9 + b) * 6144 + 5120;
#pragma unroll
            for (int j = 0; j < 4; ++j) { const f32x4 g = *((const f32x4*)g2 + 64 * j + lane_); v[j] = v[j] + g * a[j]; }
            if (L < 4) { f32x4* xo = (f32x4*)(XS + (size_t)row * D) + lane_;
#pragma unroll
                for (int j = 0; j < 4; ++j) xo[64 * j] = v[j]; }
        }
        float ss = 0.f;
#pragma unroll
        for (int j = 0; j < 4; ++j) ss += (v[j].x * v[j].x + v[j].y * v[j].y) + (v[j].z * v[j].z + v[j].w * v[j].w);
        const float rstd = 1.0f / sqrtf(wave_sum(ss) * (1.0f / D) + EPS);
        if (L < 4) {
            const float* sh = MOD + ((size_t)L * 9 + b) * 6144; const float* sc = sh + 1024;
            v2u* ho = (v2u*)(H + (size_t)row * D) + lane_;
#pragma unroll
            for (int j = 0; j < 4; ++j) { const f32x4 s = *((const f32x4*)sc + 64 * j + lane_), t = *((const f32x4*)sh + 64 * j + lane_);
                const f32x4 h = v[j] * rstd * (s + 1.0f) + t; v2u w; w.x = pk2(h.x, h.y); w.y = pk2(h.z, h.w); ho[64 * j] = w; }
        } else {
            f32x4* oo = (f32x4*)(F.out + (size_t)row * D) + lane_;
#pragma unroll
            for (int j = 0; j < 4; ++j) { const f32x4 g = *((const f32x4*)INP(I_FG) + 64 * j + lane_); oo[64 * j] = v[j] * rstd * g; }
        }
    }
}

template <int L>
__device__ __forceinline__ void phase_n2(Frame& F) {
    const int tid_ = opaque_tid(), lane_ = tid_ & 63, wave_ = __builtin_amdgcn_readfirstlane(tid_ >> 6); (void)lane_; (void)wave_;
    const int gw = F.vcu * NWAVES + wave_, NGW = F.G * NWAVES;
    constexpr int nrows = (L >= 3) ? RL : RT;
    LAS float* RW = (LAS float*)F.lds;
    { const float* router = INP(I_ROUTER) + (size_t)L * 1024 * 16;
      for (int i = tid_; i < 16384; i += 512) { const int k = i >> 4, e = i & 15; RW[e * 1024 + k] = router[i]; } }
    __syncthreads();
    const float* XS = WSP(float, WS_XS); bf16* H = WSP(bf16, WS_H); float* AFF = WSP(float, WS_AFF); const float* MOD = WSP(float, WS_MOD);
    const int lane = lane_;
    for (int row = gw; row < nrows; row += NGW) {
        const int b = row < RL ? (row >> 12) : 8;
        const f32x4* xr = (const f32x4*)(XS + (size_t)row * D) + lane;
        f32x4 v[4];
#pragma unroll
        for (int j = 0; j < 4; ++j) v[j] = xr[64 * j];
        float ss = 0.f;
#pragma unroll
        for (int j = 0; j < 4; ++j) ss += (v[j].x * v[j].x + v[j].y * v[j].y) + (v[j].z * v[j].z + v[j].w * v[j].w);
        const float rstd = 1.0f / sqrtf(wave_sum(ss) * (1.0f / D) + EPS);
        const float* sh = MOD + ((size_t)L * 9 + b) * 6144 + 3072; const float* sc = sh + 1024;
        v2u* ho = (v2u*)(H + (size_t)row * D) + lane;
#pragma unroll
        for (int j = 0; j < 4; ++j) { const f32x4 s = *((const f32x4*)sc + 64 * j + lane), t = *((const f32x4*)sh + 64 * j + lane);
            v[j] = v[j] * rstd * (s + 1.0f) + t; v2u w; w.x = pk2(v[j].x, v[j].y); w.y = pk2(v[j].z, v[j].w); ho[64 * j] = w; }
        float p[16];
#pragma unroll
        for (int e = 0; e < 16; ++e) { float s = 0.f;
#pragma unroll
            for (int j = 0; j < 4; ++j) { const f32x4 w = *(const LAS f32x4*)(RW + e * 1024 + 256 * j + 4 * lane); s += (v[j].x * w.x + v[j].y * w.y) + (v[j].z * w.z + v[j].w * w.w); }
            p[e] = s; __builtin_amdgcn_sched_barrier(0); }
#pragma unroll
        for (int i = 0; i < 8; ++i) { const bool hi = (lane & 32) != 0; const float send = hi ? p[i] : p[i + 8], keep = hi ? p[i + 8] : p[i]; p[i] = keep + __shfl_xor(send, 32); }
#pragma unroll
        for (int i = 0; i < 4; ++i) { const bool hi = (lane & 16) != 0; const float send = hi ? p[i] : p[i + 4], keep = hi ? p[i + 4] : p[i]; p[i] = keep + __shfl_xor(send, 16); }
#pragma unroll
        for (int i = 0; i < 2; ++i) { const bool hi = (lane & 8) != 0; const float send = hi ? p[i] : p[i + 2], keep = hi ? p[i + 2] : p[i]; p[i] = keep + __shfl_xor(send, 8); }
        { const bool hi = (lane & 4) != 0; const float send = hi ? p[0] : p[1], keep = hi ? p[1] : p[0]; p[0] = keep + __shfl_xor(send, 4); }
        float lg = p[0]; lg += __shfl_xor(lg, 1); lg += __shfl_xor(lg, 2);
        float mx = lg;
#pragma unroll
        for (int o = 4; o < 64; o <<= 1) mx = fmaxf(mx, __shfl_xor(mx, o));
        const float ex = __expf(lg - mx); float sm = ex;
#pragma unroll
        for (int o = 4; o < 64; o <<= 1) sm += __shfl_xor(sm, o);
        if ((lane & 3) == 0) { const int e = ((lane >> 5) & 1) * 8 + ((lane >> 4) & 1) * 4 + ((lane >> 3) & 1) * 2 + ((lane >> 2) & 1); AFF[(size_t)row * 16 + e] = ex / sm; }
    }
    __syncthreads();
}

__device__ __forceinline__ unsigned block_excl_scan(unsigned v, LAS unsigned* tmp, int tid, unsigned& total) {
    const int lane = tid & 63, w = tid >> 6; unsigned inc = v;
#pragma unroll
    for (int o = 1; o < 64; o <<= 1) { const unsigned t = __shfl_up(inc, o); if (lane >= o) inc += t; }
    if (lane == 63) tmp[w] = inc;
    __syncthreads();
    unsigned pre = 0, tot = 0;
#pragma unroll
    for (int i = 0; i < 8; ++i) { const unsigned t = tmp[i]; if (i < w) pre += t; tot += t; }
    __syncthreads();
    total = tot; return pre + inc - v;
}
template <int NPT>
__device__ __forceinline__ void topk_problem(Frame& F, const float* aff  , int n, int k, int row0  , int e, int ybase) {
    const int tid_ = opaque_tid(), lane_ = tid_ & 63, wave_ = __builtin_amdgcn_readfirstlane(tid_ >> 6); (void)lane_; (void)wave_;
    LAS unsigned* hist = (LAS unsigned*)F.lds;
    LAS unsigned* sel = hist + 256;
    LAS unsigned* tmp = hist + 272;
    const int tid = tid_;
    unsigned key[NPT];
#pragma unroll
    for (int i = 0; i < NPT; ++i) { const int t = tid * NPT + i; key[i] = (t < n) ? __builtin_bit_cast(unsigned, aff[(size_t)t * 16]) : 0u; }
    unsigned prefix = 0, kk = (unsigned)k;
#pragma unroll
    for (int pass = 0; pass < 4; ++pass) {
        const int shift = 24 - 8 * pass;
        if (tid < 256) hist[tid] = 0u;
        __syncthreads();
#pragma unroll
        for (int i = 0; i < NPT; ++i) { const int t = tid * NPT + i; const bool in = (t < n) && (pass == 0 || (key[i] >> (shift + 8)) == prefix); if (in) __hip_atomic_fetch_add(&hist[(key[i] >> shift) & 255u], 1u, __ATOMIC_RELAXED, __HIP_MEMORY_SCOPE_WORKGROUP); }
        __syncthreads();
        if (tid < 64) {
            unsigned c[4]; unsigned s = 0;
#pragma unroll
            for (int q = 0; q < 4; ++q) { c[q] = hist[255 - 4 * tid - q]; s += c[q]; }
            unsigned inc = s;
#pragma unroll
            for (int o = 1; o < 64; o <<= 1) { const unsigned t = __shfl_up(inc, o); if (tid >= o) inc += t; }
            const unsigned long long m = __ballot(inc >= kk);
            const int first = __ffsll((long long)m) - 1;
            if (tid == first) { unsigned before = inc - s; int q = 0; for (; q < 3; ++q) { if (before + c[q] >= kk) break; before += c[q]; }
                sel[0] = (unsigned)(255 - 4 * tid - q); sel[1] = kk - before; }
        }
        __syncthreads();
        prefix = (prefix << 8) | sel[0]; kk = sel[1];
        __syncthreads();
    }
    const unsigned T = prefix, need_eq = kk;
    unsigned cg = 0, ce = 0;
#pragma unroll
    for (int i = 0; i < NPT; ++i) { const int t = tid * NPT + i; if (t < n) { cg += key[i] > T; ce += key[i] == T; } }
    unsigned total; const unsigned pre = block_excl_scan((ce << 16) | cg, tmp, tid, total);
    unsigned gb = pre & 0xffffu, eb = pre >> 16;
    int* INV = WSP(int, WS_INV); int* IDX = WSP(int, WS_IDX); float* GATE = WSP(float, WS_GATE);
#pragma unroll
    for (int i = 0; i < NPT; ++i) { const int t = tid * NPT + i; if (t < n) {
        const bool g = key[i] > T, q = key[i] == T; const bool s = g || (q && eb < need_eq);
        const int slot = (int)(gb + (eb < need_eq ? eb : need_eq));
        const int row = row0 + t;
        if (s) { IDX[ybase + slot] = row; GATE[ybase + slot] = __builtin_bit_cast(float, key[i]); }
        INV[(size_t)row * 16 + e] = s ? (ybase + slot) : -1;
        gb += g; eb += q; } }
    __syncthreads();
}
template <int L>
__device__ __forceinline__ void phase_topk(Frame& F) {
    constexpr int nprob = (L >= 3) ? 128 : 256;
    const float* AFF = WSP(float, WS_AFF);
    for (int p = (int)blockIdx.x; p < nprob; p += F.G) {
        if (p < 128) { const int b = p >> 4, e = p & 15; topk_problem<8>(F, AFF + (size_t)b * SEQ * 16 + e, SEQ, SEQ / 8, b * SEQ, e, p * 512); }
        else { const int q = p - 128, e = q >> 3, b = q & 7; topk_problem<1>(F, AFF + (size_t)(RL + b * CTX) * 16 + e, CTX, CTX / 8, RL + b * CTX, e, NYL + e * 256 + b * 32); }
    }
}

__device__ __forceinline__ void seq_pos(int row, int& pos, int& len) { if (row < RL) { pos = row & (SEQ - 1); len = SEQ; } else { pos = (row - RL) & (CTX - 1); len = CTX; } }
__device__ __forceinline__ void phase_pool(Frame& F) {
    const int tid_ = opaque_tid(), lane_ = tid_ & 63, wave_ = __builtin_amdgcn_readfirstlane(tid_ >> 6); (void)lane_; (void)wave_;
    const bf16* H = WSP(bf16, WS_H); bf16* P = WSP(bf16, SC_P);
    for (int idx = (int)blockIdx.x * 512 + tid_; idx < RT * 128; idx += F.G * 512) {
        const int row = idx >> 7, c8 = idx & 127, g = c8 >> 5, half = 1 << g;
        int pos, len; seq_pos(row, pos, len);
        const int lo = max(pos - half, 0), hi = min(pos + half, len);
        float s[8];
#pragma unroll
        for (int q = 0; q < 8; ++q) s[q] = 0.f;
        for (int p = lo; p < hi; ++p) { const v4u w = *(const v4u*)(H + (size_t)(row + p - pos) * D + c8 * 8);
            s[0] += bflo(w.x); s[1] += bfhi(w.x); s[2] += bflo(w.y); s[3] += bfhi(w.y); s[4] += bflo(w.z); s[5] += bfhi(w.z); s[6] += bflo(w.w); s[7] += bfhi(w.w); }
        const float inv = 1.0f / (float)(hi - lo);
        const v4u c = *(const v4u*)(H + (size_t)row * D + c8 * 8);
        v4u o; o.x = pk2(s[0] * inv - bflo(c.x), s[1] * inv - bfhi(c.x)); o.y = pk2(s[2] * inv - bflo(c.y), s[3] * inv - bfhi(c.y));
        o.z = pk2(s[4] * inv - bflo(c.z), s[5] * inv - bfhi(c.z)); o.w = pk2(s[6] * inv - bflo(c.w), s[7] * inv - bfhi(c.w));
        *(v4u*)(P + (size_t)row * D + c8 * 8) = o;
    }
}
__device__ __forceinline__ void phase_conv(Frame& F) {
    const int tid_ = opaque_tid(), lane_ = tid_ & 63, wave_ = __builtin_amdgcn_readfirstlane(tid_ >> 6); (void)lane_; (void)wave_;
    const bf16* ZX = WSP(bf16, SC_ZX); bf16* XR = WSP(bf16, SC_XR); const float* cw = INP(I_CONVW); const float* cb = INP(I_CONVB);
    for (int idx = (int)blockIdx.x * 512 + tid_; idx < RT * 128; idx += F.G * 512) {
        const int row = idx >> 7, c8 = idx & 127;
        int pos, len; seq_pos(row, pos, len);
        float s[8];
        { const f32x4 b0 = *(const f32x4*)(cb + c8 * 8), b1 = *(const f32x4*)(cb + c8 * 8 + 4); s[0] = b0.x; s[1] = b0.y; s[2] = b0.z; s[3] = b0.w; s[4] = b1.x; s[5] = b1.y; s[6] = b1.z; s[7] = b1.w; }
#pragma unroll
        for (int k = 0; k < 4; ++k) { const int p = pos + k - 2; if (p >= 0 && p < len) {
            const v4u w = *(const v4u*)(ZX + (size_t)(row + k - 2) * D + c8 * 8);
            const f32x4 w0 = *(const f32x4*)(cw + k * 1024 + c8 * 8), w1 = *(const f32x4*)(cw + k * 1024 + c8 * 8 + 4);
            s[0] += bflo(w.x) * w0.x; s[1] += bfhi(w.x) * w0.y; s[2] += bflo(w.y) * w0.z; s[3] += bfhi(w.y) * w0.w;
            s[4] += bflo(w.z) * w1.x; s[5] += bfhi(w.z) * w1.y; s[6] += bflo(w.w) * w1.z; s[7] += bfhi(w.w) * w1.w; } }
        v4u o; o.x = pk2(s[0], s[1]); o.y = pk2(s[2], s[3]); o.z = pk2(s[4], s[5]); o.w = pk2(s[6], s[7]);
        *(v4u*)(XR + (size_t)row * D + c8 * 8) = o;
    }
}
__device__ __forceinline__ int scan_chunk(int d, int b, int s) { return d == 0 ? (s < 4 ? 512 + b * 4 + s : b * 64 + (s - 4)) : (s < 4 ? 512 + b * 4 + (3 - s) : b * 64 + (63 - (s - 4))); }
__device__ __forceinline__ void phase_carry(Frame& F) {
    const int tid_ = opaque_tid(), lane_ = tid_ & 63, wave_ = __builtin_amdgcn_readfirstlane(tid_ >> 6); (void)lane_; (void)wave_;
    const f32x2* AGG = WSP(f32x2, WS_AGG); float* CARRY = WSP(float, WS_CARRY);
    for (int gid = (int)blockIdx.x * 512 + tid_; gid < 2 * 8 * 1024; gid += F.G * 512) {
        const int d = gid >> 13, b = (gid >> 10) & 7, ch = gid & 1023;
        float st = 0.f;
#pragma unroll 4
        for (int s = 0; s < 68; ++s) { const int c = scan_chunk(d, b, s); const size_t o = ((size_t)d * 544 + c) * 1024 + ch;
            const f32x2 ah = AGG[o]; CARRY[o] = st; st = ah.x * st + ah.y; }
    }
}
__device__ __forceinline__ void phase_lruc(Frame& F) {
    const int tid_ = opaque_tid(), lane_ = tid_ & 63, wave_ = __builtin_amdgcn_readfirstlane(tid_ >> 6); (void)lane_; (void)wave_;
    const bf16 *HL0 = WSP(bf16, SC_HL0), *HL1 = WSP(bf16, SC_HL1), *AC0 = WSP(bf16, SC_AC0), *AC1 = WSP(bf16, SC_AC1), *YG = WSP(bf16, SC_YG); bf16* G = WSP(bf16, SC_G);
    const float* CARRY = WSP(float, WS_CARRY);
    for (int idx = (int)blockIdx.x * 512 + tid_; idx < RT * 128; idx += F.G * 512) {
        const int row = idx >> 7, c8 = idx & 127, chunk = row >> 6; const size_t o = (size_t)row * D + c8 * 8;
        const v4u h0 = *(const v4u*)(HL0 + o), h1 = *(const v4u*)(HL1 + o), a0 = *(const v4u*)(AC0 + o), a1 = *(const v4u*)(AC1 + o), y = *(const v4u*)(YG + o);
        const float* c0 = CARRY + ((size_t)chunk) * 1024 + c8 * 8; const float* c1 = CARRY + ((size_t)544 + chunk) * 1024 + c8 * 8;
        const f32x4 p0 = *(const f32x4*)c0, p1 = *(const f32x4*)(c0 + 4), q0 = *(const f32x4*)c1, q1 = *(const f32x4*)(c1 + 4);
        float r[8];
        r[0] = (bflo(h0.x) + bflo(a0.x) * p0.x + bflo(h1.x) + bflo(a1.x) * q0.x) * bflo(y.x); r[1] = (bfhi(h0.x) + bfhi(a0.x) * p0.y + bfhi(h1.x) + bfhi(a1.x) * q0.y) * bfhi(y.x);
        r[2] = (bflo(h0.y) + bflo(a0.y) * p0.z + bflo(h1.y) + bflo(a1.y) * q0.z) * bflo(y.y); r[3] = (bfhi(h0.y) + bfhi(a0.y) * p0.w + bfhi(h1.y) + bfhi(a1.y) * q0.w) * bfhi(y.y);
        r[4] = (bflo(h0.z) + bflo(a0.z) * p1.x + bflo(h1.z) + bflo(a1.z) * q1.x) * bflo(y.z); r[5] = (bfhi(h0.z) + bfhi(a0.z) * p1.y + bfhi(h1.z) + bfhi(a1.z) * q1.y) * bfhi(y.z);
        r[6] = (bflo(h0.w) + bflo(a0.w) * p1.z + bflo(h1.w) + bflo(a1.w) * q1.z) * bflo(y.w); r[7] = (bfhi(h0.w) + bfhi(a0.w) * p1.w + bfhi(h1.w) + bfhi(a1.w) * q1.w) * bfhi(y.w);
        v4u w; w.x = pk2(r[0], r[1]); w.y = pk2(r[2], r[3]); w.z = pk2(r[4], r[5]); w.w = pk2(r[6], r[7]);
        *(v4u*)(G + o) = w;
    }
}

using pg8::Unit;
struct SchedMN {
    int nM, nN, G, c, ash; const char* A; const char* B; size_t a_tile, a_pn, b_tile;
    __device__ __forceinline__ bool next(int i, Unit& u) const {
        int pm, pn; if (!pg8::static_order(i, G, c, nM, nN, pm, pn)) return false;
        u.pm = pm; u.pn = pn; u.rows = nullptr; u.A = A + (size_t)pm * a_tile + (size_t)(pn >> ash) * a_pn; u.B = B + (size_t)pn * b_tile; return true;
    }
};
__device__ __forceinline__ int moe_expert(int t) { return t < 256 ? ((t >> 1) & 15) : (t - 256); }
struct SchedMoeUp {
    int G, c, nct; const char* Hb; const char* W; const int* IDX;
    __device__ __forceinline__ bool next(int i, Unit& u) const {
        int t, pn;
        if (G == 256) {
            const int x = c & 7, j = c >> 3;
            if (i < 8) { const int e = 2 * x + (i >> 2), a = (i & 3) * 4 + (j >> 3); pn = j & 7; t = ((a >> 1) * 16 + e) * 2 + (a & 1); }
            else if (i == 8 && c < nct) { t = 256 + (c >> 3); pn = c & 7; }
            else return false;
        } else { const int L = i * G + c; const int tot = 2048 + nct; if (L >= tot) return false; t = L >> 3; pn = L & 7; }
        u.pm = t; u.pn = pn; u.rows = IDX + t * 256; u.A = Hb; u.B = W + ((size_t)moe_expert(t) * 2048 + (size_t)pn * 256) * 2048; return true;
    }
};
struct SchedMoeDown {
    int G, c, ntile; const char* ACT; const char* W;
    __device__ __forceinline__ bool next(int i, Unit& u) const {
        int pm, pn; if (!pg8::static_order(i, G, c, ntile, 4, pm, pn)) return false;
        u.pm = pm; u.pn = pn; u.rows = nullptr; u.A = ACT + (size_t)pm * 256 * 2048; u.B = W + ((size_t)moe_expert(pm) * 1024 + (size_t)pn * 256) * 2048; return true;
    }
};

using f32x4_t = f32x4;
typedef const f32x4 (&AccRef)[2][2][4][2];
template <bool LAYER0, bool SCALE>
struct EpiRes {
    float* XS; const float* x_in; const float* ctx_in; const float* g1base  ; const float* scale;
    __device__ __forceinline__ void operator()(AccRef acc, const Unit& u, int wr, int wc, int fr, int fq) const {
        asm volatile("" : "+v"(fr), "+v"(fq));
        const int b = u.pm < 128 ? (u.pm >> 4) : 8; const float* g1 = g1base + (size_t)b * 6144;
        const int col0 = u.pn * 256 + wc * 32 + 4 * fq;
        f32x4 gv[2][2];
#pragma unroll
        for (int bj = 0; bj < 2; ++bj)
#pragma unroll
            for (int n = 0; n < 2; ++n) { gv[bj][n] = *(const f32x4*)(g1 + col0 + bj * 128 + n * 16); if (SCALE) gv[bj][n] = gv[bj][n] * *(const f32x4*)(scale + col0 + bj * 128 + n * 16); }
#pragma unroll
        for (int ai = 0; ai < 2; ++ai)
#pragma unroll
            for (int m = 0; m < 4; ++m) {
                const int row = u.pm * 256 + ai * 128 + wr * 64 + m * 16 + fr;
                const float* src = LAYER0 ? (row < RL ? x_in + (size_t)row * D : ctx_in + (size_t)(row - RL) * D) : XS + (size_t)row * D;
                float* dst = XS + (size_t)row * D;
#pragma unroll
                for (int bj = 0; bj < 2; ++bj)
#pragma unroll
                    for (int n = 0; n < 2; ++n) { const int c = col0 + bj * 128 + n * 16; const f32x4 xv = *(const f32x4*)(src + c); *(f32x4*)(dst + c) = xv + gv[bj][n] * acc[ai][bj][m][n]; }
                __builtin_amdgcn_sched_barrier(0);
            }
    }
};
__device__ __forceinline__ v4u pack8(const f32x4& v0, const f32x4& v1) { v4u w; w.x = pk2(v0.x, v0.y); w.y = pk2(v0.z, v0.w); w.z = pk2(v1.x, v1.y); w.w = pk2(v1.z, v1.w); return w; }
struct EpiLruIn {
    bf16* YG; bf16* ZX;
    __device__ __forceinline__ void operator()(AccRef acc, const Unit& u, int wr, int wc, int fr, int fq) const {
        asm volatile("" : "+v"(fr), "+v"(fq));
        const bool isy = u.pn < 4; bf16* base = isy ? YG + u.pn * 256 : ZX + (u.pn - 4) * 256;
#pragma unroll
        for (int ai = 0; ai < 2; ++ai)
#pragma unroll
            for (int m = 0; m < 4; ++m) { const int row = u.pm * 256 + ai * 128 + wr * 64 + m * 16 + fr;
#pragma unroll
                for (int bj = 0; bj < 2; ++bj) { f32x4 v0 = acc[ai][bj][m][0], v1 = acc[ai][bj][m][1];
                    if (isy) {
#pragma unroll
                        for (int e = 0; e < 4; ++e) { v0[e] = gelu_tanh(v0[e]); v1[e] = gelu_tanh(v1[e]); } }
                    *(v4u*)(base + (size_t)row * D + bj * 128 + wc * 32 + 8 * fq) = pack8(v0, v1); } }
    }
};
struct EpiGates {
    const bf16* XR; bf16 *HL0, *HL1, *AC0, *AC1; f32x2* AGG; const float *ba, *bx, *lam;
    __device__ __forceinline__ void operator()(AccRef acc, const Unit& u, int wr, int wc, int fr, int fq) const {
        asm volatile("" : "+v"(fr), "+v"(fq));
        body<0>(acc, u, wr, wc, fr, fq); body<1>(acc, u, wr, wc, fr, fq);
    }
    template <int n>
    __device__ __forceinline__ void body(AccRef acc, const Unit& u, int wr, int wc, int fr, int fq) const {
        asm volatile("" : "+v"(fr), "+v"(fq));
        const int h = u.pn >> 1, d = u.pn & 1;
        bf16* HL = d ? HL1 : HL0; bf16* AC = d ? AC1 : AC0;
        {
            const int chb = h * 128 + wc * 32 + n * 16 + 4 * fq;
            const f32x4 bav = *(const f32x4*)(ba + d * 1024 + chb), bxv = *(const f32x4*)(bx + d * 1024 + chb), lmv = *(const f32x4*)(lam + d * 1024 + chb);
            float sp[4];
#pragma unroll
            for (int e = 0; e < 4; ++e) sp[e] = log1pf(__expf(-lmv[e]));
#pragma unroll
            for (int ai = 0; ai < 2; ++ai) {
                float av[4][4], uv[4][4];
#pragma unroll
                for (int m = 0; m < 4; ++m) { const int row = u.pm * 256 + ai * 128 + wr * 64 + m * 16 + fr;
                    const v2u xw = *(const v2u*)(XR + (size_t)row * D + chb);
                    const float xr[4] = {bflo(xw.x), bfhi(xw.x), bflo(xw.y), bfhi(xw.y)};
#pragma unroll
                    for (int e = 0; e < 4; ++e) { const float r = sigmoid_f(acc[ai][0][m][n][e] + bav[e]), ig = sigmoid_f(acc[ai][1][m][n][e] + bxv[e]);
                        const float la = -8.0f * r * sp[e]; const float a = __expf(la); const float mult = sqrtf(-expm1f(2.0f * la));
                        av[m][e] = a; uv[m][e] = xr[e] * ig * mult; } __builtin_amdgcn_sched_barrier(0); }
                float Ac[4], Hc[4];
#pragma unroll
                for (int e = 0; e < 4; ++e) { Ac[e] = 1.f; Hc[e] = 0.f; }
#pragma unroll
                for (int mm = 0; mm < 4; ++mm) { const int m = d ? 3 - mm : mm;
#pragma unroll
                    for (int e = 0; e < 4; ++e) {
                        float a = d ? av[3 - mm][e] : av[mm][e], hh = d ? uv[3 - mm][e] : uv[mm][e];
#pragma unroll
                        for (int dl = 1; dl < 16; dl <<= 1) {
                            const float ao = d ? __shfl_down(a, dl, 16) : __shfl_up(a, dl, 16), ho = d ? __shfl_down(hh, dl, 16) : __shfl_up(hh, dl, 16);
                            const bool valid = d ? (fr + dl < 16) : (fr >= dl);
                            if (valid) { hh = a * ho + hh; a = a * ao; } }
                        const float fa = __shfl(a, d ? 0 : 15, 16), fh = __shfl(hh, d ? 0 : 15, 16);
                        const float hl = hh + a * Hc[e], ac = a * Ac[e];
                        Hc[e] = fa * Hc[e] + fh; Ac[e] = fa * Ac[e];
                        if (d) { av[3 - mm][e] = ac; uv[3 - mm][e] = hl; } else { av[mm][e] = ac; uv[mm][e] = hl; }
                        __builtin_amdgcn_sched_barrier(0);
                    }
                    (void)m; }
#pragma unroll
                for (int m = 0; m < 4; ++m) { const int row = u.pm * 256 + ai * 128 + wr * 64 + m * 16 + fr;
                    v2u w; w.x = pk2(uv[m][0], uv[m][1]); w.y = pk2(uv[m][2], uv[m][3]); *(v2u*)(HL + (size_t)row * D + chb) = w;
                    v2u q; q.x = pk2(av[m][0], av[m][1]); q.y = pk2(av[m][2], av[m][3]); *(v2u*)(AC + (size_t)row * D + chb) = q; }
                if (fr == 0) { const int chunk = u.pm * 4 + ai * 2 + wr; f32x2* ag = AGG + ((size_t)d * 544 + chunk) * 1024 + chb;
#pragma unroll
                    for (int e = 0; e < 4; ++e) ag[e] = (f32x2){Ac[e], Hc[e]}; }
            }
        }
    }
};
struct EpiQKV {
    bf16 *Q, *KA, *VA; const float *qg, *kg; const f32x2* rope;
    __device__ __forceinline__ void operator()(AccRef acc, const Unit& u, int wr, int wc, int fr, int fq) const {
        asm volatile("" : "+v"(fr), "+v"(fq));
        const int kind = u.pn < 4 ? 0 : (u.pn == 4 ? 1 : 2);
        const float* gp = kind == 0 ? qg : kg;
        f32x4 g[2][2];
#pragma unroll
        for (int bj = 0; bj < 2; ++bj)
#pragma unroll
            for (int n = 0; n < 2; ++n) g[bj][n] = (kind == 2) ? (f32x4){1.f, 1.f, 1.f, 1.f} : *(const f32x4*)(gp + bj * 32 + 8 * fq + 4 * n);
        const float post = kind == 0 ? attn_body::C2 : 1.0f;
#pragma unroll
        for (int ai = 0; ai < 2; ++ai)
#pragma unroll
            for (int m = 0; m < 4; ++m) {
                const int row = u.pm * 256 + ai * 128 + wr * 64 + m * 16 + fr;
                const bool lat = row < RL; const int bb = lat ? (row >> 12) : ((row - RL) >> 8), nn = lat ? (row & (SEQ - 1)) : ((row - RL) & (CTX - 1));
                f32x4 v[2][2];
#pragma unroll
                for (int bj = 0; bj < 2; ++bj)
#pragma unroll
                    for (int n = 0; n < 2; ++n) v[bj][n] = acc[ai][bj][m][n];
                if (kind != 2) {
                    float ss = 0.f;
#pragma unroll
                    for (int bj = 0; bj < 2; ++bj)
#pragma unroll
                        for (int n = 0; n < 2; ++n) ss += (v[bj][n].x * v[bj][n].x + v[bj][n].y * v[bj][n].y) + (v[bj][n].z * v[bj][n].z + v[bj][n].w * v[bj][n].w);
                    ss += __shfl_xor(ss, 16); ss += __shfl_xor(ss, 32);
                    const float rstd = 1.0f / sqrtf(ss * (1.0f / 64.0f) + EPS);
#pragma unroll
                    for (int bj = 0; bj < 2; ++bj)
#pragma unroll
                        for (int n = 0; n < 2; ++n) v[bj][n] = v[bj][n] * rstd * g[bj][n];
                    if (lat) {
#pragma unroll
                        for (int bj = 0; bj < 2; ++bj) { const int pos = bj ? (nn & 63) : (nn >> 6);
#pragma unroll
                            for (int n = 0; n < 2; ++n) { const f32x2 cs0 = rope[pos * 16 + 4 * fq + 2 * n], cs1 = rope[pos * 16 + 4 * fq + 2 * n + 1];
                                const f32x4 t = v[bj][n];
                                v[bj][n].x = t.x * cs0.x - t.y * cs0.y; v[bj][n].y = t.x * cs0.y + t.y * cs0.x;
                                v[bj][n].z = t.z * cs1.x - t.w * cs1.y; v[bj][n].w = t.z * cs1.y + t.w * cs1.x; } }
                    }
                }
                if (kind == 0) {
                    bf16* dst = Q + (size_t)row * D + (u.pn * 4 + wc) * 64 + 8 * fq;
#pragma unroll
                    for (int bj = 0; bj < 2; ++bj) *(v4u*)(dst + bj * 32) = pack8(v[bj][0] * post, v[bj][1] * post);
                } else {
                    const size_t krow = (size_t)bb * KVLEN + (lat ? CTX + nn : nn);
                    bf16* dst = (kind == 1 ? KA : VA) + krow * 256 + wc * 64 + 8 * fq;
#pragma unroll
                    for (int bj = 0; bj < 2; ++bj) *(v4u*)(dst + bj * 32) = pack8(v[bj][0], v[bj][1]);
                }
                __builtin_amdgcn_sched_barrier(0);
            }
    }
};
struct EpiGmlpIn {
    bf16 *U, *V; f32x2* PSUM;
    __device__ __forceinline__ void operator()(AccRef acc, const Unit& u, int wr, int wc, int fr, int fq) const {
        asm volatile("" : "+v"(fr), "+v"(fq));
        const bool isu = u.pn < 12; bf16* base = isu ? U + u.pn * 256 : V + (u.pn - 12) * 256;
#pragma unroll
        for (int ai = 0; ai < 2; ++ai)
#pragma unroll
            for (int m = 0; m < 4; ++m) { const int row = u.pm * 256 + ai * 128 + wr * 64 + m * 16 + fr; float s1 = 0.f, s2 = 0.f;
#pragma unroll
                for (int bj = 0; bj < 2; ++bj) { f32x4 v0 = acc[ai][bj][m][0], v1 = acc[ai][bj][m][1];
#pragma unroll
                    for (int e = 0; e < 4; ++e) { v0[e] = gelu_tanh(v0[e]); v1[e] = gelu_tanh(v1[e]); s1 += v0[e] + v1[e]; s2 += v0[e] * v0[e] + v1[e] * v1[e]; }
                    *(v4u*)(base + (size_t)row * 3072 + bj * 128 + wc * 32 + 8 * fq) = pack8(v0, v1); }
                if (!isu) { s1 += __shfl_xor(s1, 16); s1 += __shfl_xor(s1, 32); s2 += __shfl_xor(s2, 16); s2 += __shfl_xor(s2, 32);
                    if (fq == 0) PSUM[(size_t)row * 48 + (u.pn - 12) * 4 + wc] = (f32x2){s1, s2}; } }
    }
};
struct EpiMoeUp {
    bf16* ACT;
    __device__ __forceinline__ void operator()(AccRef acc, const Unit& u, int wr, int wc, int fr, int fq) const {
        asm volatile("" : "+v"(fr), "+v"(fq));
#pragma unroll
        for (int ai = 0; ai < 2; ++ai)
#pragma unroll
            for (int m = 0; m < 4; ++m) { const size_t yrow = (size_t)u.pm * 256 + ai * 128 + wr * 64 + m * 16 + fr;
                f32x4 o[2];
#pragma unroll
                for (int n = 0; n < 2; ++n)
#pragma unroll
                    for (int e = 0; e < 4; ++e) { const float gt = acc[ai][0][m][n][e], up = acc[ai][1][m][n][e]; o[n][e] = gt * sigmoid_f(gt) * up; }
                *(v4u*)(ACT + yrow * D + u.pn * 128 + wc * 32 + 8 * fq) = pack8(o[0], o[1]); }
    }
};
struct EpiMoeDown {
    bf16* Y; const float* GATE;
    __device__ __forceinline__ void operator()(AccRef acc, const Unit& u, int wr, int wc, int fr, int fq) const {
        asm volatile("" : "+v"(fr), "+v"(fq));
#pragma unroll
        for (int ai = 0; ai < 2; ++ai)
#pragma unroll
            for (int m = 0; m < 4; ++m) { const size_t yrow = (size_t)u.pm * 256 + ai * 128 + wr * 64 + m * 16 + fr; const float gt = GATE[yrow];
#pragma unroll
                for (int bj = 0; bj < 2; ++bj) *(v4u*)(Y + yrow * D + u.pn * 256 + bj * 128 + wc * 32 + 8 * fq) = pack8(acc[ai][bj][m][0] * gt, acc[ai][bj][m][1] * gt); }
    }
};

__device__ __forceinline__ void phase_spatial(Frame& F) {
    const int tid_ = opaque_tid(), lane_ = tid_ & 63, wave_ = __builtin_amdgcn_readfirstlane(tid_ >> 6); (void)lane_; (void)wave_;
    constexpr int WLS = 136;
    LAS bf16* WL = (LAS bf16*)F.lds;
    LAS bf16* BT = (LAS bf16*)(F.lds + 128 * WLS * 2);
    LAS float* ST = (LAS float*)(F.lds + 128 * WLS * 2 + 2 * 64 * WLS * 2);
    const int tid = tid_, lane = lane_, wave = wave_, fr = lane & 15, fq = lane >> 4;
    bf16* U = WSP(bf16, SC_U); const bf16* V = WSP(bf16, SC_V); const f32x2* PSUM = WSP(f32x2, SC_PSUM);
    const bf16* WS = WSP(bf16, WS_GS); const float* lng = INP(I_LNG); const float* lnb = INP(I_LNB); const float* bs = INP(I_BS);
    for (int unit = (int)blockIdx.x; unit < 8 * 32 * 4; unit += F.G) {
        const int g = unit & 3, ck = unit >> 2;
        const size_t row0 = (size_t)ck * 128;
        __syncthreads();
        { const int q = tid >> 2, part = tid & 3; float s1 = 0.f, s2 = 0.f;
#pragma unroll
          for (int i = 0; i < 12; ++i) { const f32x2 p = PSUM[(row0 + q) * 48 + part * 12 + i]; s1 += p.x; s2 += p.y; }
          s1 += __shfl_xor(s1, 1); s1 += __shfl_xor(s1, 2); s2 += __shfl_xor(s2, 1); s2 += __shfl_xor(s2, 2);
          const float mean = s1 * (1.0f / 3072.0f); const float var = fmaxf(s2 * (1.0f / 3072.0f) - mean * mean, 0.f);
          if (part == 0) { ST[2 * q] = mean; ST[2 * q + 1] = 1.0f / sqrtf(var + EPS); } }
        for (int i = tid; i < 128 * 16; i += 512) { const int p = i >> 4, c = i & 15; *(LAS v4u*)(WL + p * WLS + c * 8) = *(const v4u*)(WS + (size_t)g * 16384 + p * 128 + c * 8); }
        __syncthreads();
        const float bsp = bs[g * 128 + wave * 16 + fr];
        for (int s = 0; s < 12; ++s) {
            const int f0 = g * 768 + s * 64;
            LAS bf16* bt = BT + (s & 1) * 64 * WLS;
#pragma unroll
            for (int pass = 0; pass < 2; ++pass) { const int q = (tid >> 3) + 64 * pass, f8 = (tid & 7) * 8;
                const v4u w = *(const v4u*)(V + (row0 + q) * 3072 + f0 + f8);
                const float mean = ST[2 * q], rstd = ST[2 * q + 1];
                const f32x4 g0 = *(const f32x4*)(lng + f0 + f8), g1 = *(const f32x4*)(lng + f0 + f8 + 4), b0 = *(const f32x4*)(lnb + f0 + f8), b1 = *(const f32x4*)(lnb + f0 + f8 + 4);
                float x[8] = {bflo(w.x), bfhi(w.x), bflo(w.y), bfhi(w.y), bflo(w.z), bfhi(w.z), bflo(w.w), bfhi(w.w)};
                const float gg[8] = {g0.x, g0.y, g0.z, g0.w, g1.x, g1.y, g1.z, g1.w}, bb[8] = {b0.x, b0.y, b0.z, b0.w, b1.x, b1.y, b1.z, b1.w};
#pragma unroll
                for (int i = 0; i < 8; ++i) bt[(f8 + i) * WLS + q] = (bf16)f2bf((x[i] - mean) * rstd * gg[i] + bb[i]); }
            __syncthreads();
            f32x4 acc[4];
#pragma unroll
            for (int nf = 0; nf < 4; ++nf) acc[nf] = (f32x4){0.f, 0.f, 0.f, 0.f};
#pragma unroll
            for (int ks = 0; ks < 4; ++ks) {
                const bf16x8 wfrag = *(const LAS bf16x8*)(WL + (wave * 16 + fr) * WLS + ks * 32 + fq * 8);
#pragma unroll
                for (int nf = 0; nf < 4; ++nf) { const bf16x8 vfrag = *(const LAS bf16x8*)(bt + (nf * 16 + fr) * WLS + ks * 32 + fq * 8);
                    acc[nf] = __builtin_amdgcn_mfma_f32_16x16x32_bf16(vfrag, wfrag, acc[nf], 0, 0, 0); }
            }
            bf16* urow = U + (row0 + wave * 16 + fr) * 3072 + f0 + 4 * fq;
#pragma unroll
            for (int nf = 0; nf < 4; ++nf) { const v2u uw = *(const v2u*)(urow + nf * 16);
                v2u o; o.x = pk2(bflo(uw.x) * (acc[nf].x + bsp), bfhi(uw.x) * (acc[nf].y + bsp)); o.y = pk2(bflo(uw.y) * (acc[nf].z + bsp), bfhi(uw.y) * (acc[nf].w + bsp));
                *(v2u*)(urow + nf * 16) = o; }
        }
    }
    __syncthreads();
}

__device__ __forceinline__ void phase_attn(Frame& F, char* lds) {
    const attn_body::bf16* Q = (const attn_body::bf16*)WSP(bf16, SC_Q); const attn_body::bf16* KA = (const attn_body::bf16*)WSP(bf16, SC_KA); const attn_body::bf16* VA = (const attn_body::bf16*)WSP(bf16, SC_VA);
    attn_body::bf16* O = (attn_body::bf16*)WSP(bf16, SC_Q);
    for (int un = F.vcu; un < 2048 + 128; un += F.G) {
        int b, h, NT; size_t qrow;
        if (un < 2048) { const int bh = un >> 4, qb = un & 15; b = bh >> 4; h = bh & 15; qrow = (size_t)b * SEQ + qb * 256; NT = KVLEN / 64; }
        else { const int q = un - 2048; b = q >> 4; h = q & 15; qrow = (size_t)RL + b * CTX; NT = CTX / 64; }
        const size_t kvoff = (size_t)b * KVLEN * 256 + (h >> 2) * 64;
        attn_body::attn_unit<8>(Q + qrow * D + h * 64, KA + kvoff, VA + kvoff, O + qrow * D + h * 64, NT, lds);
    }
}

struct Args { const float* in[N_IN]; float* out; unsigned char* ws; int ph_lo, ph_hi; };
constexpr int N_PHASES = 36;
__global__ void __launch_bounds__(NWAVES * 64, 2) hyb_fwd(Args args) {
    extern __shared__ __attribute__((aligned(16))) unsigned char lds[];
    Frame F;
    F.lds = (LAS unsigned char*)lds;
    F.MISC = (volatile LAS unsigned*)(F.lds + MISC_OFF);
    F.G = gridDim.x; { const int bx = blockIdx.x; F.vcu = (F.G % 8 == 0) ? (bx % 8) * (F.G / 8) + bx / 8 : bx; }
    F.in = args.in; F.ws = args.ws; F.out = args.out; F.ctl = (gu32*)(args.ws + WS_CTL);
    for (int u = threadIdx.x; u < (LDS_BYTES - LDSCTL_OFF) / 4; u += NWAVES * 64) ((LAS unsigned*)(F.lds + LDSCTL_OFF))[u] = 0u;
    __syncthreads();
    XcdBarrier bar; bar.bar = (unsigned*)(F.ctl + CW_BAR); bar.x = 0; bar.st = nullptr;
    const int lo = args.ph_lo, hi = args.ph_hi;
    if (hi - lo > 1) bar = xcd_barrier_post((unsigned*)(F.ctl + CW_BAR), F.MISC + 8);
#ifndef PH_LO
#define PH_LO 0
#define PH_HI 99
#endif
#define IN(k) ((k) >= PH_LO && (k) <= PH_HI && lo <= (k) && (k) < hi)
#define SEAM(k) do { if (IN(k) && IN((k) + 1)) xcd_barrier(bar); } while (0)
    LAS unsigned char* ring = F.lds;
    const int cblk = (int)blockIdx.x;
    float* XS = WSP(float, WS_XS); const float* MOD = WSP(float, WS_MOD);
    const char* Hb = (const char*)WSP(bf16, WS_H);

#define MOE_PHASES(L, base) \
    if (IN(base)) { phase_n2<L>(F); } SEAM(base); \
    if (IN((base) + 1)) { phase_topk<L>(F); } SEAM((base) + 1); \
    if (IN((base) + 2)) { SchedMoeUp S{F.G, cblk, (L) >= 3 ? 0 : 128, Hb, (const char*)WSP(bf16, WS_WGU), WSP(int, WS_IDX)}; EpiMoeUp E{WSP(bf16, SC_ACT)}; \
        pg8::gemm_phase<EpiMoeUp, SchedMoeUp, 1, true>(ring, 1024, 2048, 2048, S, E); } SEAM((base) + 2); \
    if (IN((base) + 3)) { SchedMoeDown S{F.G, cblk, (L) >= 3 ? 256 : 272, (const char*)WSP(bf16, SC_ACT), (const char*)WSP(bf16, WS_WD)}; EpiMoeDown E{WSP(bf16, SC_Y), WSP(float, WS_GATE)}; \
        pg8::gemm_phase<EpiMoeDown, SchedMoeDown, 1, false>(ring, 1024, 2048, 2048, S, E); } SEAM((base) + 3);

    if (IN(0)) { phase_prologue(F); } SEAM(0);
    if (IN(1)) { phase_n1<0>(F); } SEAM(1);
    if (IN(2)) { phase_pool(F); } SEAM(2);
    if (IN(3)) { SchedMN S{136, 4, F.G, cblk, 0, (const char*)WSP(bf16, SC_P), (const char*)WSP(bf16, WS_PW), (size_t)256 * 2048, 512, (size_t)65536 * 2};
        EpiRes<true, true> E{XS, INP(I_X), INP(I_CTX), MOD + 0 * 9 * 6144 + 2048, INP(I_POOLS)};
        pg8::gemm_phase<EpiRes<true, true>, SchedMN, 0, false>(ring, 256, 2048, 512, S, E); } SEAM(3);
    MOE_PHASES(0, 4)
    if (IN(8)) { phase_n1<1>(F); convert_moe(F, 1); } SEAM(8);
    if (IN(9)) { SchedMN S{136, 8, F.G, cblk, 0, Hb, (const char*)WSP(bf16, WS_LIN), (size_t)256 * 2048, 0, (size_t)256 * 2048};
        EpiLruIn E{WSP(bf16, SC_YG), WSP(bf16, SC_ZX)};
        pg8::gemm_phase<EpiLruIn, SchedMN, 1, false>(ring, 1024, 2048, 2048, S, E); } SEAM(9);
    if (IN(10)) { phase_conv(F); } SEAM(10);
    if (IN(11)) { SchedMN S{136, 16, F.G, cblk, 1, (const char*)WSP(bf16, SC_XR), (const char*)WSP(bf16, WS_LG), (size_t)256 * 2048, 256, (size_t)256 * 256};
        EpiGates E{WSP(bf16, SC_XR), WSP(bf16, SC_HL0), WSP(bf16, SC_HL1), WSP(bf16, SC_AC0), WSP(bf16, SC_AC1), WSP(f32x2, WS_AGG), INP(I_BA), INP(I_BX), INP(I_LAM)};
        pg8::gemm_phase<EpiGates, SchedMN, 0, false>(ring, 128, 2048, 256, S, E); } SEAM(11);
    if (IN(12)) { phase_carry(F); } SEAM(12);
    if (IN(13)) { phase_lruc(F); } SEAM(13);
    if (IN(14)) { SchedMN S{136, 4, F.G, cblk, 0, (const char*)WSP(bf16, SC_G), (const char*)WSP(bf16, WS_LOUT), (size_t)256 * 2048, 0, (size_t)256 * 2048};
        EpiRes<false, false> E{XS, nullptr, nullptr, MOD + 1 * 9 * 6144 + 2048, nullptr};
        pg8::gemm_phase<EpiRes<false, false>, SchedMN, 0, false>(ring, 1024, 2048, 2048, S, E); } SEAM(14);
    MOE_PHASES(1, 15)
    if (IN(19)) { phase_n1<2>(F); convert_moe(F, 2); } SEAM(19);
    if (IN(20)) { SchedMN S{136, 6, F.G, cblk, 0, Hb, (const char*)WSP(bf16, WS_QKV), (size_t)256 * 2048, 0, (size_t)256 * 2048};
        EpiQKV E{WSP(bf16, SC_Q), WSP(bf16, SC_KA), WSP(bf16, SC_VA), INP(I_QG), INP(I_KG), WSP(f32x2, WS_ROPE)};
        pg8::gemm_phase<EpiQKV, SchedMN, 2, false>(ring, 1024, 2048, 2048, S, E); } SEAM(20);
    if (IN(21)) { phase_attn(F, (char*)lds); } SEAM(21);
    if (IN(22)) { SchedMN S{136, 4, F.G, cblk, 0, (const char*)WSP(bf16, SC_Q), (const char*)WSP(bf16, WS_WO), (size_t)256 * 2048, 0, (size_t)256 * 2048};
        EpiRes<false, false> E{XS, nullptr, nullptr, MOD + 2 * 9 * 6144 + 2048, nullptr};
        pg8::gemm_phase<EpiRes<false, false>, SchedMN, 0, false>(ring, 1024, 2048, 2048, S, E); } SEAM(22);
    MOE_PHASES(2, 23)
    if (IN(27)) { phase_n1<3>(F); convert_moe(F, 3); } SEAM(27);
    if (IN(28)) { SchedMN S{128, 24, F.G, cblk, 0, Hb, (const char*)WSP(bf16, WS_GIN), (size_t)256 * 2048, 0, (size_t)256 * 2048};
        EpiGmlpIn E{WSP(bf16, SC_U), WSP(bf16, SC_V), WSP(f32x2, SC_PSUM)};
        pg8::gemm_phase<EpiGmlpIn, SchedMN, 1, false>(ring, 1024, 2048, 2048, S, E); } SEAM(28);
    if (IN(29)) { phase_spatial(F); } SEAM(29);
    if (IN(30)) { SchedMN S{128, 4, F.G, cblk, 0, (const char*)WSP(bf16, SC_U), (const char*)WSP(bf16, WS_GOUT), (size_t)256 * 6144, 0, (size_t)256 * 6144};
        EpiRes<false, false> E{XS, nullptr, nullptr, MOD + 3 * 9 * 6144 + 2048, nullptr};
        pg8::gemm_phase<EpiRes<false, false>, SchedMN, 0, false>(ring, 3072, 6144, 6144, S, E); } SEAM(30);
    MOE_PHASES(3, 31)
    if (IN(35)) { phase_n1<4>(F); }
#undef IN
#undef SEAM
#undef MOE_PHASES
}

extern "C" void kernel_launch(void* const* d_in, const int* in_sizes, int n_in, void* d_out, int out_size, void* d_ws, size_t ws_size, hipStream_t stream) {
    static int grid = 0;
    if (grid == 0) {
        if (n_in != N_IN || out_size != RL * D || ws_size < WS_END) { fprintf(stderr, "kernel_launch: unexpected shapes (n_in %d out %d ws %zu need %zu)\n", n_in, out_size, ws_size, (size_t)WS_END); grid = -1; return; }
        int dev = 0, cus = 0, per_cu = 0;
        if (hipGetDevice(&dev) != hipSuccess || hipDeviceGetAttribute(&cus, hipDeviceAttributeMultiprocessorCount, dev) != hipSuccess) { grid = -1; return; }
        if (hipFuncSetAttribute((const void*)hyb_fwd, hipFuncAttributeMaxDynamicSharedMemorySize, LDS_BYTES) != hipSuccess) { fprintf(stderr, "kernel_launch: hipFuncSetAttribute failed\n"); grid = -1; return; }
        if (hipOccupancyMaxActiveBlocksPerMultiprocessor(&per_cu, (const void*)hyb_fwd, NWAVES * 64, LDS_BYTES) != hipSuccess || per_cu < 1) { fprintf(stderr, "kernel_launch: occupancy query reports %d\n", per_cu); }
        (void)hipGetLastError();
        grid = cus;
    }
    if (grid < 0) return;
    (void)hipMemsetAsync((char*)d_ws + WS_CTL, 0, CTL_ZERO_BYTES, stream);
    Args a{};
    for (int i = 0; i < N_IN; ++i) a.in[i] = (const float*)d_in[i];
    a.out = (float*)d_out; a.ws = (unsigned char*)d_ws;
#if MK_PER_PHASE
    for (int p = 0; p < N_PHASES; ++p) { a.ph_lo = p; a.ph_hi = p + 1; hipLaunchKernelGGL(hyb_fwd, dim3(grid), dim3(NWAVES * 64), LDS_BYTES, stream, a); }
#else
    a.ph_lo = 0; a.ph_hi = N_PHASES;
    hipLaunchKernelGGL(hyb_fwd, dim3(grid), dim3(NWAVES * 64), LDS_BYTES, stream, a);
#endif
    const hipError_t le = hipPeekAtLastError();
    if (le != hipSuccess) fprintf(stderr, "kernel_launch: launch failed: %s\n", hipGetErrorName(le));
}
```

```cpp
#include <hip/hip_runtime.h>
#include <hip/hip_bf16.h>
#include <cstdio>
#include <cstdint>
#include <cmath>

#ifndef MK_PER_PHASE
#define MK_PER_PHASE 0
#endif

#define GAS __attribute__((address_space(1)))
#define LAS __attribute__((address_space(3)))
typedef unsigned short bf16;
typedef unsigned v4u __attribute__((ext_vector_type(4)));
typedef unsigned v2u __attribute__((ext_vector_type(2)));
typedef float f32x4 __attribute__((ext_vector_type(4)));
typedef float f32x2 __attribute__((ext_vector_type(2)));
typedef short bf16x8 __attribute__((ext_vector_type(8)));
typedef GAS unsigned gu32;
#define RLX_AGENT __ATOMIC_RELAXED, __HIP_MEMORY_SCOPE_AGENT
#define LDS_WAIT() asm volatile("s_waitcnt lgkmcnt(0)" ::: "memory")
#define VM_WAIT() asm volatile("s_waitcnt vmcnt(0)" ::: "memory")

constexpr int D = 1024, NB = 8, SEQ = 4096, CTX = 256;
constexpr int RL = NB * SEQ, RC = NB * CTX, RT = RL + RC;
constexpr int KVLEN = CTX + SEQ;
constexpr int NYL = 65536, NYC = 4096, NY = NYL + NYC;
constexpr float EPS = 1e-6f;
constexpr int NWAVES = 8;

constexpr size_t MiB = 1u << 20;
constexpr size_t WS_CTL = 0, CTL_ZERO_BYTES = 1 * MiB;
constexpr size_t WS_MOD = 1 * MiB;
constexpr size_t WS_ROPE = WS_MOD + 900 * 1024;
constexpr size_t WS_SPT = WS_ROPE + 8192;
constexpr size_t WS_PW = 2 * MiB;
constexpr size_t WS_LIN = WS_PW + 512 * 1024;
constexpr size_t WS_LG = WS_LIN + 4 * MiB;
constexpr size_t WS_LOUT = WS_LG + 1 * MiB;
constexpr size_t WS_QKV = WS_LOUT + 2 * MiB;
constexpr size_t WS_WO = WS_QKV + 3 * MiB;
constexpr size_t WS_GIN = WS_WO + 2 * MiB;
constexpr size_t WS_GS = WS_GIN + 12 * MiB;
constexpr size_t WS_GOUT = WS_GS + 128 * 1024;
constexpr size_t WS_WGU = 34 * MiB;
constexpr size_t WS_WD = WS_WGU + 32 * MiB;
constexpr size_t WSET = 48 * MiB;
constexpr size_t WS_XS = 130 * MiB;
constexpr size_t WS_H = 266 * MiB;
constexpr size_t WS_AFF = 334 * MiB;
constexpr size_t WS_INV = WS_AFF + (size_t)RT * 16 * 4;
constexpr size_t WS_IDX = WS_INV + (size_t)RT * 16 * 4;
constexpr size_t WS_GATE = WS_IDX + (size_t)NY * 4;
constexpr size_t WS_AGG = 340 * MiB;
constexpr size_t WS_CARRY = WS_AGG + (size_t)2 * 544 * 1024 * 8;
constexpr size_t WS_SCR = 354 * MiB;
static_assert(WS_GOUT + 6 * MiB <= WS_WGU && WS_GATE + (size_t)NY * 4 <= WS_AGG && WS_CARRY + (size_t)2 * 544 * 1024 * 4 <= WS_SCR, "ws map");
constexpr size_t SC_ACT = WS_SCR, SC_Y = WS_SCR + 136 * MiB;
constexpr size_t SC_P = WS_SCR;
constexpr size_t SC_YG = WS_SCR, SC_ZX = WS_SCR + 68 * MiB, SC_XR = WS_SCR + 136 * MiB;
constexpr size_t SC_HL0 = WS_SCR + 204 * MiB, SC_HL1 = WS_SCR + 272 * MiB, SC_AC0 = WS_SCR + 340 * MiB, SC_AC1 = WS_SCR + 408 * MiB;
constexpr size_t SC_G = SC_ZX;
constexpr size_t SC_Q = WS_SCR, SC_KA = WS_SCR + 68 * MiB, SC_VA = WS_SCR + 85 * MiB;
constexpr size_t SC_U = WS_SCR, SC_V = WS_SCR + 192 * MiB, SC_PSUM = WS_SCR + 384 * MiB;
constexpr size_t WS_END = WS_SCR + 476 * MiB;
constexpr int CW_BAR = 4096;

constexpr int RING_BYTES = 131072;
constexpr int LDSCTL_OFF = RING_BYTES, MISC_OFF = LDSCTL_OFF + 320;
constexpr int LDS_BYTES = 147456;

__device__ __forceinline__ unsigned f2bf(float f) { unsigned u = __builtin_bit_cast(unsigned, f); return (u + 0x7fffu + ((u >> 16) & 1u)) >> 16; }
typedef __bf16 hwbf16x2 __attribute__((ext_vector_type(2)));
__device__ __forceinline__ unsigned pk2(float lo, float hi) { const f32x2 v = {lo, hi}; return __builtin_bit_cast(unsigned, __builtin_convertvector(v, hwbf16x2)); }
__device__ __forceinline__ unsigned pk4_fp8(float a, float b, float c, float d) {
    int w = 0; w = __builtin_amdgcn_cvt_pk_fp8_f32(a, b, w, false); w = __builtin_amdgcn_cvt_pk_fp8_f32(c, d, w, true); return (unsigned)w; }
__device__ __forceinline__ float sat8(float x) { return __builtin_amdgcn_fmed3f(x, -448.0f, 448.0f); }
__device__ __forceinline__ unsigned pk4_fp8_sat(float a, float b, float c, float d) { return pk4_fp8(sat8(a), sat8(b), sat8(c), sat8(d)); }
constexpr float W8_SCALE = 64.0f, W8_INV = 1.0f / 64.0f;
constexpr float Y8_SCALE = 16.0f, Y8_INV = 1.0f / 16.0f;
__device__ __forceinline__ float bflo(unsigned w) { return __builtin_bit_cast(float, w << 16); }
__device__ __forceinline__ float bfhi(unsigned w) { return __builtin_bit_cast(float, w & 0xffff0000u); }
__device__ __forceinline__ int opaque_tid(int wv) { int l; asm volatile("v_mbcnt_lo_u32_b32 %0, -1, 0\n\tv_mbcnt_hi_u32_b32 %0, -1, %0" : "=v"(l)); return (wv << 6) | l; }
__device__ __forceinline__ f32x4 bf4(v2u w) { return (f32x4){bflo(w.x), bfhi(w.x), bflo(w.y), bfhi(w.y)}; }
__device__ __forceinline__ float wave_sum(float v) {
#pragma unroll
    for (int o = 1; o < 64; o <<= 1) v += __shfl_xor(v, o);
    return v;
}
__device__ __forceinline__ float gelu_tanh(float x) {
    const float t = x * (1.0f + 0.044715f * x * x);
    return x * __builtin_amdgcn_rcpf(1.0f + __builtin_amdgcn_exp2f(-2.3022082f * t));
}
__device__ __forceinline__ f32x2 gelu_tanh2(f32x2 x) {
    const f32x2 u = x * x, t = u * (-0.10294323f) + (-2.3022082f), a = x * t;
    f32x2 e; e.x = __builtin_amdgcn_exp2f(a.x); e.y = __builtin_amdgcn_exp2f(a.y);
    const f32x2 d = e + 1.0f; f32x2 r; r.x = __builtin_amdgcn_rcpf(d.x); r.y = __builtin_amdgcn_rcpf(d.y);
    return x * r;
}
__device__ __forceinline__ void gelu4(f32x4& v) { const f32x2 a = gelu_tanh2((f32x2){v.x, v.y}), b = gelu_tanh2((f32x2){v.z, v.w}); v = (f32x4){a.x, a.y, b.x, b.y}; }
__device__ __forceinline__ float sigmoid_f(float x) { return __builtin_amdgcn_rcpf(1.0f + __builtin_amdgcn_exp2f(-1.4426950409f * x)); }

#define XB_TMO      128
#define XB_XCNT(j)  (256  + 64 * (j))
#define XB_XSUB(j)  (1280 + 64 * (j))
#define XB_XGEN(j)  (2304 + 64 * (j))
#define XB_TOP      3328
#define XB_TOPGEN   3392
#define XCD_BAR_WORDS 3456
#define XB_SPIN_CAP (1u << 18)
__device__ __forceinline__ unsigned xb_ld(unsigned* p)              { return __hip_atomic_load(p, __ATOMIC_RELAXED, __HIP_MEMORY_SCOPE_AGENT); }
__device__ __forceinline__ unsigned xb_add(unsigned* p, unsigned v) { return __hip_atomic_fetch_add(p, v, __ATOMIC_RELAXED, __HIP_MEMORY_SCOPE_AGENT); }
__device__ __forceinline__ unsigned xb_xcc_id() { return (unsigned)__builtin_amdgcn_s_getreg((3 << 11) | 20) & 0xFu; }
#define XB_SPIN(cond, bar) do { unsigned _sp = 0; while (cond) { __builtin_amdgcn_s_sleep(1); \
    if ((++_sp & 255u) == 0u) { if (xb_ld(&(bar)[XB_TMO])) break; if (_sp > XB_SPIN_CAP) { atomicAdd(&(bar)[XB_TMO], 1u); break; } } } } while (0)
struct XcdBarrier { unsigned* bar; unsigned x; volatile LAS unsigned* st; int wv; };
__device__ __forceinline__ bool xb_thread0(int wv) { return wv == 0 && __builtin_amdgcn_mbcnt_hi(~0u, __builtin_amdgcn_mbcnt_lo(~0u, 0u)) == 0u; }
__device__ __forceinline__ XcdBarrier xcd_barrier_post(unsigned* bar, volatile LAS unsigned* st, int wv) {
    XcdBarrier b; b.bar = bar; b.x = xb_xcc_id(); b.st = st; b.wv = wv;
    if (xb_thread0(wv)) (void)xb_add(&bar[XB_XCNT(b.x)], 1u);
    return b;
}
__device__ __forceinline__ void xcd_barrier_complete(unsigned* bar, unsigned x, unsigned& nloc, unsigned& nx) {
    const unsigned G = gridDim.x * gridDim.y * gridDim.z;
    unsigned sum, cnt, mine, sp = 0u;
    for (;;) {
        sum = 0u; cnt = 0u; mine = 0u;
#pragma unroll
        for (unsigned j = 0; j < 16; ++j) { const unsigned c = xb_ld(&bar[XB_XCNT(j)]); sum += c; cnt += (c > 0u) ? 1u : 0u; mine = (j == x) ? c : mine; }
        if (sum == G) break;
        __builtin_amdgcn_s_sleep(1);
        if ((++sp & 255u) == 0u) { if (xb_ld(&bar[XB_TMO])) break; if (sp > XB_SPIN_CAP) { atomicAdd(&bar[XB_TMO], 1u); break; } }
    }
    nloc = mine > 0u ? mine : 1u; nx = cnt > 0u ? cnt : 1u;
}
__device__ __forceinline__ void xcd_barrier(const XcdBarrier& b) {
    asm volatile("s_waitcnt vmcnt(0)" ::: "memory");
    __syncthreads();
    if (xb_thread0(b.wv)) {
        unsigned* bar = b.bar;
        __builtin_amdgcn_s_waitcnt(0);
        unsigned nloc = b.st[0], nx = b.st[1];
        if (nloc == 0u) { xcd_barrier_complete(bar, b.x, nloc, nx); b.st[0] = nloc; b.st[1] = nx; }
        const unsigned old = xb_add(&bar[XB_XSUB(b.x)], 1u);
        const unsigned gen = old / nloc;
        if (old + 1u == (gen + 1u) * nloc) {
            __builtin_amdgcn_fence(__ATOMIC_RELEASE, "agent");
            asm volatile("s_waitcnt vmcnt(0)" ::: "memory");
            const unsigned og = xb_add(&bar[XB_TOP], 1u);
            const unsigned tg = og / nx;
            if (og + 1u == (tg + 1u) * nx) xb_add(&bar[XB_TOPGEN], 1u);
            else XB_SPIN(xb_ld(&bar[XB_TOPGEN]) == tg, bar);
            __builtin_amdgcn_fence(__ATOMIC_ACQUIRE, "agent");
            xb_add(&bar[XB_XGEN(b.x)], 1u);
            asm volatile("s_waitcnt vmcnt(0)" ::: "memory");
        } else {
            XB_SPIN(xb_ld(&bar[XB_XGEN(b.x)]) == gen, bar);
            __builtin_amdgcn_fence(__ATOMIC_ACQUIRE, "agent");
            asm volatile("s_waitcnt vmcnt(0)" ::: "memory");
        }
    }
    __syncthreads();
}

namespace pg8 {
constexpr int BM = 256, BK = 64, HALF = 128, HTB = HALF * BK * 2, STAGE_BYTES = 8 * HTB, NXCD = 8, WGM = 8;
__host__ __device__ __forceinline__ int lds_byte(int r, int c) { const int st = (r >> 4) * 2 + (c >> 5), rr = r & 15, cc = c & 31, ob = rr * 64 + cc * 2; return st * 1024 + (ob ^ (((ob >> 9) & 1) << 5)); }
__host__ __device__ __forceinline__ void stage_rc(int b, int& R, int& C) { const int st = b / 1024, sb = b % 1024, swz = sb ^ (((sb >> 9) & 1) << 5); R = (st >> 1) * 16 + swz / 64; C = (st & 1) * 32 + (swz % 64) / 2; }
__host__ __device__ __forceinline__ int perm32(int rho) { const int n = rho >> 4, i = rho & 15; return 8 * (i >> 2) + 4 * n + (i & 3); }

struct Unit { const char* A; const char* B; const int* rows; int pm, pn; int half, row0; };

__device__ __forceinline__ bool static_order_l(long L, int nM, int nN, int& pm, int& pn) {
    const int nwg = nM * nN; if (L >= nwg) return false;
    int wgid = (int)L; { const int q = nwg / NXCD, r = nwg % NXCD, xcd = wgid % NXCD, off = wgid / NXCD; wgid = (xcd < r ? xcd * (q + 1) : r * (q + 1) + (xcd - r) * q) + off; }
    const int nig = WGM * nN, gid = wgid / nig, fm = gid * WGM, gsz = (nM - fm) < WGM ? (nM - fm) : WGM;
    pm = fm + ((wgid % nig) % gsz); pn = (wgid % nig) / gsz; return true;
}
__device__ __forceinline__ bool static_order(int i, int G, int c, int nM, int nN, int& pm, int& pn) { return static_order_l((long)i * G + c, nM, nN, pm, pn); }

typedef int v8i_t __attribute__((ext_vector_type(8)));
typedef int v4i_t __attribute__((ext_vector_type(4)));
__device__ __forceinline__ v8i_t cat8(bf16x8 lo, bf16x8 hi) { return __builtin_shufflevector(__builtin_bit_cast(v4i_t, lo), __builtin_bit_cast(v4i_t, hi), 0, 1, 2, 3, 4, 5, 6, 7); }
__device__ __forceinline__ const char* uptr(const char* p) {
    const unsigned long long v = (unsigned long long)p; const unsigned lo = __builtin_amdgcn_readfirstlane((unsigned)v), hi = __builtin_amdgcn_readfirstlane((unsigned)(v >> 32));
    return (const char*)(((unsigned long long)hi << 32) | lo); }
template <class Epi, class Sched, int PERM, bool GATHER, bool FP8 = false>
__device__ __forceinline__ void gemm_phase(const int wv, LAS unsigned char* lds, const int K, const int lda  , const int ldb  , const Sched& S, const Epi& E) {
    const int tid = opaque_tid(wv), wid = __builtin_amdgcn_readfirstlane(tid >> 6), lane = tid & 63, wr = wid >> 2, wc = wid & 3, fr = lane & 15, fq = lane >> 4;
    int nt = K / (FP8 ? 2 * BK : BK); asm volatile("" : "+s"(nt));
    unsigned voffB[2];
#pragma unroll
    for (int i = 0; i < 2; ++i) { int R, C; stage_rc(tid * 16 + i * 8192, R, C);
        const int Rb = (PERM == 0) ? R : (PERM == 1) ? ((R & ~31) + perm32(R & 31)) : (64 * (R >> 5) + perm32(R & 31));
        voffB[i] = (unsigned)(Rb * ldb + C * 2); }
    const unsigned hstepB = (unsigned)((PERM == 2 ? 32 : 128) * ldb), hstepA = (unsigned)(128 * lda);
    const size_t kstep = (size_t)(BK * 2);
    const unsigned ldsw = (unsigned)wid * 1024u;
    const int aoffk0 = FP8 ? lds_byte(wr * 64 + fr, fq * 16) : lds_byte(wr * 64 + fr, fq * 8), aoffk1 = aoffk0 + (FP8 ? 16 : 1024);
    const int boffk0 = FP8 ? lds_byte(wc * 32 + fr, fq * 16) : lds_byte(wc * 32 + fr, fq * 8), boffk1 = boffk0 + (FP8 ? 16 : 1024); (void)boffk1;
    int boffB = boffk0 + 4 * HTB; asm volatile("" : "+v"(boffB));
#define PG8_SA(b, h) (((b) * 2 + (h)) * HTB)
#define PG8_SB(b, h) ((4 + (b) * 2 + (h)) * HTB)
#define PG8_STAGE2(bufoff, gbase_, o0, o1) do { const char* gbase = uptr(gbase_); unsigned o0_ = (o0), o1_ = (o1); asm volatile("" : "+v"(o0_), "+v"(o1_));   \
        __builtin_amdgcn_global_load_lds((const unsigned*)((const char*)(gbase) + o0_), (LAS unsigned*)(lds + (bufoff) + ldsw), 16, 0, 0); \
        __builtin_amdgcn_global_load_lds((const unsigned*)((const char*)(gbase) + o1_), (LAS unsigned*)(lds + (bufoff) + ldsw + 8192), 16, 0, 0); } while (0)
#define PG8_STAGEB(bufoff, gbase, h) PG8_STAGE2(bufoff, (gbase) + (size_t)(h) * hstepB, voffB[0], voffB[1])
#define PG8_STAGEA(bufoff, gbase, h) do { if (GATHER) PG8_STAGE2(bufoff, gbase, cO[2 * (h)], cO[2 * (h) + 1]); else PG8_STAGE2(bufoff, (gbase) + (size_t)(h) * hstepA, cO[0], cO[1]); } while (0)
#define PG8_LDA(dst, b, h) do { _Pragma("unroll") for (int m = 0; m < 4; ++m) { const bf16x8 l0_ = *(const LAS bf16x8*)(lds + PG8_SA(b, h) + aoffk0 + m * 2048), l1_ = *(const LAS bf16x8*)(lds + PG8_SA(b, h) + aoffk1 + m * 2048); \
        if constexpr (FP8) dst##8[m] = cat8(l0_, l1_); else { dst[m][0] = l0_; dst[m][1] = l1_; } } } while (0)
#define PG8_LDB(dst, b, h) do { _Pragma("unroll") for (int n = 0; n < 2; ++n) { const bf16x8 l0_ = *(const LAS bf16x8*)(lds + boffB + (PG8_SB(b, h) - 4 * HTB + n * 2048)), l1_ = *(const LAS bf16x8*)(lds + boffB + (PG8_SB(b, h) - 4 * HTB + n * 2048 + (FP8 ? 16 : 1024))); \
        if constexpr (FP8) dst##8[n] = cat8(l0_, l1_); else { dst[n][0] = l0_; dst[n][1] = l1_; } } } while (0)
#define PG8_MMA(ai, bj, At, Bt) do { __builtin_amdgcn_s_setprio(1); _Pragma("unroll") for (int m = 0; m < 4; ++m) _Pragma("unroll") for (int n = 0; n < 2; ++n) { \
        if constexpr (FP8) acc[ai][bj][m][n] = __builtin_amdgcn_mfma_scale_f32_16x16x128_f8f6f4(Bt##8[n], At##8[m], acc[ai][bj][m][n], 0, 0, 0, 0, 0, 0); \
        else { _Pragma("unroll") for (int k = 0; k < 2; ++k) acc[ai][bj][m][n] = __builtin_amdgcn_mfma_f32_16x16x32_bf16(Bt[n][k], At[m][k], acc[ai][bj][m][n], 0, 0, 0); } } \
        __builtin_amdgcn_s_setprio(0); } while (0)
#define PG8_WAIT_V(n) asm volatile("s_waitcnt vmcnt(" #n ")" ::: "memory")
#define PG8_WAIT_L(n) asm volatile("s_waitcnt lgkmcnt(" #n ")" ::: "memory")
#define PG8_BAR __builtin_amdgcn_s_barrier()
#define PG8_SCHED __builtin_amdgcn_sched_barrier(0)
#define PG8_AOFFS(dst, u) do { const int tq_ = GATHER ? opaque_tid(wv) : tid;   \
        _Pragma("unroll") for (int i = 0; i < 2; ++i) { int R_, C_; stage_rc(tq_ * 16 + i * 8192, R_, C_); _Pragma("unroll") for (int h = 0; h < 2; ++h) { \
        if (GATHER) dst[h * 2 + i] = (unsigned)((u).rows[h * 128 + R_]) * (unsigned)lda + (unsigned)(C_ * 2); \
        else dst[h * 2 + i] = (unsigned)((h * 128 + R_) * lda + C_ * 2); } } } while (0)
    Unit cur, nxt; int ui = 0;
    if (!S.next(0, cur)) return;
    f32x4 acc[2][2][4][2];
#pragma unroll
    for (int a = 0; a < 2; ++a)
#pragma unroll
        for (int b = 0; b < 2; ++b)
#pragma unroll
            for (int m = 0; m < 4; ++m)
#pragma unroll
                for (int n = 0; n < 2; ++n) acc[a][b][m][n] = (f32x4){0.f, 0.f, 0.f, 0.f};
    bf16x8 At[4][2], B0[2][2], B1[2][2]; v8i_t At8[4], B08[2], B18[2];
    const char* cA = cur.A; const char* cB = cur.B;
    unsigned cO[4], nO[4];
    PG8_AOFFS(cO, cur);
    PG8_STAGEB(PG8_SB(0, 0), cB, 0); PG8_STAGEB(PG8_SB(0, 1), cB, 1); PG8_STAGEA(PG8_SA(0, 0), cA, 0); PG8_STAGEA(PG8_SA(0, 1), cA, 1);
    if (wr == 1) PG8_BAR;
    PG8_WAIT_V(2); PG8_BAR;
    PG8_STAGEB(PG8_SB(1, 0), cB + kstep, 0); PG8_STAGEA(PG8_SA(1, 0), cA + kstep, 0); PG8_STAGEB(PG8_SB(1, 1), cB + kstep, 1);
    PG8_WAIT_V(6); PG8_BAR;
    for (;;) {
        const bool has_next = S.next(ui + 1, nxt);
        const bool hf = __builtin_amdgcn_readfirstlane(cur.half) != 0;
        const char* nA = has_next ? nxt.A : cA; const char* nB = has_next ? nxt.B : cB;
        if (GATHER) { if (has_next) { PG8_AOFFS(nO, nxt); } else {
#pragma unroll
            for (int q = 0; q < 4; ++q) nO[q] = cO[q]; } }
#pragma unroll 1
        for (int t = 0; t < nt; t += 2) {
            const bool last = (t == nt - 2);
            const char* a1 = cA + (size_t)(t + 1) * kstep;
            const char* a2 = last ? nA : cA + (size_t)(t + 2) * kstep; const char* b2 = last ? nB : cB + (size_t)(t + 2) * kstep;
            const char* a3 = a2 + kstep; const char* b3 = b2 + kstep;
            PG8_LDB(B0, 0, 0); PG8_LDB(B1, 0, 1); PG8_SCHED; PG8_LDA(At, 0, 0); PG8_STAGEA(PG8_SA(1, 1), a1, 1);
            if (GATHER) { if (last) {
#pragma unroll
                for (int q = 0; q < 4; ++q) cO[q] = nO[q]; } }
            PG8_WAIT_V(8); PG8_WAIT_L(0); PG8_BAR; PG8_MMA(0, 0, At, B0); PG8_MMA(0, 1, At, B1); PG8_BAR; PG8_SCHED;
            if (!hf) PG8_LDA(At, 0, 1);
            PG8_STAGEB(PG8_SB(0, 0), b2, 0); PG8_STAGEB(PG8_SB(0, 1), b2, 1); PG8_STAGEA(PG8_SA(0, 0), a2, 0);
            PG8_WAIT_V(8); PG8_WAIT_L(0); PG8_BAR; if (!hf) { PG8_MMA(1, 0, At, B0); PG8_MMA(1, 1, At, B1); } PG8_BAR; PG8_SCHED;
            PG8_LDB(B0, 1, 0); PG8_LDB(B1, 1, 1); PG8_SCHED; PG8_LDA(At, 1, 0); PG8_STAGEA(PG8_SA(0, 1), a2, 1);
            PG8_WAIT_V(8); PG8_WAIT_L(0); PG8_BAR; PG8_MMA(0, 0, At, B0); PG8_MMA(0, 1, At, B1); PG8_BAR; PG8_SCHED;
            if (!hf) PG8_LDA(At, 1, 1);
            PG8_STAGEB(PG8_SB(1, 0), b3, 0); PG8_STAGEB(PG8_SB(1, 1), b3, 1); PG8_STAGEA(PG8_SA(1, 0), a3, 0);
            PG8_WAIT_V(8); PG8_WAIT_L(0); PG8_BAR; if (!hf) { PG8_MMA(1, 0, At, B0); PG8_MMA(1, 1, At, B1); } PG8_BAR; PG8_SCHED;
        }
        if (wr == 0) PG8_BAR;
        { const int tz = opaque_tid(wv), lz = tz & 63; E(acc, cur, wr, wc, lz & 15, lz >> 4); }
        if (!has_next) break;
#pragma unroll
        for (int a = 0; a < 2; ++a)
#pragma unroll
            for (int b = 0; b < 2; ++b)
#pragma unroll
                for (int m = 0; m < 4; ++m)
#pragma unroll
                    for (int n = 0; n < 2; ++n) acc[a][b][m][n] = (f32x4){0.f, 0.f, 0.f, 0.f};
        cur = nxt; cA = nA; cB = nB; ++ui;
        if (GATHER) {
#pragma unroll
            for (int q = 0; q < 4; ++q) cO[q] = nO[q]; }
        if (wr == 1) PG8_BAR;
    }
    PG8_WAIT_V(0);
    PG8_BAR;
#undef PG8_SA
#undef PG8_SB
#undef PG8_STAGE2
#undef PG8_STAGEB
#undef PG8_STAGEA
#undef PG8_LDA
#undef PG8_LDB
#undef PG8_MMA
#undef PG8_WAIT_V
#undef PG8_WAIT_L
#undef PG8_BAR
#undef PG8_SCHED
#undef PG8_AOFFS
}
}

namespace attn_body {
using bf16=__hip_bfloat16;
using bf16x8=__attribute__((ext_vector_type(8)))short;
using s16x4=__attribute__((ext_vector_type(4)))short;
using f32x16=__attribute__((ext_vector_type(16)))float;
using u32x4=__attribute__((ext_vector_type(4)))unsigned;
constexpr int D=64,DMQ=1024,DMK=256;
constexpr int NW=8,QBLK=32,QB=QBLK*NW,KVBLK=64;
__device__ __forceinline__ int crow(int r,int hi){return (r&3)+8*(r>>2)+4*hi;}
#define SBAR() __builtin_amdgcn_sched_barrier(0)
constexpr int NSLOT=3, SLOTB=8192;
constexpr int LDS_K=0, LDS_V=NSLOT*SLOTB, LDS_WS=2*NSLOT*SLOTB, LDS_OST=LDS_WS+NW*64*4, LDS_BYTES=LDS_OST+NW*4096;
constexpr float C2=0.125f*1.4426950408889634f;
__device__ __forceinline__ void glds16(const void*gsrc,unsigned lds_dst){unsigned keep;
  asm volatile("s_mov_b32 %0, m0\n\ts_mov_b32 m0, %2\n\ts_nop 0\n\tglobal_load_lds_dwordx4 %1, off\n\ts_mov_b32 m0, %0":"=&s"(keep):"v"(gsrc),"s"(lds_dst):"memory");}
__device__ __forceinline__ float max3f(float a,float b,float c){float r;asm("v_max3_f32 %0, %1, %2, %3":"=v"(r):"v"(a),"v"(b),"v"(c));return r;}
__device__ __forceinline__ float max2f(float a,float b){float r;asm("v_max_f32_e32 %0, %1, %2":"=v"(r):"v"(a),"v"(b));return r;}
__device__ __forceinline__ float fadd_s(float a,float b){float r;asm("v_add_f32_e32 %0, %1, %2":"=v"(r):"v"(a),"v"(b));return r;}
__device__ __forceinline__ float fsub_s(float a,float b){float r;asm("v_sub_f32_e32 %0, %1, %2":"=v"(r):"v"(a),"v"(b));return r;}
typedef float f32x2_t __attribute__((ext_vector_type(2))); typedef __bf16 bf16x2_t __attribute__((ext_vector_type(2)));
__device__ __forceinline__ unsigned cvtpk_s(float lo,float hi){f32x2_t v={lo,hi};bf16x2_t b=__builtin_convertvector(v,bf16x2_t);return __builtin_bit_cast(unsigned,b);}
#define WAIT_BAR(N) asm volatile("s_waitcnt vmcnt(" #N ") lgkmcnt(0)\n\ts_barrier":::"memory")

__device__ __forceinline__ void qkt(f32x16&p0,f32x16&p1,const char*Kslot,const bf16x8*qr,const f32x16&negm,int r32,int hi){
  const char*kb=Kslot+hi*1024+r32*16;
  #pragma unroll
  for(int d0=0;d0<4;++d0){
    const bf16x8 b0=*reinterpret_cast<const bf16x8*>(kb+d0*2048);
    const bf16x8 b1=*reinterpret_cast<const bf16x8*>(kb+d0*2048+512);
    if(d0==0){p0=__builtin_amdgcn_mfma_f32_32x32x16_bf16(b0,qr[0],negm,0,0,0);p1=__builtin_amdgcn_mfma_f32_32x32x16_bf16(b1,qr[0],negm,0,0,0);}
    else{p0=__builtin_amdgcn_mfma_f32_32x32x16_bf16(b0,qr[d0],p0,0,0,0);p1=__builtin_amdgcn_mfma_f32_32x32x16_bf16(b1,qr[d0],p1,0,0,0);}}
}
typedef __attribute__((address_space(3))) const char* lds_cptr;
typedef short v4i16_t __attribute__((ext_vector_type(4)));
__device__ __forceinline__ void kload8(bf16x8*kf,lds_cptr kp){
  kf[0]=*(const __attribute__((address_space(3))) bf16x8*)(kp);      kf[1]=*(const __attribute__((address_space(3))) bf16x8*)(kp+512);
  kf[2]=*(const __attribute__((address_space(3))) bf16x8*)(kp+2048); kf[3]=*(const __attribute__((address_space(3))) bf16x8*)(kp+2560);
  kf[4]=*(const __attribute__((address_space(3))) bf16x8*)(kp+4096); kf[5]=*(const __attribute__((address_space(3))) bf16x8*)(kp+4608);
  kf[6]=*(const __attribute__((address_space(3))) bf16x8*)(kp+6144); kf[7]=*(const __attribute__((address_space(3))) bf16x8*)(kp+6656);
}
__device__ __forceinline__ void kload2(bf16x8*kf,lds_cptr kp,int j){ kf[2*j]=*(const __attribute__((address_space(3))) bf16x8*)(kp+j*2048); kf[2*j+1]=*(const __attribute__((address_space(3))) bf16x8*)(kp+j*2048+512); }
__device__ __forceinline__ s16x4 vtr(lds_cptr p){ return __builtin_bit_cast(s16x4,__builtin_amdgcn_ds_read_tr16_b64_v4i16((__attribute__((address_space(3))) v4i16_t*)p)); }
__device__ __forceinline__ float rowmax(const f32x16&p0,const f32x16&p1){
  float a=max3f(p0[0],p0[1],p1[0]),b=max3f(p0[2],p0[3],p1[1]);a=max3f(a,p1[2],p1[3]);
  #pragma unroll
  for(int r=4;r<16;r+=4){a=max3f(a,p0[r],p0[r+1]);b=max3f(b,p0[r+2],p0[r+3]);a=max3f(a,p1[r],p1[r+1]);b=max3f(b,p1[r+2],p1[r+3]);}
  const float m=max2f(a,b);
  auto rr=__builtin_amdgcn_permlane32_swap(__float_as_uint(m),__float_as_uint(m),false,false);
  return max2f(__uint_as_float(rr[0]),__uint_as_float(rr[1]));
}
__device__ __forceinline__ void pv(f32x16*o,int vb,bf16x8 pa0,bf16x8 pa1,bf16x8 pa2,bf16x8 pa3){
  #pragma unroll
  for(int d0=0;d0<2;++d0){s16x4 lo[4],hi[4];
    #pragma unroll
    for(int ks=0;ks<4;++ks){
      asm volatile("ds_read_b64_tr_b16 %0,%1 offset:%c2":"=&v"(lo[ks]):"v"(vb),"i"(d0*4096+ks*1024):"memory");
      asm volatile("ds_read_b64_tr_b16 %0,%1 offset:%c2":"=&v"(hi[ks]):"v"(vb),"i"(d0*4096+ks*1024+512):"memory");}
    asm volatile("s_waitcnt lgkmcnt(0)":::"memory");SBAR();
    #define PK(k) (bf16x8){lo[k][0],lo[k][1],lo[k][2],lo[k][3],hi[k][0],hi[k][1],hi[k][2],hi[k][3]}
    o[d0]=__builtin_amdgcn_mfma_f32_32x32x16_bf16(pa0,PK(0),o[d0],0,0,0);
    o[d0]=__builtin_amdgcn_mfma_f32_32x32x16_bf16(pa1,PK(1),o[d0],0,0,0);
    o[d0]=__builtin_amdgcn_mfma_f32_32x32x16_bf16(pa2,PK(2),o[d0],0,0,0);
    o[d0]=__builtin_amdgcn_mfma_f32_32x32x16_bf16(pa3,PK(3),o[d0],0,0,0);
    #undef PK
  }
}

#ifndef ATTN_STORE16
#define ATTN_STORE16(p,v) (*(u32x4*)(p)=(v))
#endif
template<int THRL> __device__ __forceinline__ void attn_unit(const int wv,const bf16*Qw0,const bf16*__restrict__ Kh,const bf16*__restrict__ Vh,bf16*Ow0,const int NT,char*shm){
  const int tid=opaque_tid(wv); const int lane=tid&63,r32=lane&31,hi=lane>>5; const int wid=__builtin_amdgcn_readfirstlane(tid>>6);
  const bf16*Qw=Qw0+(long)(wid*QBLK)*DMQ;
  const unsigned lds0=(unsigned)(uintptr_t)shm;
  float*wsf=(float*)(shm+LDS_WS)+wid*64;
  const bf16*ksrc=Kh+(long)lane*DMK+wid*8;
  const bf16*vsrc=Vh+(long)(16*(wid&3)+(lane>>2))*DMK+(wid>>2)*32+(lane&3)*8;
  const unsigned kdst=lds0+LDS_K+wid*1024, vdst=lds0+LDS_V+wid*1024;
  #define DMA_K(t,slot) glds16(ksrc+(long)(t)*KVBLK*DMK,(unsigned)__builtin_amdgcn_readfirstlane(kdst+(slot)))
  #define DMA_V(t,slot) glds16(vsrc+(long)(t)*KVBLK*DMK,(unsigned)__builtin_amdgcn_readfirstlane(vdst+(slot)))
  const int vb0=(int)(lds0+LDS_V)+((lane>>4)&1)*32+(lane&3)*8+(4*hi+((lane&15)>>2))*64;
  const char*Kbase=shm+LDS_K; bf16x8 kf[8];
  const lds_cptr shm3=(lds_cptr)shm; const lds_cptr kp0=shm3+LDS_K+hi*1024+r32*16; const lds_cptr vp0=shm3+LDS_V+((lane>>4)&1)*32+(lane&3)*8+(4*hi+((lane&15)>>2))*64;
  DMA_K(0,0);DMA_V(0,0);DMA_K(1,SLOTB);
  bf16x8 qr[4];
  #pragma unroll
  for(int d0=0;d0<4;++d0)qr[d0]=*reinterpret_cast<const bf16x8*>(&Qw[(long)r32*DMQ+d0*16+hi*8]);
  float mhat=0.f,l_reg=0.f;f32x16 o[2];o[0]=f32x16{};o[1]=f32x16{};f32x16 negm=f32x16{};asm volatile("":"+v"(negm));
  #define CMASK(P0,P1,t) do{}while(0)
  bool resc=false;
  #define START(P0,P1) do{ const float rm=rowmax(P0,P1); resc=false; \
    { const float dl=rm; mhat=fadd_s(mhat,dl); \
      _Pragma("unroll") for(int r=0;r<16;++r){P0[r]=fsub_s(P0[r],dl);P1[r]=fsub_s(P1[r],dl);} \
      _Pragma("unroll") for(int r=0;r<16;++r)negm[r]=-mhat; asm volatile("":"+v"(negm)); } \
    _Pragma("unroll") for(int r=0;r<16;++r)P0[r]=__builtin_amdgcn_exp2f(P0[r]); }while(0)
  #define RESC() do{ if(resc){ asm volatile("s_waitcnt lgkmcnt(0)":::"memory"); \
      _Pragma("unroll") for(int d_=0;d_<2;++d_) _Pragma("unroll") for(int r=0;r<16;++r)o[d_][r]*=wsf[crow(r,hi)]; } }while(0)
  f32x16 pA0,pA1,pB0,pB1;
  int sl_prev=0,sl_cur=0,sl_next=SLOTB;
  #define ROT() do{sl_prev=sl_cur;sl_cur=sl_next;sl_next=(sl_next==(NSLOT-1)*SLOTB)?0:sl_next+SLOTB;}while(0)
  DMA_K(2,2*SLOTB);
  WAIT_BAR(3);
  qkt(pA0,pA1,Kbase,qr,negm,r32,hi);asm volatile("s_nop 15\n\ts_nop 7":"+v"(pA0),"+v"(pA1));CMASK(pA0,pA1,0);
  START(pA0,pA1);
  _Pragma("unroll") for(int r=0;r<16;++r)pA1[r]=__builtin_amdgcn_exp2f(pA1[r]);
  WAIT_BAR(0);
  DMA_K(3,0);DMA_V(1,SLOTB);
  ROT();
  kload8(kf,kp0+sl_cur);
  WAIT_BAR(2);
  s16x4 vlo[8],vhi[8]; u32x4 pw0,pw1,pw2,pw3;
  #define PKW(P,B) cvtpk_s(P[B],P[B+1])
  #define PAF(k) __builtin_bit_cast(bf16x8,pw##k)
  #define VFR(i) (bf16x8){vlo[i][0],vlo[i][1],vlo[i][2],vlo[i][3],vhi[i][0],vhi[i][1],vhi[i][2],vhi[i][3]}
  #define PIN(x) asm volatile("":"+v"(x))
  #define MX3(a,b,c) __builtin_fmaxf(__builtin_fmaxf((a),(b)),(c))
  #define GAPA(MF,A0,A1,A2,A3,W0,W1,PW) do{ MF; sacc+=A0; sacc+=A1; sacc+=A2; sacc+=A3; PIN(sacc); W0; W1; PIN(PW); SBAR(); }while(0)
  #define EX(v) __builtin_amdgcn_exp2f(v)
  #define GAPB(MF,X,B) do{ MF; X[B]=EX(X[B]); X[B+1]=EX(X[B+1]); X[B+2]=EX(X[B+2]); X[B+3]=EX(X[B+3]); PIN(X); SBAR(); }while(0)
  #define VRD(i) do{ vlo[i]=vtr(vp_+(((i)>>2)*4096+((i)&3)*1024)); vhi[i]=vtr(vp_+(((i)>>2)*4096+((i)&3)*1024+512)); }while(0)
  #define KRD(G,j) do{ if(G){ kload2(kf,kp0+sl_next,j); SBAR(); } }while(0)
  #define STEP(C0,C1,P0,P1,t,GK,GV,GL) do{ SBAR(); \
    const lds_cptr vp_=vp0+sl_prev; \
    VRD(0); SBAR(); float sacc=(P0[0]+P0[1]); \
    GAPA(C0=__builtin_amdgcn_mfma_f32_32x32x16_bf16(kf[0],qr[0],negm,0,0,0), P0[2],P0[3],P0[4],P0[5],     pw0[0]=PKW(P0,0), pw0[1]=PKW(P0,2), pw0); \
    VRD(4); SBAR(); GAPA(C1=__builtin_amdgcn_mfma_f32_32x32x16_bf16(kf[1],qr[0],negm,0,0,0), P0[6],P0[7],P0[8],P0[9],     pw0[2]=PKW(P0,4), pw0[3]=PKW(P0,6), pw0); \
    VRD(1); SBAR(); GAPA(C0=__builtin_amdgcn_mfma_f32_32x32x16_bf16(kf[2],qr[1],C0,0,0,0),   P0[10],P0[11],P0[12],P0[13], pw1[0]=PKW(P0,8), pw1[1]=PKW(P0,10), pw1); \
    VRD(5); SBAR(); GAPA(C1=__builtin_amdgcn_mfma_f32_32x32x16_bf16(kf[3],qr[1],C1,0,0,0),   P0[14],P0[15],P1[0],P1[1],   pw1[2]=PKW(P0,12),pw1[3]=PKW(P0,14), pw1); \
    VRD(2); SBAR(); GAPA(C0=__builtin_amdgcn_mfma_f32_32x32x16_bf16(kf[4],qr[2],C0,0,0,0),   P1[2],P1[3],P1[4],P1[5],     pw2[0]=PKW(P1,0), pw2[1]=PKW(P1,2), pw2); \
    VRD(6); SBAR(); GAPA(C1=__builtin_amdgcn_mfma_f32_32x32x16_bf16(kf[5],qr[2],C1,0,0,0),   P1[6],P1[7],P1[8],P1[9],     pw2[2]=PKW(P1,4), pw2[3]=PKW(P1,6), pw2); \
    VRD(3); SBAR(); GAPA(C0=__builtin_amdgcn_mfma_f32_32x32x16_bf16(kf[6],qr[3],C0,0,0,0),   P1[10],P1[11],P1[12],P1[13], pw3[0]=PKW(P1,8), pw3[1]=PKW(P1,10), pw3); \
    VRD(7); SBAR(); GAPA(C1=__builtin_amdgcn_mfma_f32_32x32x16_bf16(kf[7],qr[3],C1,0,0,0),   P1[14],P1[15],0.f,0.f,       pw3[2]=PKW(P1,12),pw3[3]=PKW(P1,14), pw3); \
    l_reg+=sacc; \
    if(GK){DMA_K((t)+3,sl_cur);} if(GV){DMA_V((t)+1,sl_next);} \
    CMASK(C0,C1,t); \
    { float a=MX3(C0[0],C0[1],C1[0]),b=MX3(C0[2],C0[3],C1[1]); a=MX3(a,C1[2],C1[3]); \
      _Pragma("unroll") for(int r=4;r<16;r+=4){a=MX3(a,C0[r],C0[r+1]);b=MX3(b,C0[r+2],C0[r+3]);a=MX3(a,C1[r],C1[r+1]);b=MX3(b,C1[r+2],C1[r+3]);} \
      float rm=__builtin_fmaxf(a,b); { auto rr=__builtin_amdgcn_permlane32_swap(__float_as_uint(rm),__float_as_uint(rm),false,false); rm=__builtin_fmaxf(__uint_as_float(rr[0]),__uint_as_float(rr[1])); } \
      resc=false; \
      if(__builtin_expect(__any(rm>(float)THRL),0)){ const float dl=__builtin_fmaxf(rm,0.f); mhat+=dl; \
        _Pragma("unroll") for(int r=0;r<16;++r){C0[r]-=dl;C1[r]-=dl;} \
        _Pragma("unroll") for(int r=0;r<16;++r)negm[r]=-mhat; asm volatile("":"+v"(negm)); \
        const float f=__builtin_amdgcn_exp2f(-dl); l_reg*=f; if(hi==0)wsf[r32]=f; resc=true; } } \
    SBAR(); \
    GAPB(o[0]=__builtin_amdgcn_mfma_f32_32x32x16_bf16(PAF(0),VFR(0),o[0],0,0,0), C0,0); \
    GAPB(o[1]=__builtin_amdgcn_mfma_f32_32x32x16_bf16(PAF(0),VFR(4),o[1],0,0,0), C0,4); \
    KRD(GL,0); GAPB(o[0]=__builtin_amdgcn_mfma_f32_32x32x16_bf16(PAF(1),VFR(1),o[0],0,0,0), C0,8); \
    KRD(GL,1); GAPB(o[1]=__builtin_amdgcn_mfma_f32_32x32x16_bf16(PAF(1),VFR(5),o[1],0,0,0), C0,12); \
    KRD(GL,2); GAPB(o[0]=__builtin_amdgcn_mfma_f32_32x32x16_bf16(PAF(2),VFR(2),o[0],0,0,0), C1,0); \
    KRD(GL,3); GAPB(o[1]=__builtin_amdgcn_mfma_f32_32x32x16_bf16(PAF(2),VFR(6),o[1],0,0,0), C1,4); \
    GAPB(o[0]=__builtin_amdgcn_mfma_f32_32x32x16_bf16(PAF(3),VFR(3),o[0],0,0,0), C1,8); \
    GAPB(o[1]=__builtin_amdgcn_mfma_f32_32x32x16_bf16(PAF(3),VFR(7),o[1],0,0,0), C1,12); \
    }while(0)
  int t=1;
  #undef CMASK
  #define CMASK(P0,P1,t) do{}while(0)
  for(;t+5<NT;t+=2){
    STEP(pB0,pB1,pA0,pA1,t,true,true,true);     WAIT_BAR(2); RESC(); ROT();
    STEP(pA0,pA1,pB0,pB1,t+1,true,true,true);   WAIT_BAR(2); RESC(); ROT();
  }
  #undef CMASK
  #define CMASK(P0,P1,t) do{}while(0)
  #define ENDW(tt) do{ if((tt)+3<NT){WAIT_BAR(2);} else if((tt)+2<NT){WAIT_BAR(1);} else {WAIT_BAR(0);} }while(0)
  for(;t+1<NT;t+=2){
    STEP(pB0,pB1,pA0,pA1,t,(t+3<NT),(t+1<NT),(t+1<NT));       ENDW(t);   RESC(); ROT();
    STEP(pA0,pA1,pB0,pB1,t+1,(t+4<NT),(t+2<NT),(t+2<NT));     ENDW(t+1); RESC(); ROT();
  }
  STEP(pB0,pB1,pA0,pA1,NT-1,false,false,false); RESC();
  { float sacc=pB0[0]+pB0[1]; _Pragma("unroll") for(int r=2;r<16;++r)sacc+=pB0[r]; _Pragma("unroll") for(int r=0;r<16;++r)sacc+=pB1[r]; l_reg+=sacc;
    pw0=(u32x4){PKW(pB0,0),PKW(pB0,2),PKW(pB0,4),PKW(pB0,6)};pw1=(u32x4){PKW(pB0,8),PKW(pB0,10),PKW(pB0,12),PKW(pB0,14)};pw2=(u32x4){PKW(pB1,0),PKW(pB1,2),PKW(pB1,4),PKW(pB1,6)};pw3=(u32x4){PKW(pB1,8),PKW(pB1,10),PKW(pB1,12),PKW(pB1,14)};
    SBAR(); pv(o,vb0+sl_cur,PAF(0),PAF(1),PAF(2),PAF(3)); }
  #undef PKW
  #undef PAF
  #undef VFR
  #undef PIN
  #undef MX3
  #undef GAPA
  #undef GAPB
  #undef EX
  #undef VRD
  #undef KRD
  #undef STEP
  #undef ENDW
  {auto rr=__builtin_amdgcn_permlane32_swap(__float_as_uint(l_reg),__float_as_uint(l_reg),false,false);l_reg=__uint_as_float(rr[0])+__uint_as_float(rr[1]);}
  if(hi==0)wsf[32+r32]=l_reg;asm volatile("s_waitcnt lgkmcnt(0)":::"memory");
  float rli[16];
  #pragma unroll
  for(int r=0;r<16;++r)rli[r]=__builtin_amdgcn_rcpf(wsf[32+crow(r,hi)]);
  bf16*Ow=Ow0+(long)(wid*QBLK)*DMQ;
  { bf16*stg=(bf16*)(shm+LDS_OST)+wid*2048;
    #pragma unroll
    for(int r=0;r<16;++r){const int orow=crow(r,hi);
      #pragma unroll
      for(int d0=0;d0<2;++d0)stg[orow*64+d0*32+r32]=__float2bfloat16(o[d0][r]*rli[r]);}
    asm volatile("s_waitcnt lgkmcnt(0)":::"memory");
    #pragma unroll
    for(int i=0;i<4;++i){const int row=i*8+(lane>>3),ch=lane&7; const u32x4 v=*(const u32x4*)(stg+row*64+ch*8); ATTN_STORE16(Ow+(long)row*DMQ+ch*8,v);} }
  asm volatile("s_waitcnt lgkmcnt(0)\n\ts_barrier":::"memory");
  #undef DMA_K
  #undef DMA_V
  #undef CMASK
  #undef START
  #undef RESC
  #undef ROT
}
constexpr int ATTN_LDS_BYTES=LDS_BYTES;
#undef SBAR
#undef WAIT_BAR
}

struct Frame {
    LAS unsigned char* lds;
    volatile LAS unsigned* MISC;
    gu32* ctl;
    int vcu, G, wv;
    const float* const* in;
    unsigned char* ws;
    float* out;
};
#define WSP(T, off) ((T*)(F.ws + (off)))
#define INP(i) (F.in[i])
enum { I_X = 0, I_C, I_CTX, I_CCTX, I_MODW, I_MODB, I_POOLW, I_POOLS, I_LIN, I_CONVW, I_CONVB, I_WA, I_BA, I_WX, I_BX, I_LAM, I_LOUT, I_QKV, I_QG, I_KG, I_WO,
       I_GIN, I_LNG, I_LNB, I_WS, I_BS, I_GOUT, I_ROUTER, I_WG, I_WU, I_WDN, I_FG, N_IN };

__device__ __forceinline__ void tr_item(const float* W, int ldw, bf16* WT, int ldt, int k0, int n0, int drow  , int lane) {
    const float* src = W + (size_t)k0 * ldw + n0 + lane;
    float v[64];
#pragma unroll
    for (int k = 0; k < 64; ++k) v[k] = __builtin_nontemporal_load(src + (size_t)k * ldw);
    bf16* dst = WT + (size_t)drow * ldt + k0;
#pragma unroll
    for (int c = 0; c < 8; ++c) { v4u o; o.x = pk2(v[8 * c], v[8 * c + 1]); o.y = pk2(v[8 * c + 2], v[8 * c + 3]); o.z = pk2(v[8 * c + 4], v[8 * c + 5]); o.w = pk2(v[8 * c + 6], v[8 * c + 7]);
        *(v4u*)(dst + 8 * c) = o; }
}
template <int MODE>
__device__ __forceinline__ void tr_job(Frame& F, const float* W, int K, int N, int nb, bf16* WT) {
    const int tid_ = opaque_tid(F.wv), lane_ = tid_ & 63, wave_ = __builtin_amdgcn_readfirstlane(tid_ >> 6);
    const int gw = F.vcu * NWAVES + wave_, NGW = F.G * NWAVES;
    const int nblk = N / 64, per = (K / 64) * nblk, total = per * nb;
    for (int it = gw; it < total; it += NGW) {
        const int bb = it / per, r = it - bb * per, kb = r / nblk, nbk = r - kb * nblk, k0 = 64 * kb, n0 = 64 * nbk;
        const float* Wb = W + (size_t)bb * K * N;
        bf16* dst; int drow0;
        if (MODE == 0) { dst = WT + (size_t)bb * N * K; drow0 = n0; }
        else if (MODE == 1 || MODE == 2) { dst = WT + (size_t)bb * 2048 * K; drow0 = 256 * (n0 >> 7) + (n0 & 127) + (MODE == 2 ? 128 : 0); }
        else { const int d = bb >> 3, h = bb & 7; dst = WT + (size_t)((h * 2 + (n0 >> 6)) * 256) * K;
            drow0 = 128 * d + 32 * (lane_ >> 4) + (MODE == 4 ? 16 : 0) + (lane_ & 15) - lane_; }
        tr_item(Wb, N, dst, K, k0, n0, drow0 + lane_, lane_);
    }
}
__device__ __forceinline__ void tr_item8(const float* W, int ldw, unsigned char* WT, int ldt, int k0, int n0, int drow0, int lane) {
    const float* src = W + (size_t)k0 * ldw + n0 + lane;
    float v[32];
#pragma unroll
    for (int k = 0; k < 32; ++k) v[k] = __builtin_nontemporal_load(src + (size_t)k * ldw) * W8_SCALE;
    unsigned char* dst = WT + (size_t)(drow0 + lane) * ldt + k0;
#pragma unroll
    for (int c = 0; c < 2; ++c) { v4u o; o.x = pk4_fp8(v[16 * c], v[16 * c + 1], v[16 * c + 2], v[16 * c + 3]); o.y = pk4_fp8(v[16 * c + 4], v[16 * c + 5], v[16 * c + 6], v[16 * c + 7]);
        o.z = pk4_fp8(v[16 * c + 8], v[16 * c + 9], v[16 * c + 10], v[16 * c + 11]); o.w = pk4_fp8(v[16 * c + 12], v[16 * c + 13], v[16 * c + 14], v[16 * c + 15]);
        *(v4u*)(dst + 16 * c) = o; }
}
template <int MODE>
__device__ __forceinline__ void tr_job8(Frame& F, const float* W, int K, int N, int nb, unsigned char* WT) {
    const int tid_ = opaque_tid(F.wv), lane_ = tid_ & 63, wave_ = __builtin_amdgcn_readfirstlane(tid_ >> 6);
    const int gw = F.vcu * NWAVES + wave_, NGW = F.G * NWAVES;
    const int nblk = N / 64, per = (K / 32) * nblk, total = per * nb;
    for (int it = gw; it < total; it += NGW) {
        const int bb = it / per, r = it - bb * per, kb = r / nblk, nbk = r - kb * nblk, k0 = 32 * kb, n0 = 64 * nbk;
        const float* Wb = W + (size_t)bb * K * N;
        unsigned char* dst; int drow0;
        if (MODE == 0) { dst = WT + (size_t)bb * N * K; drow0 = n0; }
        else { dst = WT + (size_t)bb * 2048 * K; drow0 = 256 * (n0 >> 7) + (n0 & 127) + (MODE == 2 ? 128 : 0); }
        tr_item8(Wb, N, dst, K, k0, n0, drow0, lane_);
    }
}
__device__ __forceinline__ void convert_moe(Frame& F, int L) {
    const size_t so = (size_t)(L & 1) * WSET;
    tr_job8<1>(F, INP(I_WG) + (size_t)L * 16 * 1024 * 1024, 1024, 1024, 16, WSP(unsigned char, WS_WGU + so));
    tr_job8<2>(F, INP(I_WU) + (size_t)L * 16 * 1024 * 1024, 1024, 1024, 16, WSP(unsigned char, WS_WGU + so));
    tr_job8<0>(F, INP(I_WDN) + (size_t)L * 16 * 1024 * 1024, 1024, 1024, 16, WSP(unsigned char, WS_WD + so));
}
struct ConvSide {
    const float *wg, *wu, *wd;
    unsigned char *gu8, *d8;
    __device__ __forceinline__ bool issue(int item, int lane, float (&v)[32]) const {
        if (wg == nullptr || item >= 3 * 8192) return false;
        const int m = item >> 13, r = item & 8191, bb = r >> 9, kb = (r >> 4) & 31, nbk = r & 15;
        const float* src = (m == 0 ? wg : (m == 1 ? wu : wd)) + (size_t)bb * 1024 * 1024 + (size_t)(32 * kb) * 1024 + 64 * nbk + lane;
#pragma unroll
        for (int k = 0; k < 32; ++k) v[k] = __builtin_nontemporal_load(src + (size_t)k * 1024);
        return true;
    }
    __device__ __forceinline__ void finish(int item, int lane, const float (&v)[32]) const {
        const int m = item >> 13, r = item & 8191, bb = r >> 9, kb = (r >> 4) & 31, nbk = r & 15, n0 = 64 * nbk;
        unsigned char* dst = (m < 2) ? gu8 + ((size_t)bb * 2048 + 256 * (n0 >> 7) + (n0 & 127) + (m == 1 ? 128 : 0) + lane) * 1024 + 32 * kb
                                     : d8 + ((size_t)bb * 1024 + n0 + lane) * 1024 + 32 * kb;
#pragma unroll
        for (int c = 0; c < 2; ++c) { v4u o; o.x = pk4_fp8(v[16 * c] * W8_SCALE, v[16 * c + 1] * W8_SCALE, v[16 * c + 2] * W8_SCALE, v[16 * c + 3] * W8_SCALE);
            o.y = pk4_fp8(v[16 * c + 4] * W8_SCALE, v[16 * c + 5] * W8_SCALE, v[16 * c + 6] * W8_SCALE, v[16 * c + 7] * W8_SCALE);
            o.z = pk4_fp8(v[16 * c + 8] * W8_SCALE, v[16 * c + 9] * W8_SCALE, v[16 * c + 10] * W8_SCALE, v[16 * c + 11] * W8_SCALE);
            o.w = pk4_fp8(v[16 * c + 12] * W8_SCALE, v[16 * c + 13] * W8_SCALE, v[16 * c + 14] * W8_SCALE, v[16 * c + 15] * W8_SCALE);
            *(v4u*)(dst + 16 * c) = o; }
    }
};

__device__ __forceinline__ void phase_prologue(Frame& F) {
    const int tid_ = opaque_tid(F.wv), lane_ = tid_ & 63, wave_ = __builtin_amdgcn_readfirstlane(tid_ >> 6); (void)lane_; (void)wave_;
    tr_job<0>(F, INP(I_POOLW), 256, 256, 4, WSP(bf16, WS_PW));
    tr_job<0>(F, INP(I_LIN), 1024, 2048, 1, WSP(bf16, WS_LIN));
    tr_job<3>(F, INP(I_WA), 128, 128, 16, WSP(bf16, WS_LG));
    tr_job<4>(F, INP(I_WX), 128, 128, 16, WSP(bf16, WS_LG));
    tr_job<0>(F, INP(I_LOUT), 1024, 1024, 1, WSP(bf16, WS_LOUT));
    tr_job<0>(F, INP(I_QKV), 1024, 1536, 1, WSP(bf16, WS_QKV));
    tr_job<0>(F, INP(I_WO), 1024, 1024, 1, WSP(bf16, WS_WO));
    tr_job8<0>(F, INP(I_GIN), 1024, 6144, 1, WSP(unsigned char, WS_GIN));
    tr_job8<0>(F, INP(I_GOUT), 3072, 1024, 1, WSP(unsigned char, WS_GOUT));
    convert_moe(F, 0);
    {
        const float* s = INP(I_WS); bf16* d = WSP(bf16, WS_GS);
        for (int i = (int)blockIdx.x * 512 + tid_; i < 4 * 128 * 128 / 2; i += F.G * 512) ((unsigned*)d)[i] = pk2(s[2 * i], s[2 * i + 1]);
    }
    if (blockIdx.x == 0) {
        float* rt = WSP(float, WS_ROPE);
        for (int i = tid_; i < 1024; i += 512) { const int pos = i >> 4, f = i & 15; const float inv = powf(10000.0f, -(float)f / 16.0f); const float ang = (float)pos * inv;
            rt[2 * i] = cosf(ang); rt[2 * i + 1] = sinf(ang); }
        float* spt = WSP(float, WS_SPT);
        for (int i = tid_; i < 2048; i += 512) spt[i] = -8.0f * 1.4426950409f * log1pf(expf(-INP(I_LAM)[i]));
    }
    __syncthreads();
    LAS float* S = (LAS float*)F.lds;
    LAS float* RED = (LAS float*)(F.lds + 40960);
    { float cv[18];
#pragma unroll
      for (int q = 0; q < 18; ++q) { const int i = tid_ + 512 * q, r = i >> 10, k = i & 1023; cv[q] = (r < 8) ? INP(I_C)[r * 1024 + k] : INP(I_CCTX)[k]; }
#pragma unroll
      for (int q = 0; q < 18; ++q) S[tid_ + 512 * q] = cv[q] * sigmoid_f(cv[q]); }
    __syncthreads();
    for (int u = (int)blockIdx.x; u < 4 * 96; u += F.G) {
        const int l = u / 96, n0 = (u % 96) * 64;
        const float* Wl = INP(I_MODW) + (size_t)l * 1024 * 6144 + n0 + lane_;
        float a[9];
#pragma unroll
        for (int r = 0; r < 9; ++r) a[r] = 0.f;
        const int kb = wave_ * 128;
#pragma unroll 1
        for (int k0 = 0; k0 < 128; k0 += 16) {
            float w[16];
#pragma unroll
            for (int q = 0; q < 16; ++q) w[q] = __builtin_nontemporal_load(Wl + (size_t)(kb + k0 + q) * 6144);
#pragma unroll
            for (int k = 0; k < 16; k += 4) {
#pragma unroll
                for (int r = 0; r < 9; ++r) { const f32x4 s = *(const LAS f32x4*)(S + r * 1024 + kb + k0 + k); a[r] += s.x * w[k] + s.y * w[k + 1] + s.z * w[k + 2] + s.w * w[k + 3]; }
                __builtin_amdgcn_sched_barrier(0); }
        }
#pragma unroll
        for (int r = 0; r < 9; ++r) RED[(wave_ * 9 + r) * 64 + lane_] = a[r];
        __syncthreads();
        for (int i = tid_; i < 9 * 64; i += 512) { const int r = i >> 6, c = i & 63; float s = 0.f;
#pragma unroll
            for (int w8 = 0; w8 < 8; ++w8) s += RED[(w8 * 9 + r) * 64 + c];
            WSP(float, WS_MOD)[((size_t)l * 9 + r) * 6144 + n0 + c] = s + INP(I_MODB)[l * 6144 + n0 + c]; }
        __syncthreads();
    }
}

template <int L>
__device__ __forceinline__ void phase_n1(Frame& F, const bool dry = false) {
    const int tid_ = opaque_tid(F.wv), lane_ = tid_ & 63, wave_ = __builtin_amdgcn_readfirstlane(tid_ >> 6);
    const int gw = F.vcu * NWAVES + wave_, NGW = F.G * NWAVES;
    constexpr int nrows = (L >= 3) ? RL : RT;
    const int rpw = (nrows + NGW - 1) / NGW, r0 = gw * rpw, r1 = (r0 + rpw < nrows) ? r0 + rpw : nrows;
    bf16* XS = WSP(bf16, WS_XS); bf16* H = WSP(bf16, WS_H); const int* INV = WSP(int, WS_INV); const unsigned char* Y = WSP(unsigned char, SC_Y);
    const float* MOD = WSP(float, WS_MOD);
#define N1_SRC(r) ((r) < RL ? INP(I_X) + (size_t)(r) * D : INP(I_CTX) + (size_t)((r) - RL) * D)
#define N1_LOADX(r) do { if (L == 0) { const f32x4* xr_ = (const f32x4*)N1_SRC(r) + lane_; _Pragma("unroll") for (int j = 0; j < 4; ++j) vn[j] = xr_[64 * j]; } \
        else { const v2u* xr_ = (const v2u*)(XS + (size_t)(r) * D) + lane_; _Pragma("unroll") for (int j = 0; j < 4; ++j) vnb[j] = xr_[64 * j]; } } while (0)
    f32x4 vn[4]; v2u vnb[4]; unsigned ywn[4][4]; int yrn[4]; unsigned mrest_n = 0; int inv_n = -1, inv_nn = -1;
#define N1_ISSUE_Y(invv) do { unsigned m_ = (unsigned)(__ballot((invv) >= 0) & 0xffffull); \
        _Pragma("unroll") for (int k = 0; k < 4; ++k) { yrn[k] = -1; if (m_) { const int e_ = __builtin_ctz(m_); m_ &= m_ - 1; yrn[k] = __builtin_amdgcn_readlane((invv), e_); } } \
        mrest_n = m_; \
        _Pragma("unroll") for (int k = 0; k < 4; ++k) if (yrn[k] >= 0) { const unsigned* yp_ = (const unsigned*)(Y + (size_t)yrn[k] * D) + lane_; _Pragma("unroll") for (int j = 0; j < 4; ++j) ywn[k][j] = yp_[64 * j]; } } while (0)
#pragma unroll
    for (int k = 0; k < 4; ++k) yrn[k] = -1;
    if (r0 < r1) { N1_LOADX(r0);
        if (L > 0) { inv_n = (lane_ < 16) ? INV[r0 * 16 + lane_] : -1; if (r0 + 1 < r1) inv_nn = (lane_ < 16) ? INV[(r0 + 1) * 16 + lane_] : -1; N1_ISSUE_Y(inv_n); } }
    int cb = -1; f32x4 shv[4], scv[4], g2v[4];
#pragma unroll
    for (int j = 0; j < 4; ++j) { shv[j] = (f32x4){0.f, 0.f, 0.f, 0.f}; scv[j] = shv[j]; g2v[j] = shv[j]; }
    for (int row = r0; row < r1; ++row) {
        const int b = row < RL ? (row >> 12) : 8;
        if (b != cb) { cb = b;
            if (L < 4) { const float* sh = MOD + ((size_t)L * 9 + b) * 6144;
#pragma unroll
                for (int j = 0; j < 4; ++j) { shv[j] = *((const f32x4*)sh + 64 * j + lane_); scv[j] = *((const f32x4*)(sh + 1024) + 64 * j + lane_) + 1.0f; } }
            else {
#pragma unroll
                for (int j = 0; j < 4; ++j) scv[j] = *((const f32x4*)INP(I_FG) + 64 * j + lane_); }
            if (L > 0) { const float* g2 = MOD + ((size_t)(L - 1) * 9 + b) * 6144 + 5120;
#pragma unroll
                for (int j = 0; j < 4; ++j) g2v[j] = *((const f32x4*)g2 + 64 * j + lane_) * Y8_INV; } }
        f32x4 v[4]; unsigned yw[4][4]; int yr[4];
#pragma unroll
        for (int j = 0; j < 4; ++j) v[j] = (L == 0) ? vn[j] : bf4(vnb[j]);
#pragma unroll
        for (int k = 0; k < 4; ++k) { yr[k] = yrn[k];
#pragma unroll
            for (int j = 0; j < 4; ++j) yw[k][j] = ywn[k][j]; }
        unsigned mrest = mrest_n; const int inv = inv_n;
        { const int rn = row + 1; if (rn < r1) { N1_LOADX(rn);
            if (L > 0) { inv_n = inv_nn; if (rn + 1 < r1) inv_nn = (lane_ < 16) ? INV[(rn + 1) * 16 + lane_] : -1; N1_ISSUE_Y(inv_n); } } }
        if (L > 0) {
            f32x4 a[4];
#pragma unroll
            for (int j = 0; j < 4; ++j) a[j] = (f32x4){0.f, 0.f, 0.f, 0.f};
#pragma unroll
            for (int k = 0; k < 4; ++k) if (yr[k] >= 0) {
#pragma unroll
                for (int j = 0; j < 4; ++j) { const f32x2 lo = __builtin_amdgcn_cvt_pk_f32_fp8((int)yw[k][j], false), hi = __builtin_amdgcn_cvt_pk_f32_fp8((int)yw[k][j], true); a[j].x += lo.x; a[j].y += lo.y; a[j].z += hi.x; a[j].w += hi.y; } }
            while (mrest) {
                const int e = __builtin_ctz(mrest); mrest &= mrest - 1; const int yq = __builtin_amdgcn_readlane(inv, e);
                const unsigned* yp = (const unsigned*)(Y + (size_t)yq * D) + lane_;
#pragma unroll
                for (int j = 0; j < 4; ++j) { const int w = (int)yp[64 * j]; const f32x2 lo = __builtin_amdgcn_cvt_pk_f32_fp8(w, false), hi = __builtin_amdgcn_cvt_pk_f32_fp8(w, true); a[j].x += lo.x; a[j].y += lo.y; a[j].z += hi.x; a[j].w += hi.y; } }
#pragma unroll
            for (int j = 0; j < 4; ++j) v[j] = v[j] + g2v[j] * a[j];
            if (L < 4 && !dry) { v2u* xo = (v2u*)(XS + (size_t)row * D) + lane_;
#pragma unroll
                for (int j = 0; j < 4; ++j) { v2u w; w.x = pk2(v[j].x, v[j].y); w.y = pk2(v[j].z, v[j].w); xo[64 * j] = w; } }
        }
        float ss = 0.f;
#pragma unroll
        for (int j = 0; j < 4; ++j) ss += (v[j].x * v[j].x + v[j].y * v[j].y) + (v[j].z * v[j].z + v[j].w * v[j].w);
        const float rstd = 1.0f / sqrtf(wave_sum(ss) * (1.0f / D) + EPS);
        if (L == 3) {
            unsigned* ho = (unsigned*)((unsigned char*)H + (size_t)row * D) + lane_;
#pragma unroll
            for (int j = 0; j < 4; ++j) { const f32x4 h = v[j] * rstd * scv[j] + shv[j]; ho[64 * j] = pk4_fp8_sat(h.x, h.y, h.z, h.w); }
        } else if (L < 4) {
            v2u* ho = (v2u*)(H + (size_t)row * D) + lane_;
#pragma unroll
            for (int j = 0; j < 4; ++j) { const f32x4 h = v[j] * rstd * scv[j] + shv[j]; v2u w; w.x = pk2(h.x, h.y); w.y = pk2(h.z, h.w); ho[64 * j] = w; }
        } else {
            f32x4* oo = (f32x4*)(F.out + (size_t)row * D) + lane_;
#pragma unroll
            for (int j = 0; j < 4; ++j) oo[64 * j] = v[j] * rstd * scv[j];
        }
    }
#undef N1_SRC
#undef N1_LOADX
#undef N1_ISSUE_Y
}

template <int L>
__device__ __forceinline__ void phase_n2(Frame& F) {
    const int tid_ = opaque_tid(F.wv), lane_ = tid_ & 63, wave_ = __builtin_amdgcn_readfirstlane(tid_ >> 6);
    const int gw = F.vcu * NWAVES + wave_, NGW = F.G * NWAVES;
    constexpr int nrows = (L >= 2) ? RL : RT;
    const int rpw = (((nrows + NGW - 1) / NGW) + 1) & ~1  , r0 = gw * rpw, r1 = (r0 + rpw < nrows) ? r0 + rpw : nrows;
    LAS float* RW = (LAS float*)F.lds;
    { const float* router = INP(I_ROUTER) + (size_t)L * 1024 * 16 + (size_t)tid_ * 32;
      f32x4 rv[8];
#pragma unroll
      for (int q = 0; q < 8; ++q) rv[q] = *((const f32x4*)router + q);
#pragma unroll
      for (int q = 0; q < 4; ++q)
#pragma unroll
          for (int c = 0; c < 4; ++c) { const int e = 4 * q + c; *(LAS f32x2*)(RW + e * 1024 + 2 * tid_) = (f32x2){rv[q][c], rv[4 + q][c]}; } }
    __syncthreads();
    const bf16* XS = WSP(bf16, WS_XS); unsigned char* H8 = WSP(unsigned char, WS_H); float* AFF = WSP(float, WS_AFF); const float* MOD = WSP(float, WS_MOD);
    const int lane = lane_;
    constexpr int R2 = 2;
    v2u vn[R2][4];
#pragma unroll
    for (int q = 0; q < R2; ++q) if (r0 + q < r1) { const v2u* xr = (const v2u*)(XS + (size_t)(r0 + q) * D) + lane;
#pragma unroll
        for (int j = 0; j < 4; ++j) vn[q][j] = xr[64 * j]; }
    int cb = -1; f32x4 shv[4], scv[4];
#pragma unroll
    for (int j = 0; j < 4; ++j) { shv[j] = (f32x4){0.f, 0.f, 0.f, 0.f}; scv[j] = shv[j]; }
    for (int row = r0; row < r1; row += R2) {
        const int b = row < RL ? (row >> 12) : 8;
        if (b != cb) { cb = b; const float* sh = MOD + ((size_t)L * 9 + b) * 6144 + 3072;
#pragma unroll
            for (int j = 0; j < 4; ++j) { shv[j] = *((const f32x4*)sh + 64 * j + lane); scv[j] = *((const f32x4*)(sh + 1024) + 64 * j + lane) + 1.0f; } }
        f32x4 v[R2][4];
#pragma unroll
        for (int q = 0; q < R2; ++q)
#pragma unroll
            for (int j = 0; j < 4; ++j) v[q][j] = bf4(vn[q][j]);
#pragma unroll
        for (int q = 0; q < R2; ++q) { const int rn = row + R2 + q; if (rn < r1) { const v2u* xr = (const v2u*)(XS + (size_t)rn * D) + lane;
#pragma unroll
            for (int j = 0; j < 4; ++j) vn[q][j] = xr[64 * j]; } }
        float ss[R2];
#pragma unroll
        for (int q = 0; q < R2; ++q) { ss[q] = 0.f;
#pragma unroll
            for (int j = 0; j < 4; ++j) ss[q] += (v[q][j].x * v[q][j].x + v[q][j].y * v[q][j].y) + (v[q][j].z * v[q][j].z + v[q][j].w * v[q][j].w); }
#pragma unroll
        for (int o = 1; o < 64; o <<= 1)
#pragma unroll
            for (int q = 0; q < R2; ++q) ss[q] += __shfl_xor(ss[q], o);
        float p[R2][16];
#pragma unroll
        for (int q = 0; q < R2; ++q) { const float rstd = 1.0f / sqrtf(ss[q] * (1.0f / D) + EPS);
            const bool live = row + q < r1;
            unsigned* ho = (unsigned*)(H8 + (size_t)(row + q) * D) + lane;
#pragma unroll
            for (int j = 0; j < 4; ++j) { v[q][j] = v[q][j] * rstd * scv[j] + shv[j]; if (live) ho[64 * j] = pk4_fp8_sat(v[q][j].x, v[q][j].y, v[q][j].z, v[q][j].w); } }
#pragma unroll
        for (int e = 0; e < 16; ++e) { f32x2 a0 = {0.f, 0.f}, b0 = a0, a1 = a0, b1 = a0;
#pragma unroll
            for (int j = 0; j < 4; ++j) { const f32x4 w = *(const LAS f32x4*)(RW + e * 1024 + 256 * j + 4 * lane); const f32x2 wl = {w.x, w.y}, wh = {w.z, w.w};
                a0 = __builtin_elementwise_fma((f32x2){v[0][j].x, v[0][j].y}, wl, a0); b0 = __builtin_elementwise_fma((f32x2){v[0][j].z, v[0][j].w}, wh, b0);
                a1 = __builtin_elementwise_fma((f32x2){v[1][j].x, v[1][j].y}, wl, a1); b1 = __builtin_elementwise_fma((f32x2){v[1][j].z, v[1][j].w}, wh, b1); }
            a0 = a0 + b0; a1 = a1 + b1;
            p[0][e] = a0.x + a0.y; p[1][e] = a1.x + a1.y; __builtin_amdgcn_sched_barrier(0); }
#pragma unroll
        for (int i = 0; i < 8; ++i)
#pragma unroll
            for (int q = 0; q < R2; ++q) { const bool hi = (lane & 32) != 0; const float send = hi ? p[q][i] : p[q][i + 8], keep = hi ? p[q][i + 8] : p[q][i]; p[q][i] = keep + __shfl_xor(send, 32); }
#pragma unroll
        for (int i = 0; i < 4; ++i)
#pragma unroll
            for (int q = 0; q < R2; ++q) { const bool hi = (lane & 16) != 0; const float send = hi ? p[q][i] : p[q][i + 4], keep = hi ? p[q][i + 4] : p[q][i]; p[q][i] = keep + __shfl_xor(send, 16); }
#pragma unroll
        for (int i = 0; i < 2; ++i)
#pragma unroll
            for (int q = 0; q < R2; ++q) { const bool hi = (lane & 8) != 0; const float send = hi ? p[q][i] : p[q][i + 2], keep = hi ? p[q][i + 2] : p[q][i]; p[q][i] = keep + __shfl_xor(send, 8); }
#pragma unroll
        for (int q = 0; q < R2; ++q) { const bool hi = (lane & 4) != 0; const float send = hi ? p[q][0] : p[q][1], keep = hi ? p[q][1] : p[q][0]; p[q][0] = keep + __shfl_xor(send, 4); }
        float lg[R2], mx[R2], ex[R2], sm[R2];
#pragma unroll
        for (int q = 0; q < R2; ++q) { lg[q] = p[q][0]; lg[q] += __shfl_xor(lg[q], 1); }
#pragma unroll
        for (int q = 0; q < R2; ++q) { lg[q] += __shfl_xor(lg[q], 2); mx[q] = lg[q]; }
#pragma unroll
        for (int o = 4; o < 64; o <<= 1)
#pragma unroll
            for (int q = 0; q < R2; ++q) mx[q] = fmaxf(mx[q], __shfl_xor(mx[q], o));
#pragma unroll
        for (int q = 0; q < R2; ++q) { ex[q] = __expf(lg[q] - mx[q]); sm[q] = ex[q]; }
#pragma unroll
        for (int o = 4; o < 64; o <<= 1)
#pragma unroll
            for (int q = 0; q < R2; ++q) sm[q] += __shfl_xor(sm[q], o);
        if ((lane & 3) == 0) { const int e = ((lane >> 5) & 1) * 8 + ((lane >> 4) & 1) * 4 + ((lane >> 3) & 1) * 2 + ((lane >> 2) & 1);
#pragma unroll
            for (int q = 0; q < R2; ++q) if (row + q < r1) AFF[(size_t)(row + q) * 16 + e] = ex[q] / sm[q]; }
    }
    __syncthreads();
}

__device__ __forceinline__ unsigned block_excl_scan(unsigned v, LAS unsigned* tmp, int tid, unsigned& total) {
    const int lane = tid & 63, w = tid >> 6; unsigned inc = v;
#pragma unroll
    for (int o = 1; o < 64; o <<= 1) { const unsigned t = __shfl_up(inc, o); if (lane >= o) inc += t; }
    if (lane == 63) tmp[w] = inc;
    __syncthreads();
    unsigned pre = 0, tot = 0;
#pragma unroll
    for (int i = 0; i < 8; ++i) { const unsigned t = tmp[i]; if (i < w) pre += t; tot += t; }
    __syncthreads();
    total = tot; return pre + inc - v;
}
template <int NPT>
__device__ __forceinline__ void topk_problem(Frame& F, const float* aff  , int n, int k, int row0  , int e, int ybase) {
    const int tid_ = opaque_tid(F.wv), lane_ = tid_ & 63, wave_ = __builtin_amdgcn_readfirstlane(tid_ >> 6); (void)lane_; (void)wave_;
    LAS unsigned* hist = (LAS unsigned*)F.lds;
    LAS unsigned* sel = hist + 256;
    LAS unsigned* tmp = hist + 272;
    const int tid = tid_;
    unsigned key[NPT];
#pragma unroll
    for (int i = 0; i < NPT; ++i) { const int t = tid * NPT + i; key[i] = (t < n) ? __builtin_bit_cast(unsigned, aff[(size_t)t * 16]) : 0u; }
    unsigned prefix = 0, kk = (unsigned)k;
#pragma unroll
    for (int pass = 0; pass < 4; ++pass) {
        const int shift = 24 - 8 * pass;
        if (tid < 256) hist[tid] = 0u;
        __syncthreads();
#pragma unroll
        for (int i = 0; i < NPT; ++i) { const int t = tid * NPT + i; const bool in = (t < n) && (pass == 0 || (key[i] >> (shift + 8)) == prefix); if (in) __hip_atomic_fetch_add(&hist[(key[i] >> shift) & 255u], 1u, __ATOMIC_RELAXED, __HIP_MEMORY_SCOPE_WORKGROUP); }
        __syncthreads();
        if (tid < 64) {
            unsigned c[4]; unsigned s = 0;
#pragma unroll
            for (int q = 0; q < 4; ++q) { c[q] = hist[255 - 4 * tid - q]; s += c[q]; }
            unsigned inc = s;
#pragma unroll
            for (int o = 1; o < 64; o <<= 1) { const unsigned t = __shfl_up(inc, o); if (tid >= o) inc += t; }
            const unsigned long long m = __ballot(inc >= kk);
            const int first = __ffsll((long long)m) - 1;
            if (tid == first) { unsigned before = inc - s; int q = 0; for (; q < 3; ++q) { if (before + c[q] >= kk) break; before += c[q]; }
                sel[0] = (unsigned)(255 - 4 * tid - q); sel[1] = kk - before; }
        }
        __syncthreads();
        prefix = (prefix << 8) | sel[0]; kk = sel[1];
        __syncthreads();
    }
    const unsigned T = prefix, need_eq = kk;
    unsigned cg = 0, ce = 0;
#pragma unroll
    for (int i = 0; i < NPT; ++i) { const int t = tid * NPT + i; if (t < n) { cg += key[i] > T; ce += key[i] == T; } }
    unsigned total; const unsigned pre = block_excl_scan((ce << 16) | cg, tmp, tid, total);
    unsigned gb = pre & 0xffffu, eb = pre >> 16;
    int* INV = WSP(int, WS_INV); int* IDX = WSP(int, WS_IDX); float* GATE = WSP(float, WS_GATE);
#pragma unroll
    for (int i = 0; i < NPT; ++i) { const int t = tid * NPT + i; if (t < n) {
        const bool g = key[i] > T, q = key[i] == T; const bool s = g || (q && eb < need_eq);
        const int slot = (int)(gb + (eb < need_eq ? eb : need_eq));
        const int row = row0 + t;
        if (s) { IDX[ybase + slot] = row; GATE[ybase + slot] = __builtin_bit_cast(float, key[i]); }
        INV[(size_t)row * 16 + e] = s ? (ybase + slot) : -1;
        gb += g; eb += q; } }
    __syncthreads();
}
template <int L>
__device__ __forceinline__ void phase_topk(Frame& F) {
    constexpr int nprob = (L >= 2) ? 128 : 256;
    const float* AFF = WSP(float, WS_AFF);
    for (int p = (int)blockIdx.x; p < nprob; p += F.G) {
        if (p < 128) { const int b = p >> 4, e = p & 15; topk_problem<8>(F, AFF + (size_t)b * SEQ * 16 + e, SEQ, SEQ / 8, b * SEQ, e, p * 512); }
        else { const int q = p - 128, e = q >> 3, b = q & 7; topk_problem<1>(F, AFF + (size_t)(RL + b * CTX) * 16 + e, CTX, CTX / 8, RL + b * CTX, e, NYL + e * 256 + b * 32); }
    }
}

__device__ __forceinline__ void seq_pos(int row, int& pos, int& len) { if (row < RL) { pos = row & (SEQ - 1); len = SEQ; } else { pos = (row - RL) & (CTX - 1); len = CTX; } }
template <int W>
__device__ __forceinline__ void pool_run(const bf16* H, bf16* P, int r0, int c8) {
    constexpr int RR = 8, NL = RR + W - 1;
    int pos0, len; seq_pos(r0, pos0, len);
    v4u w[NL];
#pragma unroll
    for (int k = 0; k < NL; ++k) { const int p = pos0 - W / 2 + k; const bool ok = (p >= 0 && p < len); w[k] = ok ? *(const v4u*)(H + (size_t)(r0 - W / 2 + k) * D + c8 * 8) : (v4u){0u, 0u, 0u, 0u}; }
    float s[8];
#pragma unroll
    for (int q = 0; q < 8; ++q) s[q] = 0.f;
#pragma unroll
    for (int k = 0; k < W; ++k) { s[0] += bflo(w[k].x); s[1] += bfhi(w[k].x); s[2] += bflo(w[k].y); s[3] += bfhi(w[k].y); s[4] += bflo(w[k].z); s[5] += bfhi(w[k].z); s[6] += bflo(w[k].w); s[7] += bfhi(w[k].w); }
#pragma unroll
    for (int j = 0; j < RR; ++j) {
        const int pos = pos0 + j, lo = max(pos - W / 2, 0), hi = min(pos + W / 2, len);
        const float inv = __builtin_amdgcn_rcpf((float)(hi - lo));
        const v4u c = w[j + W / 2];
        v4u o; o.x = pk2(s[0] * inv - bflo(c.x), s[1] * inv - bfhi(c.x)); o.y = pk2(s[2] * inv - bflo(c.y), s[3] * inv - bfhi(c.y));
        o.z = pk2(s[4] * inv - bflo(c.z), s[5] * inv - bfhi(c.z)); o.w = pk2(s[6] * inv - bflo(c.w), s[7] * inv - bfhi(c.w));
        *(v4u*)(P + (size_t)(r0 + j) * D + c8 * 8) = o;
        if (j + 1 < RR) { const v4u a = w[j + W], d = w[j];
            s[0] += bflo(a.x) - bflo(d.x); s[1] += bfhi(a.x) - bfhi(d.x); s[2] += bflo(a.y) - bflo(d.y); s[3] += bfhi(a.y) - bfhi(d.y);
            s[4] += bflo(a.z) - bflo(d.z); s[5] += bfhi(a.z) - bfhi(d.z); s[6] += bflo(a.w) - bflo(d.w); s[7] += bfhi(a.w) - bfhi(d.w); }
    }
}
__device__ __forceinline__ void phase_pool(Frame& F) {
    const int tid_ = opaque_tid(F.wv), lane_ = tid_ & 63, wave_ = __builtin_amdgcn_readfirstlane(tid_ >> 6);
    const bf16* H = WSP(bf16, WS_H); bf16* P = WSP(bf16, SC_P);
    const int gw = F.vcu * NWAVES + wave_, NGW = F.G * NWAVES;
    for (int it = gw; it < 4 * (RT / 16); it += NGW) {
        const int g = it & 3, r0 = ((it >> 2) * 2 + (lane_ >> 5)) * 8, c8 = g * 32 + (lane_ & 31);
        if (g == 0) pool_run<2>(H, P, r0, c8); else if (g == 1) pool_run<4>(H, P, r0, c8); else if (g == 2) pool_run<8>(H, P, r0, c8); else pool_run<16>(H, P, r0, c8);
    }
}
__device__ __forceinline__ void phase_conv(Frame& F) {
    const int tid_ = opaque_tid(F.wv);
    const bf16* ZX = WSP(bf16, SC_ZX); bf16* XR = WSP(bf16, SC_XR); const float* cw = INP(I_CONVW); const float* cb = INP(I_CONVB);
    constexpr int U = 4;
    for (int j = (int)blockIdx.x * 512 + tid_; j < (RT / U) * 128; j += F.G * 512) {
        const int rg = j >> 7, c8 = j & 127, row0 = rg * U; int pos0, len; seq_pos(row0, pos0, len);
        v4u w[U + 3];
#pragma unroll
        for (int k = 0; k < U + 3; ++k) { const int p = pos0 + k - 2; const bool ok = p >= 0 && p < len; w[k] = ok ? *(const v4u*)(ZX + (size_t)(row0 + k - 2) * D + c8 * 8) : (v4u){0u, 0u, 0u, 0u}; }
        f32x4 w0[4], w1[4];
#pragma unroll
        for (int k = 0; k < 4; ++k) { w0[k] = *(const f32x4*)(cw + k * 1024 + c8 * 8); w1[k] = *(const f32x4*)(cw + k * 1024 + c8 * 8 + 4); }
        const f32x4 b0 = *(const f32x4*)(cb + c8 * 8), b1 = *(const f32x4*)(cb + c8 * 8 + 4);
#pragma unroll
        for (int u = 0; u < U; ++u) {
            float s[8] = {b0.x, b0.y, b0.z, b0.w, b1.x, b1.y, b1.z, b1.w};
#pragma unroll
            for (int k = 0; k < 4; ++k) { const v4u x = w[u + k];
                s[0] += bflo(x.x) * w0[k].x; s[1] += bfhi(x.x) * w0[k].y; s[2] += bflo(x.y) * w0[k].z; s[3] += bfhi(x.y) * w0[k].w;
                s[4] += bflo(x.z) * w1[k].x; s[5] += bfhi(x.z) * w1[k].y; s[6] += bflo(x.w) * w1[k].z; s[7] += bfhi(x.w) * w1[k].w; }
            v4u o; o.x = pk2(s[0], s[1]); o.y = pk2(s[2], s[3]); o.z = pk2(s[4], s[5]); o.w = pk2(s[6], s[7]);
            *(v4u*)(XR + (size_t)(row0 + u) * D + c8 * 8) = o; }
    }
}
__device__ __forceinline__ int scan_chunk(int d, int b, int s) { return d == 0 ? (s < 4 ? 512 + b * 4 + s : b * 64 + (s - 4)) : (s < 4 ? 512 + b * 4 + (3 - s) : b * 64 + (63 - (s - 4))); }
__device__ __forceinline__ void phase_carry(Frame& F) {
    const int tid_ = opaque_tid(F.wv), lane_ = tid_ & 63, wave_ = __builtin_amdgcn_readfirstlane(tid_ >> 6); (void)lane_; (void)wave_;
    const f32x2* AGG = WSP(f32x2, WS_AGG); float* CARRY = WSP(float, WS_CARRY);
    for (int gid = (int)blockIdx.x * 512 + tid_; gid < 2 * 8 * 1024; gid += F.G * 512) {
        const int d = gid >> 13, b = (gid >> 10) & 7, ch = gid & 1023;
        float st = 0.f;
#pragma unroll 17
        for (int s = 0; s < 68; ++s) { const int c = scan_chunk(d, b, s); const size_t o = ((size_t)d * 544 + c) * 1024 + ch;
            const f32x2 ah = AGG[o]; CARRY[o] = st; st = ah.x * st + ah.y; }
    }
}
__device__ __forceinline__ void phase_lruc(Frame& F) {
    const int tid_ = opaque_tid(F.wv);
    const bf16 *HL0 = WSP(bf16, SC_HL0), *AC0 = WSP(bf16, SC_AC0), *AC1 = WSP(bf16, SC_AC1); bf16* G = WSP(bf16, SC_G);
    const float* CARRY = WSP(float, WS_CARRY);
    constexpr int U = 4;
    for (int j = (int)blockIdx.x * 512 + tid_; j < (RT / U) * 128; j += F.G * 512) {
        const int rg = j >> 7, c8 = j & 127, row0 = rg * U, chunk = row0 >> 6;
        v4u h0[U], a0[U], a1[U];
        const float* c0 = CARRY + ((size_t)chunk) * 1024 + c8 * 8; const float* c1 = CARRY + ((size_t)544 + chunk) * 1024 + c8 * 8;
        const f32x4 p0 = *(const f32x4*)c0, p1 = *(const f32x4*)(c0 + 4), q0 = *(const f32x4*)c1, q1 = *(const f32x4*)(c1 + 4);
#pragma unroll
        for (int u = 0; u < U; ++u) { const size_t o = (size_t)(row0 + u) * D + c8 * 8; h0[u] = *(const v4u*)(HL0 + o); a0[u] = *(const v4u*)(AC0 + o); a1[u] = *(const v4u*)(AC1 + o); }
#pragma unroll
        for (int u = 0; u < U; ++u) { const size_t o = (size_t)(row0 + u) * D + c8 * 8;
            float r[8];
            r[0] = bflo(h0[u].x) + bflo(a0[u].x) * p0.x + bflo(a1[u].x) * q0.x; r[1] = bfhi(h0[u].x) + bfhi(a0[u].x) * p0.y + bfhi(a1[u].x) * q0.y;
            r[2] = bflo(h0[u].y) + bflo(a0[u].y) * p0.z + bflo(a1[u].y) * q0.z; r[3] = bfhi(h0[u].y) + bfhi(a0[u].y) * p0.w + bfhi(a1[u].y) * q0.w;
            r[4] = bflo(h0[u].z) + bflo(a0[u].z) * p1.x + bflo(a1[u].z) * q1.x; r[5] = bfhi(h0[u].z) + bfhi(a0[u].z) * p1.y + bfhi(a1[u].z) * q1.y;
            r[6] = bflo(h0[u].w) + bflo(a0[u].w) * p1.z + bflo(a1[u].w) * q1.z; r[7] = bfhi(h0[u].w) + bfhi(a0[u].w) * p1.w + bfhi(a1[u].w) * q1.w;
            v4u w; w.x = pk2(r[0], r[1]); w.y = pk2(r[2], r[3]); w.z = pk2(r[4], r[5]); w.w = pk2(r[6], r[7]);
            *(v4u*)(G + o) = w; }
    }
}

using pg8::Unit;
struct SchedMN {
    int nM, nN, G, c, ash; const char* A; const char* B; size_t a_tile, a_pn, b_tile;
    __device__ __forceinline__ bool next(int i, Unit& u) const {
        const int nwg = nM * nN, R = nwg / G, T = nwg - R * G;
        int pm, pn, hf = 0, ro = 0;
        if (i == R && T > 0 && 2 * T <= G) { if (c >= 2 * T) return false; if (!pg8::static_order_l((long)R * G + (c >> 1), nM, nN, pm, pn)) return false; hf = 1; ro = (c & 1) * 128; }
        else if (!pg8::static_order(i, G, c, nM, nN, pm, pn)) return false;
        u.pm = pm; u.pn = pn; u.rows = nullptr; u.half = hf; u.row0 = pm * 256 + ro;
        u.A = A + (size_t)pm * a_tile + (size_t)ro * (a_tile >> 8) + (size_t)(pn >> ash) * a_pn; u.B = B + (size_t)pn * b_tile; return true;
    }
};
__device__ __forceinline__ int moe_expert(int t) { return t < 256 ? ((t >> 1) & 15) : (t - 256); }
struct SchedMoeUp {
    int G, c, nct; const char* Hb; const char* W; const int* IDX;
    __device__ __forceinline__ bool next(int i, Unit& u) const {
        int t, pn;
        if (G == 256) {
            const int x = c & 7, j = c >> 3;
            if (i < 8) { const int e = 2 * x + (i >> 2), a = (i & 3) * 4 + (j >> 3); pn = j & 7; t = ((a >> 1) * 16 + e) * 2 + (a & 1); }
            else if (i == 8 && c < nct) { t = 256 + (c >> 3); pn = c & 7; }
            else return false;
        } else { const int L = i * G + c; const int tot = 2048 + nct; if (L >= tot) return false; t = L >> 3; pn = L & 7; }
        u.pm = t; u.pn = pn; u.rows = IDX + t * 256; u.half = 0; u.row0 = t * 256; u.A = Hb; u.B = W + ((size_t)moe_expert(t) * 2048 + (size_t)pn * 256) * 1024; return true;
    }
};
struct SchedMoeDown {
    int G, c, ntile; const char* ACT; const char* W;
    __device__ __forceinline__ bool next(int i, Unit& u) const {
        int pm, pn;
        if (G == 256) {
            const int x = c & 7, j = c >> 3;
            if (i < 4) { const int e = 2 * x + (i >> 1), a = (i & 1) * 8 + (j >> 2); pn = j & 3; pm = ((a >> 1) * 16 + e) * 2 + (a & 1); }
            else if (i == 4 && ntile > 256 && c < 64) { pm = 256 + (c >> 2); pn = c & 3; }
            else return false;
        } else if (!pg8::static_order(i, G, c, ntile, 4, pm, pn)) return false;
        u.pm = pm; u.pn = pn; u.rows = nullptr; u.half = 0; u.row0 = pm * 256; u.A = ACT + (size_t)pm * 256 * 1024; u.B = W + ((size_t)moe_expert(pm) * 1024 + (size_t)pn * 256) * 1024; return true;
    }
};

using f32x4_t = f32x4;
typedef const f32x4 (&AccRef)[2][2][4][2];
__device__ __forceinline__ v4u pack8(const f32x4& v0, const f32x4& v1) { v4u w; w.x = pk2(v0.x, v0.y); w.y = pk2(v0.z, v0.w); w.z = pk2(v1.x, v1.y); w.w = pk2(v1.z, v1.w); return w; }
template <bool LAYER0, bool SCALE>
struct EpiRes {
    bf16* XS; const float* x_in; const float* ctx_in; const float* g1base  ; const float* scale; bf16* DST; int ctx_shift; float mul;
    __device__ __forceinline__ void operator()(AccRef acc, const Unit& u, int wr, int wc, int fr, int fq) const {
        asm volatile("" : "+v"(fr), "+v"(fq));
        const int b = u.pm < 128 ? (u.pm >> 4) : 8; const float* g1 = g1base + (size_t)b * 6144;
        const int col0 = u.pn * 256 + wc * 32 + 8 * fq;
        f32x4 gv[2][2];
#pragma unroll
        for (int bj = 0; bj < 2; ++bj)
#pragma unroll
            for (int n = 0; n < 2; ++n) { gv[bj][n] = *(const f32x4*)(g1 + col0 + bj * 128 + n * 4) * mul; if (SCALE) gv[bj][n] = gv[bj][n] * *(const f32x4*)(scale + col0 + bj * 128 + n * 4); }
#pragma unroll
        for (int ai = 0; ai < 2; ++ai) {
            if (ai == 1 && u.half) continue;
            f32x4 xv[4][2][2]; v4u xb[4][2];
#pragma unroll
            for (int m = 0; m < 4; ++m) {
                const int row = u.row0 + ai * 128 + wr * 64 + m * 16 + fr;
#pragma unroll
                for (int bj = 0; bj < 2; ++bj) {
                    if (LAYER0) { const float* src = (row < RL ? x_in + (size_t)row * D : ctx_in + (size_t)(row - RL) * D) + col0 + bj * 128; xv[m][bj][0] = *(const f32x4*)src; xv[m][bj][1] = *(const f32x4*)(src + 4); }
                    else xb[m][bj] = *(const v4u*)(XS + (size_t)row * D + col0 + bj * 128); } }
#pragma unroll
            for (int m = 0; m < 4; ++m) {
                const int row = u.row0 + ai * 128 + wr * 64 + m * 16 + fr;
                bf16* dst = DST + (size_t)(row - (u.pm >= 128 ? ctx_shift : 0)) * D;
#pragma unroll
                for (int bj = 0; bj < 2; ++bj) {
                    f32x4 x0, x1;
                    if (LAYER0) { x0 = xv[m][bj][0]; x1 = xv[m][bj][1]; } else { x0 = bf4((v2u){xb[m][bj].x, xb[m][bj].y}); x1 = bf4((v2u){xb[m][bj].z, xb[m][bj].w}); }
                    *(v4u*)(dst + col0 + bj * 128) = pack8(x0 + gv[bj][0] * acc[ai][bj][m][0], x1 + gv[bj][1] * acc[ai][bj][m][1]); } }
            __builtin_amdgcn_sched_barrier(0);
        }
    }
};
struct EpiLruIn {
    bf16* YG; bf16* ZX;
    __device__ __forceinline__ void operator()(AccRef acc, const Unit& u, int wr, int wc, int fr, int fq) const {
        asm volatile("" : "+v"(fr), "+v"(fq));
        const bool isy = u.pn < 4; bf16* base = isy ? YG + u.pn * 256 : ZX + (u.pn - 4) * 256;
#pragma unroll
        for (int ai = 0; ai < 2; ++ai) { if (ai == 1 && u.half) continue;
#pragma unroll
            for (int m = 0; m < 4; ++m) { const int row = u.row0 + ai * 128 + wr * 64 + m * 16 + fr;
#pragma unroll
                for (int bj = 0; bj < 2; ++bj) { f32x4 v0 = acc[ai][bj][m][0], v1 = acc[ai][bj][m][1];
                    if (isy) {
#pragma unroll
                        for (int e = 0; e < 1; ++e) { gelu4(v0); gelu4(v1); } }
                    *(v4u*)(base + (size_t)row * D + bj * 128 + wc * 32 + 8 * fq) = pack8(v0, v1); } } }
    }
};
template <int CTRL> __device__ __forceinline__ float dpp_f(float oldv, float src) {
    return __builtin_bit_cast(float, __builtin_amdgcn_update_dpp(__builtin_bit_cast(int, oldv), __builtin_bit_cast(int, src), CTRL, 0xf, 0xf, false)); }
struct EpiGates {
    const bf16* XR; const bf16* YG; bf16 *HS, *AC0, *AC1; f32x2* AGG; const float *ba, *bx, *lam;
    __device__ __forceinline__ void operator()(AccRef acc, const Unit& u, int wr, int wc, int fr_, int fq_) const {
        const int lz = opaque_tid(0), fr = lz & 15, fq = lz >> 4;
        const int chb = (u.pn >> 1) * 128 + (u.pn & 1) * 64 + wc * 16 + 4 * fq;
        v2u xwp[2][4];
#pragma unroll
        for (int ai = 0; ai < 2; ++ai)
#pragma unroll
            for (int m = 0; m < 4; ++m) xwp[ai][m] = *(const v2u*)(XR + (size_t)(u.row0 + (u.half ? 0 : ai * 128) + wr * 64 + m * 16 + fr) * D + chb);
#pragma unroll
        for (int ai = 0; ai < 2; ++ai) {
            if (ai == 1 && u.half) continue;
            v2u ywp[4];
#pragma unroll
            for (int m = 0; m < 4; ++m) ywp[m] = *(const v2u*)(YG + (size_t)(u.row0 + ai * 128 + wr * 64 + m * 16 + fr) * D + chb);
            float hs[4][4];
            dir<0>(acc, u, ai, wr, fr, chb, xwp[ai], ywp, hs);
            dir<1>(acc, u, ai, wr, fr, chb, xwp[ai], ywp, hs);
        }
    }
    template <int d>
    __device__ __forceinline__ void dir(AccRef acc, const Unit& u, const int ai, const int wr, const int fr, const int chb, const v2u (&xwa)[4], const v2u (&ywa)[4], float (&hs)[4][4]) const {
        bf16* AC = d ? AC1 : AC0;
        constexpr int SH = d ? 0x100 : 0x110;
        constexpr int BC = d ? 0x150 : 0x15F;
        const f32x4 bav = *(const f32x4*)(ba + d * 1024 + chb), bxv = *(const f32x4*)(bx + d * 1024 + chb), c8 = *(const f32x4*)(lam + d * 1024 + chb);
        float Ac[4], Hc[4];
#pragma unroll
        for (int e = 0; e < 4; ++e) { Ac[e] = 1.f; Hc[e] = 0.f; }
#pragma unroll
        for (int mm = 0; mm < 4; ++mm) { constexpr int dd = d; const int m = dd ? 3 - mm : mm;
            const int row = u.row0 + ai * 128 + wr * 64 + m * 16 + fr;
            const v2u xw = xwa[m];
            const float xr[4] = {bflo(xw.x), bfhi(xw.x), bflo(xw.y), bfhi(xw.y)};
            float hl[4], ac[4];
#pragma unroll
            for (int e = 0; e < 4; ++e) { const float r = sigmoid_f(acc[ai][d][m][0][e] + bav[e]), ig = sigmoid_f(acc[ai][d][m][1][e] + bxv[e]);
                const float l2 = r * c8[e];
                float a = __builtin_amdgcn_exp2f(l2);
                const float om = fmaxf(1.0f - a * a, 0.f);
                float hh = xr[e] * ig * __builtin_amdgcn_sqrtf(om);
                { const float ao = dpp_f<SH + 1>(1.0f, a), ho = dpp_f<SH + 1>(0.0f, hh); hh = a * ho + hh; a = a * ao; }
                { const float ao = dpp_f<SH + 2>(1.0f, a), ho = dpp_f<SH + 2>(0.0f, hh); hh = a * ho + hh; a = a * ao; }
                { const float ao = dpp_f<SH + 4>(1.0f, a), ho = dpp_f<SH + 4>(0.0f, hh); hh = a * ho + hh; a = a * ao; }
                { const float ao = dpp_f<SH + 8>(1.0f, a), ho = dpp_f<SH + 8>(0.0f, hh); hh = a * ho + hh; a = a * ao; }
                const float fa = dpp_f<BC>(0.0f, a), fh = dpp_f<BC>(0.0f, hh);
                hl[e] = hh + a * Hc[e]; ac[e] = a * Ac[e];
                Hc[e] = fa * Hc[e] + fh; Ac[e] = fa * Ac[e]; }
            if (dd == 0) {
#pragma unroll
                for (int e = 0; e < 4; ++e) hs[m][e] = hl[e]; }
            const v2u yw = ywa[m]; const float yg[4] = {bflo(yw.x), bfhi(yw.x), bflo(yw.y), bfhi(yw.y)};
            if (dd == 1) { v2u w; w.x = pk2((hs[m][0] + hl[0]) * yg[0], (hs[m][1] + hl[1]) * yg[1]); w.y = pk2((hs[m][2] + hl[2]) * yg[2], (hs[m][3] + hl[3]) * yg[3]); *(v2u*)(HS + (size_t)row * D + chb) = w; }
            v2u q; q.x = pk2(ac[0] * yg[0], ac[1] * yg[1]); q.y = pk2(ac[2] * yg[2], ac[3] * yg[3]); *(v2u*)(AC + (size_t)row * D + chb) = q;
            __builtin_amdgcn_sched_barrier(0); }
        if (fr == 0) { const int chunk = (u.row0 >> 6) + ai * 2 + wr; f32x2* ag = AGG + ((size_t)d * 544 + chunk) * 1024 + chb;
#pragma unroll
            for (int e = 0; e < 4; ++e) ag[e] = (f32x2){Ac[e], Hc[e]}; }
    }
};
struct EpiQKV {
    bf16 *Q, *KA, *VA; const float *qg, *kg; const f32x2* rope;
    __device__ __forceinline__ void operator()(AccRef acc, const Unit& u, int wr, int wc, int fr, int fq) const {
        asm volatile("" : "+v"(fr), "+v"(fq));
        const int kind = u.pn < 4 ? 0 : (u.pn == 4 ? 1 : 2);
        const float* gp = kind == 0 ? qg : kg;
        f32x4 g[2][2];
#pragma unroll
        for (int bj = 0; bj < 2; ++bj)
#pragma unroll
            for (int n = 0; n < 2; ++n) g[bj][n] = (kind == 2) ? (f32x4){1.f, 1.f, 1.f, 1.f} : *(const f32x4*)(gp + bj * 32 + 8 * fq + 4 * n);
        const float post = kind == 0 ? attn_body::C2 : 1.0f;
#pragma unroll
        for (int ai = 0; ai < 2; ++ai)
#pragma unroll
            for (int m = 0; m < 4; ++m) {
                if (ai == 1 && u.half) continue;
                const int row = u.row0 + ai * 128 + wr * 64 + m * 16 + fr;
                const bool lat = row < RL; const int bb = lat ? (row >> 12) : ((row - RL) >> 8), nn = lat ? (row & (SEQ - 1)) : ((row - RL) & (CTX - 1));
                f32x4 v[2][2];
#pragma unroll
                for (int bj = 0; bj < 2; ++bj)
#pragma unroll
                    for (int n = 0; n < 2; ++n) v[bj][n] = acc[ai][bj][m][n];
                if (kind != 2) {
                    float ss = 0.f;
#pragma unroll
                    for (int bj = 0; bj < 2; ++bj)
#pragma unroll
                        for (int n = 0; n < 2; ++n) ss += (v[bj][n].x * v[bj][n].x + v[bj][n].y * v[bj][n].y) + (v[bj][n].z * v[bj][n].z + v[bj][n].w * v[bj][n].w);
                    ss += __shfl_xor(ss, 16); ss += __shfl_xor(ss, 32);
                    const float rstd = 1.0f / sqrtf(ss * (1.0f / 64.0f) + EPS);
#pragma unroll
                    for (int bj = 0; bj < 2; ++bj)
#pragma unroll
                        for (int n = 0; n < 2; ++n) v[bj][n] = v[bj][n] * rstd * g[bj][n];
                    if (lat) {
#pragma unroll
                        for (int bj = 0; bj < 2; ++bj) { const int pos = bj ? (nn & 63) : (nn >> 6);
#pragma unroll
                            for (int n = 0; n < 2; ++n) { const f32x2 cs0 = rope[pos * 16 + 4 * fq + 2 * n], cs1 = rope[pos * 16 + 4 * fq + 2 * n + 1];
                                const f32x4 t = v[bj][n];
                                v[bj][n].x = t.x * cs0.x - t.y * cs0.y; v[bj][n].y = t.x * cs0.y + t.y * cs0.x;
                                v[bj][n].z = t.z * cs1.x - t.w * cs1.y; v[bj][n].w = t.z * cs1.y + t.w * cs1.x; } }
                    }
                }
                if (kind == 0) {
                    bf16* dst = Q + (size_t)row * D + (u.pn * 4 + wc) * 64 + 8 * fq;
#pragma unroll
                    for (int bj = 0; bj < 2; ++bj) *(v4u*)(dst + bj * 32) = pack8(v[bj][0] * post, v[bj][1] * post);
                } else {
                    const size_t krow = (size_t)bb * KVLEN + (lat ? CTX + nn : nn);
                    bf16* dst = (kind == 1 ? KA : VA) + krow * 256 + wc * 64 + 8 * fq;
#pragma unroll
                    for (int bj = 0; bj < 2; ++bj) *(v4u*)(dst + bj * 32) = pack8(v[bj][0], v[bj][1]);
                }
                __builtin_amdgcn_sched_barrier(0);
            }
    }
};
struct EpiGmlpIn {
    bf16 *U, *V; f32x2* PSUM;
    __device__ __forceinline__ void operator()(AccRef acc, const Unit& u, int wr, int wc, int fr, int fq) const {
        const int lz = opaque_tid(0); fr = lz & 15; fq = lz >> 4;
        const int x16 = (lz ^ 16) << 2, x32 = (lz ^ 32) << 2;
#define GX(v, a) __builtin_bit_cast(float, __builtin_amdgcn_ds_bpermute((a), __builtin_bit_cast(int, (v))))
        const bool isu = u.pn < 12; bf16* base = isu ? U + u.pn * 256 : V + (u.pn - 12) * 256;
#pragma unroll
        for (int ai = 0; ai < 2; ++ai)
#pragma unroll
            for (int m = 0; m < 4; ++m) { const int row = u.pm * 256 + ai * 128 + wr * 64 + m * 16 + fr; float s1, s2;
                asm volatile("v_mov_b32 %0, 0\n\tv_mov_b32 %1, 0" : "=v"(s1), "=v"(s2));
#pragma unroll
                for (int bj = 0; bj < 2; ++bj) { f32x4 v0 = acc[ai][bj][m][0] * W8_INV;
                    gelu4(v0); { const f32x4 qv = v0 * v0; s1 += (v0.x + v0.y) + (v0.z + v0.w); s2 += (qv.x + qv.y) + (qv.z + qv.w); }
                    __builtin_amdgcn_sched_barrier(0);
                    f32x4 v1 = acc[ai][bj][m][1] * W8_INV;
                    gelu4(v1); { const f32x4 qv = v1 * v1; s1 += (v1.x + v1.y) + (v1.z + v1.w); s2 += (qv.x + qv.y) + (qv.z + qv.w); }
                    *(v4u*)((char*)base + (unsigned)(row * 6144 + (bj * 128 + wc * 32 + 8 * fq) * 2)) = pack8(v0, v1);
                    __builtin_amdgcn_sched_barrier(0); }
                if (!isu) { s1 += GX(s1, x16); s1 += GX(s1, x32); s2 += GX(s2, x16); s2 += GX(s2, x32);
                    if (fq == 0) PSUM[(size_t)row * 48 + (u.pn - 12) * 4 + wc] = (f32x2){s1, s2}; }
                __builtin_amdgcn_sched_barrier(0); }
#undef GX
    }
};
struct EpiMoeUp {
    unsigned char* ACT;
    ConvSide cs;
    __device__ __forceinline__ void operator()(AccRef acc, const Unit& u, int wr, int wc, int fr, int fq) const {
        asm volatile("" : "+v"(fr), "+v"(fq));
        const int cs_item = (u.pm * 8 + u.pn) * 8 + wr * 4 + wc; float csv[32];
        const bool cs_on = cs.issue(cs_item, fq * 16 + fr, csv);
        __builtin_amdgcn_sched_barrier(0);
#pragma unroll
        for (int ai = 0; ai < 2; ++ai)
#pragma unroll
            for (int m = 0; m < 4; ++m) { const size_t yrow = (size_t)u.pm * 256 + ai * 128 + wr * 64 + m * 16 + fr;
                f32x4 o[2];
#pragma unroll
                for (int n = 0; n < 2; ++n)
#pragma unroll
                    for (int e = 0; e < 4; ++e) { const float gt = acc[ai][0][m][n][e] * W8_INV, up = acc[ai][1][m][n][e] * W8_INV; o[n][e] = gt * sigmoid_f(gt) * up; }
                v2u w; w.x = pk4_fp8_sat(o[0].x, o[0].y, o[0].z, o[0].w); w.y = pk4_fp8_sat(o[1].x, o[1].y, o[1].z, o[1].w);
                *(v2u*)(ACT + yrow * D + u.pn * 128 + wc * 32 + 8 * fq) = w; }
        __builtin_amdgcn_sched_barrier(0);
        if (cs_on) cs.finish(cs_item, fq * 16 + fr, csv);
    }
};
struct EpiMoeDown {
    unsigned char* Y; const float* GATE;
    ConvSide cs; int ctx_remap;
    __device__ __forceinline__ void operator()(AccRef acc, const Unit& u, int wr, int wc, int fr, int fq) const {
        asm volatile("" : "+v"(fr), "+v"(fq));
        const int cs_item = ((ctx_remap && u.pm >= 224) ? (2048 + (u.pm - 224) * 4 + u.pn) : (2176 + u.pm * 4 + u.pn)) * 8 + wr * 4 + wc; float csv[32];
        const bool cs_on = cs.issue(cs_item, fq * 16 + fr, csv);
        __builtin_amdgcn_sched_barrier(0);
        float gtv[2][4];
#pragma unroll
        for (int ai = 0; ai < 2; ++ai)
#pragma unroll
            for (int m = 0; m < 4; ++m) gtv[ai][m] = GATE[(size_t)u.pm * 256 + ai * 128 + wr * 64 + m * 16 + fr] * (W8_INV * Y8_SCALE);
#pragma unroll
        for (int ai = 0; ai < 2; ++ai)
#pragma unroll
            for (int m = 0; m < 4; ++m) { const size_t yrow = (size_t)u.pm * 256 + ai * 128 + wr * 64 + m * 16 + fr; const float gt = gtv[ai][m];
#pragma unroll
                for (int bj = 0; bj < 2; ++bj) { const f32x4 y0 = acc[ai][bj][m][0] * gt, y1 = acc[ai][bj][m][1] * gt; v2u w; w.x = pk4_fp8_sat(y0.x, y0.y, y0.z, y0.w); w.y = pk4_fp8_sat(y1.x, y1.y, y1.z, y1.w);
                    *(v2u*)(Y + yrow * D + u.pn * 256 + bj * 128 + wc * 32 + 8 * fq) = w; }  __builtin_amdgcn_sched_barrier(0); }
        if (cs_on) cs.finish(cs_item, fq * 16 + fr, csv);
    }
};

typedef short v4i16_tr __attribute__((ext_vector_type(4)));
__device__ __forceinline__ void phase_spatial(Frame& F, unsigned char* Gdst) {
    const int tid_ = opaque_tid(F.wv), lane_ = tid_ & 63, wave_ = __builtin_amdgcn_readfirstlane(tid_ >> 6); (void)lane_; (void)wave_;
    constexpr int WLS = 136;
    constexpr int VP = 160;
    LAS bf16* WL = (LAS bf16*)F.lds;
    LAS unsigned char* VS = F.lds + 128 * WLS * 2;
    LAS float* ST = (LAS float*)(F.lds + 128 * WLS * 2 + 2 * 128 * VP);
    const int tid = tid_, lane = lane_, wave = wave_, fr = lane & 15, fq = lane >> 4;
    const bf16* U = WSP(bf16, SC_U); const bf16* V = WSP(bf16, SC_V); const f32x2* PSUM = WSP(f32x2, SC_PSUM);
    const bf16* WS = WSP(bf16, WS_GS); const float* lng = INP(I_LNG); const float* lnb = INP(I_LNB); const float* bs = INP(I_BS);
    for (int unit = (int)blockIdx.x; unit < 8 * 32 * 4; unit += F.G) {
        const int g = unit & 3, ck = unit >> 2;
        const size_t row0 = (size_t)ck * 128;
        __syncthreads();
        { const int q = tid >> 2, part = tid & 3; float s1 = 0.f, s2 = 0.f;
#pragma unroll
          for (int i = 0; i < 12; ++i) { const f32x2 p = PSUM[(row0 + q) * 48 + part * 12 + i]; s1 += p.x; s2 += p.y; }
          s1 += __shfl_xor(s1, 1); s1 += __shfl_xor(s1, 2); s2 += __shfl_xor(s2, 1); s2 += __shfl_xor(s2, 2);
          const float mean = s1 * (1.0f / 3072.0f); const float var = fmaxf(s2 * (1.0f / 3072.0f) - mean * mean, 0.f);
          if (part == 0) { ST[2 * q] = mean; ST[2 * q + 1] = 1.0f / sqrtf(var + EPS); } }
        { v4u wv4[4];
#pragma unroll
          for (int q = 0; q < 4; ++q) { const int i = tid + 512 * q; wv4[q] = *(const v4u*)(WS + (size_t)g * 16384 + (i >> 4) * 128 + (i & 15) * 8); }
#pragma unroll
          for (int q = 0; q < 4; ++q) { const int i = tid + 512 * q; *(LAS v4u*)(WL + (i >> 4) * WLS + (i & 15) * 8) = wv4[q]; } }
        __syncthreads();
        const float bsp = bs[g * 128 + wave * 16 + fr];
        const int tq = tid >> 3, tf8 = (tid & 7) * 8;
        float tmean[2], trstd[2];
#pragma unroll
        for (int pass = 0; pass < 2; ++pass) { tmean[pass] = ST[2 * (tq + 64 * pass)]; trstd[pass] = ST[2 * (tq + 64 * pass) + 1]; }
        v4u vw[2]; v2u uwn[4];
#pragma unroll
        for (int pass = 0; pass < 2; ++pass) vw[pass] = *(const v4u*)(V + (row0 + tq + 64 * pass) * 3072 + g * 768 + tf8);
#pragma unroll
        for (int nf = 0; nf < 4; ++nf) uwn[nf] = *(const v2u*)(U + (row0 + wave * 16 + fr) * 3072 + g * 768 + 4 * fq + nf * 16);
        const int trb = (8 * fq + (fr >> 2)) * VP + 8 * (fr & 3);
        for (int s = 0; s < 12; ++s) {
            const int f0 = g * 768 + s * 64;
            LAS unsigned char* vs = VS + (s & 1) * 128 * VP;
#pragma unroll
            for (int pass = 0; pass < 2; ++pass) {
                const v4u w = vw[pass];
                const f32x4 g0 = *(const f32x4*)(lng + f0 + tf8), g1 = *(const f32x4*)(lng + f0 + tf8 + 4), b0 = *(const f32x4*)(lnb + f0 + tf8), b1 = *(const f32x4*)(lnb + f0 + tf8 + 4);
                const f32x4 x0 = (bf4((v2u){w.x, w.y}) - tmean[pass]) * trstd[pass] * g0 + b0, x1 = (bf4((v2u){w.z, w.w}) - tmean[pass]) * trstd[pass] * g1 + b1;
                *(LAS v4u*)(vs + (tq + 64 * pass) * VP + tf8 * 2) = pack8(x0, x1); }
            if (s + 1 < 12) {
#pragma unroll
                for (int pass = 0; pass < 2; ++pass) vw[pass] = *(const v4u*)(V + (row0 + tq + 64 * pass) * 3072 + f0 + 64 + tf8); }
            const bf16* urow = U + (row0 + wave * 16 + fr) * 3072 + f0 + 4 * fq; unsigned char* grow = Gdst + (row0 + wave * 16 + fr) * 3072 + f0 + 4 * fq;
            v2u uw[4];
#pragma unroll
            for (int nf = 0; nf < 4; ++nf) uw[nf] = uwn[nf];
            if (s + 1 < 12) {
#pragma unroll
                for (int nf = 0; nf < 4; ++nf) uwn[nf] = *(const v2u*)(urow + 64 + nf * 16); }
            __syncthreads();
            f32x4 acc[4];
#pragma unroll
            for (int nf = 0; nf < 4; ++nf) acc[nf] = (f32x4){0.f, 0.f, 0.f, 0.f};
#pragma unroll
            for (int ks = 0; ks < 4; ++ks) {
                const bf16x8 wfrag = *(const LAS bf16x8*)(WL + (wave * 16 + fr) * WLS + ks * 32 + fq * 8);
#pragma unroll
                for (int nf = 0; nf < 4; ++nf) {
                    const v4i16_tr r0 = __builtin_amdgcn_ds_read_tr16_b64_v4i16((LAS v4i16_tr*)(vs + trb + (32 * ks) * VP + nf * 32));
                    const v4i16_tr r1 = __builtin_amdgcn_ds_read_tr16_b64_v4i16((LAS v4i16_tr*)(vs + trb + (32 * ks + 4) * VP + nf * 32));
                    const bf16x8 vfrag = (bf16x8){r0[0], r0[1], r0[2], r0[3], r1[0], r1[1], r1[2], r1[3]};
                    acc[nf] = __builtin_amdgcn_mfma_f32_16x16x32_bf16(vfrag, wfrag, acc[nf], 0, 0, 0); }
            }
#pragma unroll
            for (int nf = 0; nf < 4; ++nf) {
                *(unsigned*)(grow + nf * 16) = pk4_fp8_sat(bflo(uw[nf].x) * (acc[nf].x + bsp), bfhi(uw[nf].x) * (acc[nf].y + bsp), bflo(uw[nf].y) * (acc[nf].z + bsp), bfhi(uw[nf].y) * (acc[nf].w + bsp)); }
        }
    }
    __syncthreads();
}

__device__ __forceinline__ void phase_attn(Frame& F, char* lds, bf16* Obuf) {
    const attn_body::bf16* Q = (const attn_body::bf16*)WSP(bf16, SC_Q); const attn_body::bf16* KA = (const attn_body::bf16*)WSP(bf16, SC_KA); const attn_body::bf16* VA = (const attn_body::bf16*)WSP(bf16, SC_VA);
    attn_body::bf16* O = (attn_body::bf16*)Obuf;
    for (int un = F.vcu; un < 2048; un += F.G) {
        int b, h, NT; size_t qrow;
        if (un < 2048) { const int bh = un >> 4, qb = un & 15; b = bh >> 4; h = bh & 15; qrow = (size_t)b * SEQ + qb * 256; NT = KVLEN / 64; }
        else { const int q = un - 2048; b = q >> 4; h = q & 15; qrow = (size_t)RL + b * CTX; NT = CTX / 64; }
        const size_t kvoff = (size_t)b * KVLEN * 256 + (h >> 2) * 64;
        attn_body::attn_unit<8>(F.wv, Q + qrow * D + h * 64, KA + kvoff, VA + kvoff, O + qrow * D + h * 64, NT, lds);
    }
}

struct Args { const float* in[N_IN]; float* out; unsigned char* ws; int ph_lo, ph_hi; };
constexpr int N_PHASES = 36;
__global__ void __launch_bounds__(NWAVES * 64, 2) hyb_fwd(Args args) {
    extern __shared__ __attribute__((aligned(16))) unsigned char lds[];
    Frame F;
    F.lds = (LAS unsigned char*)lds;
    F.MISC = (volatile LAS unsigned*)(F.lds + MISC_OFF);
    F.G = gridDim.x; { const int bx = blockIdx.x; F.vcu = (F.G % 8 == 0) ? (bx % 8) * (F.G / 8) + bx / 8 : bx; }
    F.wv = __builtin_amdgcn_readfirstlane((int)threadIdx.x >> 6);
    F.in = args.in; F.ws = args.ws; F.out = args.out; F.ctl = (gu32*)(args.ws + WS_CTL);
    for (int u = threadIdx.x; u < (LDS_BYTES - LDSCTL_OFF) / 4; u += NWAVES * 64) ((LAS unsigned*)(F.lds + LDSCTL_OFF))[u] = 0u;
    __syncthreads();
    XcdBarrier bar; bar.bar = (unsigned*)(F.ctl + CW_BAR); bar.x = 0; bar.st = nullptr; bar.wv = F.wv;
    const int lo = args.ph_lo, hi = args.ph_hi;
    if (hi - lo > 1) bar = xcd_barrier_post((unsigned*)(F.ctl + CW_BAR), F.MISC + 8, F.wv);
#ifndef PH_LO
#define PH_LO 0
#define PH_HI 99
#endif
#define IN(k) ((k) >= PH_LO && (k) <= PH_HI && lo <= (k) && (k) < hi)
#if defined(PROBE_MASK_A) || defined(PROBE_DELAY_MASK)
#define STAMP(k) do { if (xb_thread0(F.wv)) ((volatile LAS unsigned long long*)(F.lds + LDSCTL_OFF))[k] = __builtin_amdgcn_s_memrealtime(); } while (0)
#else
#define STAMP(k) do { } while (0)
#endif
    STAMP(0);
#define SEAM(k) do { if (IN(k) && IN((k) + 1)) xcd_barrier(bar); STAMP((k) + 1); } while (0)
    LAS unsigned char* ring = F.lds;
    const int cblk = (int)blockIdx.x;
    bf16* XS = WSP(bf16, WS_XS); const float* MOD = WSP(float, WS_MOD);
    const char* Hb = (const char*)WSP(bf16, WS_H);

#ifdef PROBE_REP_MASK
#define NREP(k) (1 + (int)(((unsigned long long)(PROBE_REP_MASK) >> (k)) & 1ull))
#else
#define NREP(k) 1
#endif
#define PH(k, ...) if (IN(k)) { for (int r_ = NREP(k) - 1; r_ >= 0; --r_) { const bool dry = r_ > 0; (void)dry; __VA_ARGS__ if (r_ > 0) xcd_barrier(bar); } } SEAM(k);
#define CONV_SIDE(L) ((L) < 3 ? ConvSide{INP(I_WG) + (size_t)((L) + 1) * 16 * 1024 * 1024, INP(I_WU) + (size_t)((L) + 1) * 16 * 1024 * 1024, INP(I_WDN) + (size_t)((L) + 1) * 16 * 1024 * 1024, \
        WSP(unsigned char, WS_WGU + (((L) + 1) & 1) * WSET), WSP(unsigned char, WS_WD + (((L) + 1) & 1) * WSET)} : ConvSide{nullptr, nullptr, nullptr, nullptr, nullptr})
#define MOE_PHASES(L, base) \
    PH(base, phase_n2<L>(F); ) \
    PH((base) + 1, phase_topk<L>(F); ) \
    PH((base) + 2, { SchedMoeUp S{F.G, cblk, (L) >= 2 ? 0 : 128, Hb, (const char*)WSP(unsigned char, WS_WGU + ((L) & 1) * WSET), WSP(int, WS_IDX)}; \
        EpiMoeUp E{WSP(unsigned char, SC_ACT), CONV_SIDE(L)}; \
        pg8::gemm_phase<EpiMoeUp, SchedMoeUp, 1, true, true>(F.wv, ring, 1024, 1024, 1024, S, E); } ) \
    PH((base) + 3, { SchedMoeDown S{F.G, cblk, (L) >= 2 ? 256 : 272, (const char*)WSP(bf16, SC_ACT), (const char*)WSP(unsigned char, WS_WD + ((L) & 1) * WSET)}; \
        EpiMoeDown E{WSP(unsigned char, SC_Y), WSP(float, WS_GATE), CONV_SIDE(L), (L) == 2}; \
        pg8::gemm_phase<EpiMoeDown, SchedMoeDown, 1, false, true>(F.wv, ring, 1024, 1024, 1024, S, E); } )
#define RES_GEMM(k, L, Aoff, Boff, nM, Kdim) \
    PH(k, { SchedMN S{nM, 4, F.G, cblk, 0, (const char*)WSP(bf16, Aoff), (const char*)WSP(bf16, Boff), (size_t)256 * (Kdim) * 2, 0, (size_t)256 * (Kdim) * 2}; \
        EpiRes<false, false> E{XS, nullptr, nullptr, MOD + (L) * 9 * 6144 + 2048, nullptr, dry ? (bf16*)F.out : XS, dry ? RL : 0, 1.0f}; \
        pg8::gemm_phase<EpiRes<false, false>, SchedMN, 1, false>(F.wv, ring, Kdim, (Kdim) * 2, (Kdim) * 2, S, E); } )

    PH(0, phase_prologue(F); )
    PH(1, phase_n1<0>(F); )
    PH(2, phase_pool(F); )
    PH(3, { SchedMN S{136, 4, F.G, cblk, 0, (const char*)WSP(bf16, SC_P), (const char*)WSP(bf16, WS_PW), (size_t)256 * 2048, 512, (size_t)65536 * 2};
        EpiRes<true, true> E{XS, INP(I_X), INP(I_CTX), MOD + 0 * 9 * 6144 + 2048, INP(I_POOLS), XS, 0, 1.0f};
        pg8::gemm_phase<EpiRes<true, true>, SchedMN, 1, false>(F.wv, ring, 256, 2048, 512, S, E); } )
    MOE_PHASES(0, 4)
    PH(8, phase_n1<1>(F, dry); )
    PH(9, { SchedMN S{136, 8, F.G, cblk, 0, Hb, (const char*)WSP(bf16, WS_LIN), (size_t)256 * 2048, 0, (size_t)256 * 2048};
        EpiLruIn E{WSP(bf16, SC_YG), WSP(bf16, SC_ZX)};
        pg8::gemm_phase<EpiLruIn, SchedMN, 1, false>(F.wv, ring, 1024, 2048, 2048, S, E); } )
    PH(10, phase_conv(F); )
    PH(11, { SchedMN S{136, 16, F.G, cblk, 1, (const char*)WSP(bf16, SC_XR), (const char*)WSP(bf16, WS_LG), (size_t)256 * 2048, 256, (size_t)256 * 256};
        EpiGates E{WSP(bf16, SC_XR), WSP(bf16, SC_YG), WSP(bf16, SC_HL0), WSP(bf16, SC_AC0), WSP(bf16, SC_AC1), WSP(f32x2, WS_AGG), INP(I_BA), INP(I_BX), WSP(float, WS_SPT)};
        pg8::gemm_phase<EpiGates, SchedMN, 0, false>(F.wv, ring, 128, 2048, 256, S, E); } )
    PH(12, phase_carry(F); )
    PH(13, phase_lruc(F); )
    RES_GEMM(14, 1, SC_G, WS_LOUT, 136, 1024)
    MOE_PHASES(1, 15)
    PH(19, phase_n1<2>(F, dry); )
    PH(20, { SchedMN S{136, 6, F.G, cblk, 0, Hb, (const char*)WSP(bf16, WS_QKV), (size_t)256 * 2048, 0, (size_t)256 * 2048};
        EpiQKV E{WSP(bf16, SC_Q), WSP(bf16, SC_KA), WSP(bf16, SC_VA), INP(I_QG), INP(I_KG), WSP(f32x2, WS_ROPE)};
        pg8::gemm_phase<EpiQKV, SchedMN, 2, false>(F.wv, ring, 1024, 2048, 2048, S, E); } )
    PH(21, phase_attn(F, (char*)lds, dry ? WSP(bf16, WS_H) : WSP(bf16, SC_Q)); )
    RES_GEMM(22, 2, SC_Q, WS_WO, 128, 1024)
    MOE_PHASES(2, 23)
    PH(27, phase_n1<3>(F, dry); )
    PH(28, { SchedMN S{128, 24, F.G, cblk, 0, Hb, (const char*)WSP(bf16, WS_GIN), (size_t)256 * 1024, 0, (size_t)256 * 1024};
        EpiGmlpIn E{WSP(bf16, SC_U), WSP(bf16, SC_V), WSP(f32x2, SC_PSUM)};
        pg8::gemm_phase<EpiGmlpIn, SchedMN, 1, false, true>(F.wv, ring, 1024, 1024, 1024, S, E); } )
    PH(29, phase_spatial(F, (unsigned char*)F.out); )
    PH(30, { SchedMN S{128, 4, F.G, cblk, 0, (const char*)F.out, (const char*)WSP(bf16, WS_GOUT), (size_t)256 * 3072, 0, (size_t)256 * 3072};
        EpiRes<false, false> E{XS, nullptr, nullptr, MOD + 3 * 9 * 6144 + 2048, nullptr, XS, 0, W8_INV};
        pg8::gemm_phase<EpiRes<false, false>, SchedMN, 1, false, true>(F.wv, ring, 3072, 3072, 3072, S, E); } )
    MOE_PHASES(3, 31)
#ifdef PROBE_MASK_A
    if (IN(35)) { __syncthreads(); float TA = 0.f, TB = 0.f;
        for (int k = 0; k < 35; ++k) { const volatile LAS unsigned long long* st = (const volatile LAS unsigned long long*)(F.lds + LDSCTL_OFF); const float dt = (float)(st[k + 1] - st[k]) * 0.01f;
            if ((PROBE_MASK_A >> k) & 1ull) TA += dt; if ((PROBE_MASK_B >> k) & 1ull) TB += dt; }
        const float va = sqrtf(TA);
        for (size_t i = (size_t)blockIdx.x * 512 + threadIdx.x; i < (size_t)RL * D; i += (size_t)F.G * 512) F.out[i] = (i == 0) ? TB : va; }
#else
    if (IN(35)) { phase_n1<4>(F); }
#endif
#ifdef PROBE_DELAY_MASK
    STAMP(36);
    if (blockIdx.x == 0 && xb_thread0(F.wv)) {
        const volatile LAS unsigned long long* st = (const volatile LAS unsigned long long*)(F.lds + LDSCTL_OFF);
        unsigned long long T = 0;
        for (int k = 0; k < 36; ++k) if (((unsigned long long)(PROBE_DELAY_MASK) >> k) & 1ull) T += st[k + 1] - st[k];
        T *= (unsigned long long)(PROBE_DELAY_MULT);
        const unsigned long long t0 = __builtin_amdgcn_s_memrealtime();
        while (__builtin_amdgcn_s_memrealtime() - t0 < T) __builtin_amdgcn_s_sleep(32);
    }
#endif
#undef IN
#undef SEAM
#undef MOE_PHASES
#undef CONV_SIDE
#undef RES_GEMM
#undef PH
}

extern "C" void kernel_launch(void* const* d_in, const int* in_sizes, int n_in, void* d_out, int out_size, void* d_ws, size_t ws_size, hipStream_t stream) {
    static int grid = 0;
    if (grid == 0) {
        if (n_in != N_IN || out_size != RL * D || ws_size < WS_END) { fprintf(stderr, "kernel_launch: unexpected shapes (n_in %d out %d ws %zu need %zu)\n", n_in, out_size, ws_size, (size_t)WS_END); grid = -1; return; }
        int dev = 0, cus = 0, per_cu = 0;
        if (hipGetDevice(&dev) != hipSuccess || hipDeviceGetAttribute(&cus, hipDeviceAttributeMultiprocessorCount, dev) != hipSuccess) { grid = -1; return; }
        if (hipFuncSetAttribute((const void*)hyb_fwd, hipFuncAttributeMaxDynamicSharedMemorySize, LDS_BYTES) != hipSuccess) { fprintf(stderr, "kernel_launch: hipFuncSetAttribute failed\n"); grid = -1; return; }
        if (hipOccupancyMaxActiveBlocksPerMultiprocessor(&per_cu, (const void*)hyb_fwd, NWAVES * 64, LDS_BYTES) != hipSuccess || per_cu < 1) { fprintf(stderr, "kernel_launch: occupancy query reports %d\n", per_cu); }
        (void)hipGetLastError();
        grid = cus;
    }
    if (grid < 0) return;
    (void)hipMemsetAsync((char*)d_ws + WS_CTL, 0, CTL_ZERO_BYTES, stream);
    Args a{};
    for (int i = 0; i < N_IN; ++i) a.in[i] = (const float*)d_in[i];
    a.out = (float*)d_out; a.ws = (unsigned char*)d_ws;
#if MK_PER_PHASE
    for (int p = 0; p < N_PHASES; ++p) { a.ph_lo = p; a.ph_hi = p + 1; hipLaunchKernelGGL(hyb_fwd, dim3(grid), dim3(NWAVES * 64), LDS_BYTES, stream, a); }
#else
    a.ph_lo = 0; a.ph_hi = N_PHASES;
    hipLaunchKernelGGL(hyb_fwd, dim3(grid), dim3(NWAVES * 64), LDS_BYTES, stream, a);
#endif
    const hipError_t le = hipPeekAtLastError();
    if (le != hipSuccess) fprintf(stderr, "kernel_launch: launch failed: %s\n", hipGetErrorName(le));
}
```

```cpp
#include <hip/hip_runtime.h>
#include <hip/hip_bf16.h>
#include <cstdio>
#include <cstdint>
#include <cmath>

#ifndef MK_PER_PHASE
#define MK_PER_PHASE 0
#endif

#define GAS __attribute__((address_space(1)))
#define LAS __attribute__((address_space(3)))
typedef unsigned short bf16;
typedef unsigned v4u __attribute__((ext_vector_type(4)));
typedef unsigned v2u __attribute__((ext_vector_type(2)));
typedef float f32x4 __attribute__((ext_vector_type(4)));
typedef float f32x2 __attribute__((ext_vector_type(2)));
typedef short bf16x8 __attribute__((ext_vector_type(8)));
typedef GAS unsigned gu32;
#define RLX_AGENT __ATOMIC_RELAXED, __HIP_MEMORY_SCOPE_AGENT
#define LDS_WAIT() asm volatile("s_waitcnt lgkmcnt(0)" ::: "memory")
#define VM_WAIT() asm volatile("s_waitcnt vmcnt(0)" ::: "memory")

constexpr int D = 1024, NB = 8, SEQ = 4096, CTX = 256;
constexpr int RL = NB * SEQ, RC = NB * CTX, RT = RL + RC;
constexpr int KVLEN = CTX + SEQ;
constexpr int NYL = 65536, NYC = 4096, NY = NYL + NYC;
constexpr float EPS = 1e-6f;
constexpr int NWAVES = 8;

constexpr size_t MiB = 1u << 20;
constexpr size_t WS_CTL = 0, CTL_ZERO_BYTES = 1 * MiB;
constexpr size_t WS_MOD = 1 * MiB;
constexpr size_t WS_ROPE = WS_MOD + 900 * 1024;
constexpr size_t WS_SPT = WS_ROPE + 8192;
constexpr size_t WS_PW = 2 * MiB;
constexpr size_t WS_LIN = WS_PW + 512 * 1024;
constexpr size_t WS_LG = WS_LIN + 4 * MiB;
constexpr size_t WS_LOUT = WS_LG + 1 * MiB;
constexpr size_t WS_QKV = WS_LOUT + 2 * MiB;
constexpr size_t WS_WO = WS_QKV + 3 * MiB;
constexpr size_t WS_GIN = WS_WO + 2 * MiB;
constexpr size_t WS_GS = WS_GIN + 12 * MiB;
constexpr size_t WS_GOUT = WS_GS + 128 * 1024;
constexpr size_t WS_WGU = 34 * MiB;
constexpr size_t WS_WD = WS_WGU + 32 * MiB;
constexpr size_t WSET = 48 * MiB;
constexpr size_t WS_XS = 130 * MiB;
constexpr size_t WS_H = 266 * MiB;
constexpr size_t WS_AFF = 334 * MiB;
constexpr size_t WS_INV = WS_AFF + (size_t)RT * 16 * 4;
constexpr size_t WS_IDX = WS_INV + (size_t)RT * 16 * 4;
constexpr size_t WS_GATE = WS_IDX + (size_t)NY * 4;
constexpr size_t WS_AGG = 340 * MiB;
constexpr size_t WS_CARRY = WS_AGG + (size_t)2 * 544 * 1024 * 8;
constexpr size_t WS_SCR = 354 * MiB;
static_assert(WS_GOUT + 6 * MiB <= WS_WGU && WS_GATE + (size_t)NY * 4 <= WS_AGG && WS_CARRY + (size_t)2 * 544 * 1024 * 4 <= WS_SCR, "ws map");
constexpr size_t SC_ACT = WS_SCR, SC_Y = WS_SCR + 136 * MiB;
constexpr size_t SC_P = WS_SCR;
constexpr size_t SC_YG = WS_SCR, SC_ZX = WS_SCR + 68 * MiB, SC_XR = WS_SCR + 136 * MiB;
constexpr size_t SC_HL0 = WS_SCR + 204 * MiB, SC_HL1 = WS_SCR + 272 * MiB, SC_AC0 = WS_SCR + 340 * MiB, SC_AC1 = WS_SCR + 408 * MiB;
constexpr size_t SC_G = SC_ZX;
constexpr size_t SC_Q = WS_SCR, SC_KA = WS_SCR + 68 * MiB, SC_VA = WS_SCR + 85 * MiB;
constexpr size_t SC_U = WS_SCR, SC_V = WS_SCR + 192 * MiB, SC_PSUM = WS_SCR + 384 * MiB;
constexpr size_t WS_END = WS_SCR + 476 * MiB;
constexpr int CW_BAR = 4096;

constexpr int RING_BYTES = 131072;
constexpr int LDSCTL_OFF = RING_BYTES, MISC_OFF = LDSCTL_OFF + 320;
constexpr int LDS_BYTES = 147456;

__device__ __forceinline__ unsigned f2bf(float f) { unsigned u = __builtin_bit_cast(unsigned, f); return (u + 0x7fffu + ((u >> 16) & 1u)) >> 16; }
typedef __bf16 hwbf16x2 __attribute__((ext_vector_type(2)));
__device__ __forceinline__ unsigned pk2(float lo, float hi) { const f32x2 v = {lo, hi}; return __builtin_bit_cast(unsigned, __builtin_convertvector(v, hwbf16x2)); }
__device__ __forceinline__ unsigned pk4_fp8(float a, float b, float c, float d) {
    int w = 0; w = __builtin_amdgcn_cvt_pk_fp8_f32(a, b, w, false); w = __builtin_amdgcn_cvt_pk_fp8_f32(c, d, w, true); return (unsigned)w; }
__device__ __forceinline__ float sat8(float x) { return __builtin_amdgcn_fmed3f(x, -448.0f, 448.0f); }
__device__ __forceinline__ unsigned pk4_fp8_sat(float a, float b, float c, float d) { return pk4_fp8(sat8(a), sat8(b), sat8(c), sat8(d)); }
constexpr float W8_SCALE = 64.0f, W8_INV = 1.0f / 64.0f;
constexpr float Y8_SCALE = 16.0f, Y8_INV = 1.0f / 16.0f;
__device__ __forceinline__ float bflo(unsigned w) { return __builtin_bit_cast(float, w << 16); }
__device__ __forceinline__ float bfhi(unsigned w) { return __builtin_bit_cast(float, w & 0xffff0000u); }
__device__ __forceinline__ int opaque_tid(int wv) { int l; asm volatile("v_mbcnt_lo_u32_b32 %0, -1, 0\n\tv_mbcnt_hi_u32_b32 %0, -1, %0" : "=v"(l)); return (wv << 6) | l; }
__device__ __forceinline__ f32x4 bf4(v2u w) { return (f32x4){bflo(w.x), bfhi(w.x), bflo(w.y), bfhi(w.y)}; }
__device__ __forceinline__ float wave_sum(float v) {
#pragma unroll
    for (int o = 1; o < 64; o <<= 1) v += __shfl_xor(v, o);
    return v;
}
__device__ __forceinline__ float gelu_tanh(float x) {
    const float t = x * (1.0f + 0.044715f * x * x);
    return x * __builtin_amdgcn_rcpf(1.0f + __builtin_amdgcn_exp2f(-2.3022082f * t));
}
__device__ __forceinline__ f32x2 gelu_tanh2(f32x2 x) {
    const f32x2 u = x * x, t = u * (-0.10294323f) + (-2.3022082f), a = x * t;
    f32x2 e; e.x = __builtin_amdgcn_exp2f(a.x); e.y = __builtin_amdgcn_exp2f(a.y);
    const f32x2 d = e + 1.0f; f32x2 r; r.x = __builtin_amdgcn_rcpf(d.x); r.y = __builtin_amdgcn_rcpf(d.y);
    return x * r;
}
__device__ __forceinline__ void gelu4(f32x4& v) { const f32x2 a = gelu_tanh2((f32x2){v.x, v.y}), b = gelu_tanh2((f32x2){v.z, v.w}); v = (f32x4){a.x, a.y, b.x, b.y}; }
__device__ __forceinline__ float sigmoid_f(float x) { return __builtin_amdgcn_rcpf(1.0f + __builtin_amdgcn_exp2f(-1.4426950409f * x)); }

#define XB_TMO      128
#define XB_XCNT(j)  (256  + 64 * (j))
#define XB_XSUB(j)  (1280 + 64 * (j))
#define XB_XGEN(j)  (2304 + 64 * (j))
#define XB_TOP      3328
#define XB_TOPGEN   3392
#define XCD_BAR_WORDS 3456
#define XB_SPIN_CAP (1u << 18)
__device__ __forceinline__ unsigned xb_ld(unsigned* p)              { return __hip_atomic_load(p, __ATOMIC_RELAXED, __HIP_MEMORY_SCOPE_AGENT); }
__device__ __forceinline__ unsigned xb_add(unsigned* p, unsigned v) { return __hip_atomic_fetch_add(p, v, __ATOMIC_RELAXED, __HIP_MEMORY_SCOPE_AGENT); }
__device__ __forceinline__ unsigned xb_xcc_id() { return (unsigned)__builtin_amdgcn_s_getreg((3 << 11) | 20) & 0xFu; }
#define XB_SPIN(cond, bar) do { unsigned _sp = 0; while (cond) { __builtin_amdgcn_s_sleep(1); \
    if ((++_sp & 255u) == 0u) { if (xb_ld(&(bar)[XB_TMO])) break; if (_sp > XB_SPIN_CAP) { atomicAdd(&(bar)[XB_TMO], 1u); break; } } } } while (0)
struct XcdBarrier { unsigned* bar; unsigned x; volatile LAS unsigned* st; int wv; };
__device__ __forceinline__ bool xb_thread0(int wv) { return wv == 0 && __builtin_amdgcn_mbcnt_hi(~0u, __builtin_amdgcn_mbcnt_lo(~0u, 0u)) == 0u; }
__device__ __forceinline__ XcdBarrier xcd_barrier_post(unsigned* bar, volatile LAS unsigned* st, int wv) {
    XcdBarrier b; b.bar = bar; b.x = xb_xcc_id(); b.st = st; b.wv = wv;
    if (xb_thread0(wv)) (void)xb_add(&bar[XB_XCNT(b.x)], 1u);
    return b;
}
__device__ __forceinline__ void xcd_barrier_complete(unsigned* bar, unsigned x, unsigned& nloc, unsigned& nx) {
    const unsigned G = gridDim.x * gridDim.y * gridDim.z;
    unsigned sum, cnt, mine, sp = 0u;
    for (;;) {
        sum = 0u; cnt = 0u; mine = 0u;
#pragma unroll
        for (unsigned j = 0; j < 16; ++j) { const unsigned c = xb_ld(&bar[XB_XCNT(j)]); sum += c; cnt += (c > 0u) ? 1u : 0u; mine = (j == x) ? c : mine; }
        if (sum == G) break;
        __builtin_amdgcn_s_sleep(1);
        if ((++sp & 255u) == 0u) { if (xb_ld(&bar[XB_TMO])) break; if (sp > XB_SPIN_CAP) { atomicAdd(&bar[XB_TMO], 1u); break; } }
    }
    nloc = mine > 0u ? mine : 1u; nx = cnt > 0u ? cnt : 1u;
}
__device__ __forceinline__ void xcd_barrier(const XcdBarrier& b) {
    asm volatile("s_waitcnt vmcnt(0)" ::: "memory");
    __syncthreads();
    if (xb_thread0(b.wv)) {
        unsigned* bar = b.bar;
        __builtin_amdgcn_s_waitcnt(0);
        unsigned nloc = b.st[0], nx = b.st[1];
        if (nloc == 0u) { xcd_barrier_complete(bar, b.x, nloc, nx); b.st[0] = nloc; b.st[1] = nx; }
        const unsigned old = xb_add(&bar[XB_XSUB(b.x)], 1u);
        const unsigned gen = old / nloc;
        if (old + 1u == (gen + 1u) * nloc) {
            __builtin_amdgcn_fence(__ATOMIC_RELEASE, "agent");
            asm volatile("s_waitcnt vmcnt(0)" ::: "memory");
            const unsigned og = xb_add(&bar[XB_TOP], 1u);
            const unsigned tg = og / nx;
            if (og + 1u == (tg + 1u) * nx) xb_add(&bar[XB_TOPGEN], 1u);
            else XB_SPIN(xb_ld(&bar[XB_TOPGEN]) == tg, bar);
            __builtin_amdgcn_fence(__ATOMIC_ACQUIRE, "agent");
            xb_add(&bar[XB_XGEN(b.x)], 1u);
            asm volatile("s_waitcnt vmcnt(0)" ::: "memory");
        } else {
            XB_SPIN(xb_ld(&bar[XB_XGEN(b.x)]) == gen, bar);
            __builtin_amdgcn_fence(__ATOMIC_ACQUIRE, "agent");
            asm volatile("s_waitcnt vmcnt(0)" ::: "memory");
        }
    }
    __syncthreads();
}

namespace pg8 {
constexpr int BM = 256, BK = 64, HALF = 128, HTB = HALF * BK * 2, STAGE_BYTES = 8 * HTB, NXCD = 8, WGM = 8;
__host__ __device__ __forceinline__ int lds_byte(int r, int c) { const int st = (r >> 4) * 2 + (c >> 5), rr = r & 15, cc = c & 31, ob = rr * 64 + cc * 2; return st * 1024 + (ob ^ (((ob >> 9) & 1) << 5)); }
__host__ __device__ __forceinline__ void stage_rc(int b, int& R, int& C) { const int st = b / 1024, sb = b % 1024, swz = sb ^ (((sb >> 9) & 1) << 5); R = (st >> 1) * 16 + swz / 64; C = (st & 1) * 32 + (swz % 64) / 2; }
__host__ __device__ __forceinline__ int perm32(int rho) { const int n = rho >> 4, i = rho & 15; return 8 * (i >> 2) + 4 * n + (i & 3); }

struct Unit { const char* A; const char* B; const int* rows; int pm, pn; int half, row0; };

__device__ __forceinline__ bool static_order_l(long L, int nM, int nN, int& pm, int& pn) {
    const int nwg = nM * nN; if (L >= nwg) return false;
    int wgid = (int)L; { const int q = nwg / NXCD, r = nwg % NXCD, xcd = wgid % NXCD, off = wgid / NXCD; wgid = (xcd < r ? xcd * (q + 1) : r * (q + 1) + (xcd - r) * q) + off; }
    const int nig = WGM * nN, gid = wgid / nig, fm = gid * WGM, gsz = (nM - fm) < WGM ? (nM - fm) : WGM;
    pm = fm + ((wgid % nig) % gsz); pn = (wgid % nig) / gsz; return true;
}
__device__ __forceinline__ bool static_order(int i, int G, int c, int nM, int nN, int& pm, int& pn) { return static_order_l((long)i * G + c, nM, nN, pm, pn); }

typedef int v8i_t __attribute__((ext_vector_type(8)));
typedef int v4i_t __attribute__((ext_vector_type(4)));
__device__ __forceinline__ v8i_t cat8(bf16x8 lo, bf16x8 hi) { return __builtin_shufflevector(__builtin_bit_cast(v4i_t, lo), __builtin_bit_cast(v4i_t, hi), 0, 1, 2, 3, 4, 5, 6, 7); }
__device__ __forceinline__ const char* uptr(const char* p) {
    const unsigned long long v = (unsigned long long)p; const unsigned lo = __builtin_amdgcn_readfirstlane((unsigned)v), hi = __builtin_amdgcn_readfirstlane((unsigned)(v >> 32));
    return (const char*)(((unsigned long long)hi << 32) | lo); }
template <class Epi, class Sched, int PERM, bool GATHER, bool FP8 = false>
__device__ __forceinline__ void gemm_phase(const int wv, LAS unsigned char* lds, const int K, const int lda  , const int ldb  , const Sched& S, const Epi& E) {
    const int tid = opaque_tid(wv), wid = __builtin_amdgcn_readfirstlane(tid >> 6), lane = tid & 63, wr = wid >> 2, wc = wid & 3, fr = lane & 15, fq = lane >> 4;
    int nt = K / (FP8 ? 2 * BK : BK); asm volatile("" : "+s"(nt));
    unsigned voffB[2];
#pragma unroll
    for (int i = 0; i < 2; ++i) { int R, C; stage_rc(tid * 16 + i * 8192, R, C);
        const int Rb = (PERM == 0) ? R : (PERM == 1) ? ((R & ~31) + perm32(R & 31)) : (64 * (R >> 5) + perm32(R & 31));
        voffB[i] = (unsigned)(Rb * ldb + C * 2); }
    const unsigned hstepB = (unsigned)((PERM == 2 ? 32 : 128) * ldb), hstepA = (unsigned)(128 * lda);
    const size_t kstep = (size_t)(BK * 2);
    const unsigned ldsw = (unsigned)wid * 1024u;
    const int aoffk0 = FP8 ? lds_byte(wr * 64 + fr, fq * 16) : lds_byte(wr * 64 + fr, fq * 8), aoffk1 = aoffk0 + (FP8 ? 16 : 1024);
    const int boffk0 = FP8 ? lds_byte(wc * 32 + fr, fq * 16) : lds_byte(wc * 32 + fr, fq * 8), boffk1 = boffk0 + (FP8 ? 16 : 1024); (void)boffk1;
    int boffB = boffk0 + 4 * HTB; asm volatile("" : "+v"(boffB));
#define PG8_SA(b, h) (((b) * 2 + (h)) * HTB)
#define PG8_SB(b, h) ((4 + (b) * 2 + (h)) * HTB)
#define PG8_STAGE2(bufoff, gbase_, o0, o1) do { const char* gbase = uptr(gbase_); unsigned o0_ = (o0), o1_ = (o1); asm volatile("" : "+v"(o0_), "+v"(o1_));   \
        __builtin_amdgcn_global_load_lds((const unsigned*)((const char*)(gbase) + o0_), (LAS unsigned*)(lds + (bufoff) + ldsw), 16, 0, 0); \
        __builtin_amdgcn_global_load_lds((const unsigned*)((const char*)(gbase) + o1_), (LAS unsigned*)(lds + (bufoff) + ldsw + 8192), 16, 0, 0); } while (0)
#define PG8_STAGEB(bufoff, gbase, h) PG8_STAGE2(bufoff, (gbase) + (size_t)(h) * hstepB, voffB[0], voffB[1])
#define PG8_STAGEA(bufoff, gbase, h) do { if (GATHER) PG8_STAGE2(bufoff, gbase, cO[2 * (h)], cO[2 * (h) + 1]); else PG8_STAGE2(bufoff, (gbase) + (size_t)(h) * hstepA, cO[0], cO[1]); } while (0)
#define PG8_LDA(dst, b, h) do { _Pragma("unroll") for (int m = 0; m < 4; ++m) { const bf16x8 l0_ = *(const LAS bf16x8*)(lds + PG8_SA(b, h) + aoffk0 + m * 2048), l1_ = *(const LAS bf16x8*)(lds + PG8_SA(b, h) + aoffk1 + m * 2048); \
        if constexpr (FP8) dst##8[m] = cat8(l0_, l1_); else { dst[m][0] = l0_; dst[m][1] = l1_; } } } while (0)
#define PG8_LDB(dst, b, h) do { _Pragma("unroll") for (int n = 0; n < 2; ++n) { const bf16x8 l0_ = *(const LAS bf16x8*)(lds + boffB + (PG8_SB(b, h) - 4 * HTB + n * 2048)), l1_ = *(const LAS bf16x8*)(lds + boffB + (PG8_SB(b, h) - 4 * HTB + n * 2048 + (FP8 ? 16 : 1024))); \
        if constexpr (FP8) dst##8[n] = cat8(l0_, l1_); else { dst[n][0] = l0_; dst[n][1] = l1_; } } } while (0)
#define PG8_MMA(ai, bj, At, Bt) do { __builtin_amdgcn_s_setprio(1); _Pragma("unroll") for (int m = 0; m < 4; ++m) _Pragma("unroll") for (int n = 0; n < 2; ++n) { \
        if constexpr (FP8) acc[ai][bj][m][n] = __builtin_amdgcn_mfma_scale_f32_16x16x128_f8f6f4(Bt##8[n], At##8[m], acc[ai][bj][m][n], 0, 0, 0, 0, 0, 0); \
        else { _Pragma("unroll") for (int k = 0; k < 2; ++k) acc[ai][bj][m][n] = __builtin_amdgcn_mfma_f32_16x16x32_bf16(Bt[n][k], At[m][k], acc[ai][bj][m][n], 0, 0, 0); } } \
        __builtin_amdgcn_s_setprio(0); } while (0)
#define PG8_WAIT_V(n) asm volatile("s_waitcnt vmcnt(" #n ")" ::: "memory")
#define PG8_WAIT_L(n) asm volatile("s_waitcnt lgkmcnt(" #n ")" ::: "memory")
#define PG8_BAR __builtin_amdgcn_s_barrier()
#define PG8_SCHED __builtin_amdgcn_sched_barrier(0)
#define PG8_AOFFS(dst, u) do { const int tq_ = GATHER ? opaque_tid(wv) : tid;   \
        _Pragma("unroll") for (int i = 0; i < 2; ++i) { int R_, C_; stage_rc(tq_ * 16 + i * 8192, R_, C_); _Pragma("unroll") for (int h = 0; h < 2; ++h) { \
        if (GATHER) dst[h * 2 + i] = (unsigned)((u).rows[h * 128 + R_]) * (unsigned)lda + (unsigned)(C_ * 2); \
        else dst[h * 2 + i] = (unsigned)((h * 128 + R_) * lda + C_ * 2); } } } while (0)
    Unit cur, nxt; int ui = 0;
    if (!S.next(0, cur)) return;
    f32x4 acc[2][2][4][2];
#pragma unroll
    for (int a = 0; a < 2; ++a)
#pragma unroll
        for (int b = 0; b < 2; ++b)
#pragma unroll
            for (int m = 0; m < 4; ++m)
#pragma unroll
                for (int n = 0; n < 2; ++n) acc[a][b][m][n] = (f32x4){0.f, 0.f, 0.f, 0.f};
    bf16x8 At[4][2], B0[2][2], B1[2][2]; v8i_t At8[4], B08[2], B18[2];
    const char* cA = cur.A; const char* cB = cur.B;
    unsigned cO[4], nO[4];
    PG8_AOFFS(cO, cur);
    PG8_STAGEB(PG8_SB(0, 0), cB, 0); PG8_STAGEB(PG8_SB(0, 1), cB, 1); PG8_STAGEA(PG8_SA(0, 0), cA, 0); PG8_STAGEA(PG8_SA(0, 1), cA, 1);
    if (wr == 1) PG8_BAR;
    PG8_WAIT_V(2); PG8_BAR;
    PG8_STAGEB(PG8_SB(1, 0), cB + kstep, 0); PG8_STAGEA(PG8_SA(1, 0), cA + kstep, 0); PG8_STAGEB(PG8_SB(1, 1), cB + kstep, 1);
    PG8_WAIT_V(6); PG8_BAR;
    for (;;) {
        const bool has_next = S.next(ui + 1, nxt);
        const bool hf = __builtin_amdgcn_readfirstlane(cur.half) != 0;
        const char* nA = has_next ? nxt.A : cA; const char* nB = has_next ? nxt.B : cB;
        if (GATHER) { if (has_next) { PG8_AOFFS(nO, nxt); } else {
#pragma unroll
            for (int q = 0; q < 4; ++q) nO[q] = cO[q]; } }
#pragma unroll 1
        for (int t = 0; t < nt; t += 2) {
            const bool last = (t == nt - 2);
            const char* a1 = cA + (size_t)(t + 1) * kstep;
            const char* a2 = last ? nA : cA + (size_t)(t + 2) * kstep; const char* b2 = last ? nB : cB + (size_t)(t + 2) * kstep;
            const char* a3 = a2 + kstep; const char* b3 = b2 + kstep;
            PG8_LDB(B0, 0, 0); PG8_LDB(B1, 0, 1); PG8_SCHED; PG8_LDA(At, 0, 0); PG8_STAGEA(PG8_SA(1, 1), a1, 1);
            if (GATHER) { if (last) {
#pragma unroll
                for (int q = 0; q < 4; ++q) cO[q] = nO[q]; } }
            PG8_WAIT_V(8); PG8_WAIT_L(0); PG8_BAR; PG8_MMA(0, 0, At, B0); PG8_MMA(0, 1, At, B1); PG8_BAR; PG8_SCHED;
            if (!hf) PG8_LDA(At, 0, 1);
            PG8_STAGEB(PG8_SB(0, 0), b2, 0); PG8_STAGEB(PG8_SB(0, 1), b2, 1); PG8_STAGEA(PG8_SA(0, 0), a2, 0);
            PG8_WAIT_V(8); PG8_WAIT_L(0); PG8_BAR; if (!hf) { PG8_MMA(1, 0, At, B0); PG8_MMA(1, 1, At, B1); } PG8_BAR; PG8_SCHED;
            PG8_LDB(B0, 1, 0); PG8_LDB(B1, 1, 1); PG8_SCHED; PG8_LDA(At, 1, 0); PG8_STAGEA(PG8_SA(0, 1), a2, 1);
            PG8_WAIT_V(8); PG8_WAIT_L(0); PG8_BAR; PG8_MMA(0, 0, At, B0); PG8_MMA(0, 1, At, B1); PG8_BAR; PG8_SCHED;
            if (!hf) PG8_LDA(At, 1, 1);
            PG8_STAGEB(PG8_SB(1, 0), b3, 0); PG8_STAGEB(PG8_SB(1, 1), b3, 1); PG8_STAGEA(PG8_SA(1, 0), a3, 0);
            PG8_WAIT_V(8); PG8_WAIT_L(0); PG8_BAR; if (!hf) { PG8_MMA(1, 0, At, B0); PG8_MMA(1, 1, At, B1); } PG8_BAR; PG8_SCHED;
        }
        if (wr == 0) PG8_BAR;
        { const int tz = opaque_tid(wv), lz = tz & 63; E(acc, cur, wr, wc, lz & 15, lz >> 4); }
        if (!has_next) break;
#pragma unroll
        for (int a = 0; a < 2; ++a)
#pragma unroll
            for (int b = 0; b < 2; ++b)
#pragma unroll
                for (int m = 0; m < 4; ++m)
#pragma unroll
                    for (int n = 0; n < 2; ++n) acc[a][b][m][n] = (f32x4){0.f, 0.f, 0.f, 0.f};
        cur = nxt; cA = nA; cB = nB; ++ui;
        if (GATHER) {
#pragma unroll
            for (int q = 0; q < 4; ++q) cO[q] = nO[q]; }
        if (wr == 1) PG8_BAR;
    }
    PG8_WAIT_V(0);
    PG8_BAR;
#undef PG8_SA
#undef PG8_SB
#undef PG8_STAGE2
#undef PG8_STAGEB
#undef PG8_STAGEA
#undef PG8_LDA
#undef PG8_LDB
#undef PG8_MMA
#undef PG8_WAIT_V
#undef PG8_WAIT_L
#undef PG8_BAR
#undef PG8_SCHED
#undef PG8_AOFFS
}
}

namespace attn_body {
using bf16=__hip_bfloat16;
using bf16x8=__attribute__((ext_vector_type(8)))short;
using s16x4=__attribute__((ext_vector_type(4)))short;
using f32x16=__attribute__((ext_vector_type(16)))float;
using u32x4=__attribute__((ext_vector_type(4)))unsigned;
constexpr int D=64,DMQ=1024,DMK=256;
constexpr int NW=8,QBLK=32,QB=QBLK*NW,KVBLK=64;
__device__ __forceinline__ int crow(int r,int hi){return (r&3)+8*(r>>2)+4*hi;}
#define SBAR() __builtin_amdgcn_sched_barrier(0)
constexpr int NSLOT=3, SLOTB=8192;
constexpr int LDS_K=0, LDS_V=NSLOT*SLOTB, LDS_WS=2*NSLOT*SLOTB, LDS_OST=LDS_WS+NW*64*4, LDS_BYTES=LDS_OST+NW*4096;
constexpr float C2=0.125f*1.4426950408889634f;
__device__ __forceinline__ void glds16(const void*gsrc,unsigned lds_dst){unsigned keep;
  asm volatile("s_mov_b32 %0, m0\n\ts_mov_b32 m0, %2\n\ts_nop 0\n\tglobal_load_lds_dwordx4 %1, off\n\ts_mov_b32 m0, %0":"=&s"(keep):"v"(gsrc),"s"(lds_dst):"memory");}
__device__ __forceinline__ float max3f(float a,float b,float c){float r;asm("v_max3_f32 %0, %1, %2, %3":"=v"(r):"v"(a),"v"(b),"v"(c));return r;}
__device__ __forceinline__ float max2f(float a,float b){float r;asm("v_max_f32_e32 %0, %1, %2":"=v"(r):"v"(a),"v"(b));return r;}
__device__ __forceinline__ float fadd_s(float a,float b){float r;asm("v_add_f32_e32 %0, %1, %2":"=v"(r):"v"(a),"v"(b));return r;}
__device__ __forceinline__ float fsub_s(float a,float b){float r;asm("v_sub_f32_e32 %0, %1, %2":"=v"(r):"v"(a),"v"(b));return r;}
typedef float f32x2_t __attribute__((ext_vector_type(2))); typedef __bf16 bf16x2_t __attribute__((ext_vector_type(2)));
__device__ __forceinline__ unsigned cvtpk_s(float lo,float hi){f32x2_t v={lo,hi};bf16x2_t b=__builtin_convertvector(v,bf16x2_t);return __builtin_bit_cast(unsigned,b);}
#define WAIT_BAR(N) asm volatile("s_waitcnt vmcnt(" #N ") lgkmcnt(0)\n\ts_barrier":::"memory")

__device__ __forceinline__ void qkt(f32x16&p0,f32x16&p1,const char*Kslot,const bf16x8*qr,const f32x16&negm,int r32,int hi){
  const char*kb=Kslot+hi*1024+r32*16;
  #pragma unroll
  for(int d0=0;d0<4;++d0){
    const bf16x8 b0=*reinterpret_cast<const bf16x8*>(kb+d0*2048);
    const bf16x8 b1=*reinterpret_cast<const bf16x8*>(kb+d0*2048+512);
    if(d0==0){p0=__builtin_amdgcn_mfma_f32_32x32x16_bf16(b0,qr[0],negm,0,0,0);p1=__builtin_amdgcn_mfma_f32_32x32x16_bf16(b1,qr[0],negm,0,0,0);}
    else{p0=__builtin_amdgcn_mfma_f32_32x32x16_bf16(b0,qr[d0],p0,0,0,0);p1=__builtin_amdgcn_mfma_f32_32x32x16_bf16(b1,qr[d0],p1,0,0,0);}}
}
typedef __attribute__((address_space(3))) const char* lds_cptr;
typedef short v4i16_t __attribute__((ext_vector_type(4)));
__device__ __forceinline__ void kload8(bf16x8*kf,lds_cptr kp){
  kf[0]=*(const __attribute__((address_space(3))) bf16x8*)(kp);      kf[1]=*(const __attribute__((address_space(3))) bf16x8*)(kp+512);
  kf[2]=*(const __attribute__((address_space(3))) bf16x8*)(kp+2048); kf[3]=*(const __attribute__((address_space(3))) bf16x8*)(kp+2560);
  kf[4]=*(const __attribute__((address_space(3))) bf16x8*)(kp+4096); kf[5]=*(const __attribute__((address_space(3))) bf16x8*)(kp+4608);
  kf[6]=*(const __attribute__((address_space(3))) bf16x8*)(kp+6144); kf[7]=*(const __attribute__((address_space(3))) bf16x8*)(kp+6656);
}
__device__ __forceinline__ void kload2(bf16x8*kf,lds_cptr kp,int j){ kf[2*j]=*(const __attribute__((address_space(3))) bf16x8*)(kp+j*2048); kf[2*j+1]=*(const __attribute__((address_space(3))) bf16x8*)(kp+j*2048+512); }
__device__ __forceinline__ s16x4 vtr(lds_cptr p){ return __builtin_bit_cast(s16x4,__builtin_amdgcn_ds_read_tr16_b64_v4i16((__attribute__((address_space(3))) v4i16_t*)p)); }
__device__ __forceinline__ float rowmax(const f32x16&p0,const f32x16&p1){
  float a=max3f(p0[0],p0[1],p1[0]),b=max3f(p0[2],p0[3],p1[1]);a=max3f(a,p1[2],p1[3]);
  #pragma unroll
  for(int r=4;r<16;r+=4){a=max3f(a,p0[r],p0[r+1]);b=max3f(b,p0[r+2],p0[r+3]);a=max3f(a,p1[r],p1[r+1]);b=max3f(b,p1[r+2],p1[r+3]);}
  const float m=max2f(a,b);
  auto rr=__builtin_amdgcn_permlane32_swap(__float_as_uint(m),__float_as_uint(m),false,false);
  return max2f(__uint_as_float(rr[0]),__uint_as_float(rr[1]));
}
__device__ __forceinline__ void pv(f32x16*o,int vb,bf16x8 pa0,bf16x8 pa1,bf16x8 pa2,bf16x8 pa3){
  #pragma unroll
  for(int d0=0;d0<2;++d0){s16x4 lo[4],hi[4];
    #pragma unroll
    for(int ks=0;ks<4;++ks){
      asm volatile("ds_read_b64_tr_b16 %0,%1 offset:%c2":"=&v"(lo[ks]):"v"(vb),"i"(d0*4096+ks*1024):"memory");
      asm volatile("ds_read_b64_tr_b16 %0,%1 offset:%c2":"=&v"(hi[ks]):"v"(vb),"i"(d0*4096+ks*1024+512):"memory");}
    asm volatile("s_waitcnt lgkmcnt(0)":::"memory");SBAR();
    #define PK(k) (bf16x8){lo[k][0],lo[k][1],lo[k][2],lo[k][3],hi[k][0],hi[k][1],hi[k][2],hi[k][3]}
    o[d0]=__builtin_amdgcn_mfma_f32_32x32x16_bf16(pa0,PK(0),o[d0],0,0,0);
    o[d0]=__builtin_amdgcn_mfma_f32_32x32x16_bf16(pa1,PK(1),o[d0],0,0,0);
    o[d0]=__builtin_amdgcn_mfma_f32_32x32x16_bf16(pa2,PK(2),o[d0],0,0,0);
    o[d0]=__builtin_amdgcn_mfma_f32_32x32x16_bf16(pa3,PK(3),o[d0],0,0,0);
    #undef PK
  }
}

#ifndef ATTN_STORE16
#define ATTN_STORE16(p,v) (*(u32x4*)(p)=(v))
#endif
template<int THRL> __device__ __forceinline__ void attn_unit(const int wv,const bf16*Qw0,const bf16*__restrict__ Kh,const bf16*__restrict__ Vh,bf16*Ow0,const int NT,char*shm){
  const int tid=opaque_tid(wv); const int lane=tid&63,r32=lane&31,hi=lane>>5; const int wid=__builtin_amdgcn_readfirstlane(tid>>6);
  const bf16*Qw=Qw0+(long)(wid*QBLK)*DMQ;
  const unsigned lds0=(unsigned)(uintptr_t)shm;
  float*wsf=(float*)(shm+LDS_WS)+wid*64;
  const bf16*ksrc=Kh+(long)lane*DMK+wid*8;
  const bf16*vsrc=Vh+(long)(16*(wid&3)+(lane>>2))*DMK+(wid>>2)*32+(lane&3)*8;
  const unsigned kdst=lds0+LDS_K+wid*1024, vdst=lds0+LDS_V+wid*1024;
  #define DMA_K(t,slot) glds16(ksrc+(long)(t)*KVBLK*DMK,(unsigned)__builtin_amdgcn_readfirstlane(kdst+(slot)))
  #define DMA_V(t,slot) glds16(vsrc+(long)(t)*KVBLK*DMK,(unsigned)__builtin_amdgcn_readfirstlane(vdst+(slot)))
  const int vb0=(int)(lds0+LDS_V)+((lane>>4)&1)*32+(lane&3)*8+(4*hi+((lane&15)>>2))*64;
  const char*Kbase=shm+LDS_K; bf16x8 kf[8];
  const lds_cptr shm3=(lds_cptr)shm; const lds_cptr kp0=shm3+LDS_K+hi*1024+r32*16; const lds_cptr vp0=shm3+LDS_V+((lane>>4)&1)*32+(lane&3)*8+(4*hi+((lane&15)>>2))*64;
  DMA_K(0,0);DMA_V(0,0);DMA_K(1,SLOTB);
  bf16x8 qr[4];
  #pragma unroll
  for(int d0=0;d0<4;++d0)qr[d0]=*reinterpret_cast<const bf16x8*>(&Qw[(long)r32*DMQ+d0*16+hi*8]);
  float mhat=0.f,l_reg=0.f;f32x16 o[2];o[0]=f32x16{};o[1]=f32x16{};f32x16 negm=f32x16{};asm volatile("":"+v"(negm));
  #define CMASK(P0,P1,t) do{}while(0)
  bool resc=false;
  #define START(P0,P1) do{ const float rm=rowmax(P0,P1); resc=false; \
    { const float dl=rm; mhat=fadd_s(mhat,dl); \
      _Pragma("unroll") for(int r=0;r<16;++r){P0[r]=fsub_s(P0[r],dl);P1[r]=fsub_s(P1[r],dl);} \
      _Pragma("unroll") for(int r=0;r<16;++r)negm[r]=-mhat; asm volatile("":"+v"(negm)); } \
    _Pragma("unroll") for(int r=0;r<16;++r)P0[r]=__builtin_amdgcn_exp2f(P0[r]); }while(0)
  #define RESC() do{ if(resc){ asm volatile("s_waitcnt lgkmcnt(0)":::"memory"); \
      _Pragma("unroll") for(int d_=0;d_<2;++d_) _Pragma("unroll") for(int r=0;r<16;++r)o[d_][r]*=wsf[crow(r,hi)]; } }while(0)
  f32x16 pA0,pA1,pB0,pB1;
  int sl_prev=0,sl_cur=0,sl_next=SLOTB;
  #define ROT() do{sl_prev=sl_cur;sl_cur=sl_next;sl_next=(sl_next==(NSLOT-1)*SLOTB)?0:sl_next+SLOTB;}while(0)
  DMA_K(2,2*SLOTB);
  WAIT_BAR(3);
  qkt(pA0,pA1,Kbase,qr,negm,r32,hi);asm volatile("s_nop 15\n\ts_nop 7":"+v"(pA0),"+v"(pA1));CMASK(pA0,pA1,0);
  START(pA0,pA1);
  _Pragma("unroll") for(int r=0;r<16;++r)pA1[r]=__builtin_amdgcn_exp2f(pA1[r]);
  WAIT_BAR(0);
  DMA_K(3,0);DMA_V(1,SLOTB);
  ROT();
  kload8(kf,kp0+sl_cur);
  WAIT_BAR(2);
  s16x4 vlo[8],vhi[8]; u32x4 pw0,pw1,pw2,pw3;
  #define PKW(P,B) cvtpk_s(P[B],P[B+1])
  #define PAF(k) __builtin_bit_cast(bf16x8,pw##k)
  #define VFR(i) (bf16x8){vlo[i][0],vlo[i][1],vlo[i][2],vlo[i][3],vhi[i][0],vhi[i][1],vhi[i][2],vhi[i][3]}
  #define PIN(x) asm volatile("":"+v"(x))
  #define MX3(a,b,c) __builtin_fmaxf(__builtin_fmaxf((a),(b)),(c))
  #define GAPA(MF,A0,A1,A2,A3,W0,W1,PW) do{ MF; sacc+=A0; sacc+=A1; sacc+=A2; sacc+=A3; PIN(sacc); W0; W1; PIN(PW); SBAR(); }while(0)
  #define EX(v) __builtin_amdgcn_exp2f(v)
  #define GAPB(MF,X,B) do{ MF; X[B]=EX(X[B]); X[B+1]=EX(X[B+1]); X[B+2]=EX(X[B+2]); X[B+3]=EX(X[B+3]); PIN(X); SBAR(); }while(0)
  #define VRD(i) do{ vlo[i]=vtr(vp_+(((i)>>2)*4096+((i)&3)*1024)); vhi[i]=vtr(vp_+(((i)>>2)*4096+((i)&3)*1024+512)); }while(0)
  #define KRD(G,j) do{ if(G){ kload2(kf,kp0+sl_next,j); SBAR(); } }while(0)
  #define STEP(C0,C1,P0,P1,t,GK,GV,GL) do{ SBAR(); \
    const lds_cptr vp_=vp0+sl_prev; \
    VRD(0); SBAR(); float sacc=(P0[0]+P0[1]); \
    GAPA(C0=__builtin_amdgcn_mfma_f32_32x32x16_bf16(kf[0],qr[0],negm,0,0,0), P0[2],P0[3],P0[4],P0[5],     pw0[0]=PKW(P0,0), pw0[1]=PKW(P0,2), pw0); \
    VRD(4); SBAR(); GAPA(C1=__builtin_amdgcn_mfma_f32_32x32x16_bf16(kf[1],qr[0],negm,0,0,0), P0[6],P0[7],P0[8],P0[9],     pw0[2]=PKW(P0,4), pw0[3]=PKW(P0,6), pw0); \
    VRD(1); SBAR(); GAPA(C0=__builtin_amdgcn_mfma_f32_32x32x16_bf16(kf[2],qr[1],C0,0,0,0),   P0[10],P0[11],P0[12],P0[13], pw1[0]=PKW(P0,8), pw1[1]=PKW(P0,10), pw1); \
    VRD(5); SBAR(); GAPA(C1=__builtin_amdgcn_mfma_f32_32x32x16_bf16(kf[3],qr[1],C1,0,0,0),   P0[14],P0[15],P1[0],P1[1],   pw1[2]=PKW(P0,12),pw1[3]=PKW(P0,14), pw1); \
    VRD(2); SBAR(); GAPA(C0=__builtin_amdgcn_mfma_f32_32x32x16_bf16(kf[4],qr[2],C0,0,0,0),   P1[2],P1[3],P1[4],P1[5],     pw2[0]=PKW(P1,0), pw2[1]=PKW(P1,2), pw2); \
    VRD(6); SBAR(); GAPA(C1=__builtin_amdgcn_mfma_f32_32x32x16_bf16(kf[5],qr[2],C1,0,0,0),   P1[6],P1[7],P1[8],P1[9],     pw2[2]=PKW(P1,4), pw2[3]=PKW(P1,6), pw2); \
    VRD(3); SBAR(); GAPA(C0=__builtin_amdgcn_mfma_f32_32x32x16_bf16(kf[6],qr[3],C0,0,0,0),   P1[10],P1[11],P1[12],P1[13], pw3[0]=PKW(P1,8), pw3[1]=PKW(P1,10), pw3); \
    VRD(7); SBAR(); GAPA(C1=__builtin_amdgcn_mfma_f32_32x32x16_bf16(kf[7],qr[3],C1,0,0,0),   P1[14],P1[15],0.f,0.f,       pw3[2]=PKW(P1,12),pw3[3]=PKW(P1,14), pw3); \
    l_reg+=sacc; \
    if(GK){DMA_K((t)+3,sl_cur);} if(GV){DMA_V((t)+1,sl_next);} \
    CMASK(C0,C1,t); \
    { float a=MX3(C0[0],C0[1],C1[0]),b=MX3(C0[2],C0[3],C1[1]); a=MX3(a,C1[2],C1[3]); \
      _Pragma("unroll") for(int r=4;r<16;r+=4){a=MX3(a,C0[r],C0[r+1]);b=MX3(b,C0[r+2],C0[r+3]);a=MX3(a,C1[r],C1[r+1]);b=MX3(b,C1[r+2],C1[r+3]);} \
      float rm=__builtin_fmaxf(a,b); { auto rr=__builtin_amdgcn_permlane32_swap(__float_as_uint(rm),__float_as_uint(rm),false,false); rm=__builtin_fmaxf(__uint_as_float(rr[0]),__uint_as_float(rr[1])); } \
      resc=false; \
      if(__builtin_expect(__any(rm>(float)THRL),0)){ const float dl=__builtin_fmaxf(rm,0.f); mhat+=dl; \
        _Pragma("unroll") for(int r=0;r<16;++r){C0[r]-=dl;C1[r]-=dl;} \
        _Pragma("unroll") for(int r=0;r<16;++r)negm[r]=-mhat; asm volatile("":"+v"(negm)); \
        const float f=__builtin_amdgcn_exp2f(-dl); l_reg*=f; if(hi==0)wsf[r32]=f; resc=true; } } \
    SBAR(); \
    GAPB(o[0]=__builtin_amdgcn_mfma_f32_32x32x16_bf16(PAF(0),VFR(0),o[0],0,0,0), C0,0); \
    GAPB(o[1]=__builtin_amdgcn_mfma_f32_32x32x16_bf16(PAF(0),VFR(4),o[1],0,0,0), C0,4); \
    KRD(GL,0); GAPB(o[0]=__builtin_amdgcn_mfma_f32_32x32x16_bf16(PAF(1),VFR(1),o[0],0,0,0), C0,8); \
    KRD(GL,1); GAPB(o[1]=__builtin_amdgcn_mfma_f32_32x32x16_bf16(PAF(1),VFR(5),o[1],0,0,0), C0,12); \
    KRD(GL,2); GAPB(o[0]=__builtin_amdgcn_mfma_f32_32x32x16_bf16(PAF(2),VFR(2),o[0],0,0,0), C1,0); \
    KRD(GL,3); GAPB(o[1]=__builtin_amdgcn_mfma_f32_32x32x16_bf16(PAF(2),VFR(6),o[1],0,0,0), C1,4); \
    GAPB(o[0]=__builtin_amdgcn_mfma_f32_32x32x16_bf16(PAF(3),VFR(3),o[0],0,0,0), C1,8); \
    GAPB(o[1]=__builtin_amdgcn_mfma_f32_32x32x16_bf16(PAF(3),VFR(7),o[1],0,0,0), C1,12); \
    }while(0)
  int t=1;
  #undef CMASK
  #define CMASK(P0,P1,t) do{}while(0)
  for(;t+5<NT;t+=2){
    STEP(pB0,pB1,pA0,pA1,t,true,true,true);     WAIT_BAR(2); RESC(); ROT();
    STEP(pA0,pA1,pB0,pB1,t+1,true,true,true);   WAIT_BAR(2); RESC(); ROT();
  }
  #undef CMASK
  #define CMASK(P0,P1,t) do{}while(0)
  #define ENDW(tt) do{ if((tt)+3<NT){WAIT_BAR(2);} else if((tt)+2<NT){WAIT_BAR(1);} else {WAIT_BAR(0);} }while(0)
  for(;t+1<NT;t+=2){
    STEP(pB0,pB1,pA0,pA1,t,(t+3<NT),(t+1<NT),(t+1<NT));       ENDW(t);   RESC(); ROT();
    STEP(pA0,pA1,pB0,pB1,t+1,(t+4<NT),(t+2<NT),(t+2<NT));     ENDW(t+1); RESC(); ROT();
  }
  STEP(pB0,pB1,pA0,pA1,NT-1,false,false,false); RESC();
  { float sacc=pB0[0]+pB0[1]; _Pragma("unroll") for(int r=2;r<16;++r)sacc+=pB0[r]; _Pragma("unroll") for(int r=0;r<16;++r)sacc+=pB1[r]; l_reg+=sacc;
    pw0=(u32x4){PKW(pB0,0),PKW(pB0,2),PKW(pB0,4),PKW(pB0,6)};pw1=(u32x4){PKW(pB0,8),PKW(pB0,10),PKW(pB0,12),PKW(pB0,14)};pw2=(u32x4){PKW(pB1,0),PKW(pB1,2),PKW(pB1,4),PKW(pB1,6)};pw3=(u32x4){PKW(pB1,8),PKW(pB1,10),PKW(pB1,12),PKW(pB1,14)};
    SBAR(); pv(o,vb0+sl_cur,PAF(0),PAF(1),PAF(2),PAF(3)); }
  #undef PKW
  #undef PAF
  #undef VFR
  #undef PIN
  #undef MX3
  #undef GAPA
  #undef GAPB
  #undef EX
  #undef VRD
  #undef KRD
  #undef STEP
  #undef ENDW
  {auto rr=__builtin_amdgcn_permlane32_swap(__float_as_uint(l_reg),__float_as_uint(l_reg),false,false);l_reg=__uint_as_float(rr[0])+__uint_as_float(rr[1]);}
  if(hi==0)wsf[32+r32]=l_reg;asm volatile("s_waitcnt lgkmcnt(0)":::"memory");
  float rli[16];
  #pragma unroll
  for(int r=0;r<16;++r)rli[r]=__builtin_amdgcn_rcpf(wsf[32+crow(r,hi)]);
  bf16*Ow=Ow0+(long)(wid*QBLK)*DMQ;
  { bf16*stg=(bf16*)(shm+LDS_OST)+wid*2048;
    #pragma unroll
    for(int r=0;r<16;++r){const int orow=crow(r,hi);
      #pragma unroll
      for(int d0=0;d0<2;++d0)stg[orow*64+d0*32+r32]=__float2bfloat16(o[d0][r]*rli[r]);}
    asm volatile("s_waitcnt lgkmcnt(0)":::"memory");
    #pragma unroll
    for(int i=0;i<4;++i){const int row=i*8+(lane>>3),ch=lane&7; const u32x4 v=*(const u32x4*)(stg+row*64+ch*8); ATTN_STORE16(Ow+(long)row*DMQ+ch*8,v);} }
  asm volatile("s_waitcnt lgkmcnt(0)\n\ts_barrier":::"memory");
  #undef DMA_K
  #undef DMA_V
  #undef CMASK
  #undef START
  #undef RESC
  #undef ROT
}
constexpr int ATTN_LDS_BYTES=LDS_BYTES;
#undef SBAR
#undef WAIT_BAR
}

struct Frame {
    LAS unsigned char* lds;
    volatile LAS unsigned* MISC;
    gu32* ctl;
    int vcu, G, wv;
    const float* const* in;
    unsigned char* ws;
    float* out;
};
#define WSP(T, off) ((T*)(F.ws + (off)))
#define INP(i) (F.in[i])
enum { I_X = 0, I_C, I_CTX, I_CCTX, I_MODW, I_MODB, I_POOLW, I_POOLS, I_LIN, I_CONVW, I_CONVB, I_WA, I_BA, I_WX, I_BX, I_LAM, I_LOUT, I_QKV, I_QG, I_KG, I_WO,
       I_GIN, I_LNG, I_LNB, I_WS, I_BS, I_GOUT, I_ROUTER, I_WG, I_WU, I_WDN, I_FG, N_IN };

__device__ __forceinline__ void tr_item(const float* W, int ldw, bf16* WT, int ldt, int k0, int n0, int drow  , int lane) {
    const float* src = W + (size_t)k0 * ldw + n0 + lane;
    float v[64];
#pragma unroll
    for (int k = 0; k < 64; ++k) v[k] = __builtin_nontemporal_load(src + (size_t)k * ldw);
    bf16* dst = WT + (size_t)drow * ldt + k0;
#pragma unroll
    for (int c = 0; c < 8; ++c) { v4u o; o.x = pk2(v[8 * c], v[8 * c + 1]); o.y = pk2(v[8 * c + 2], v[8 * c + 3]); o.z = pk2(v[8 * c + 4], v[8 * c + 5]); o.w = pk2(v[8 * c + 6], v[8 * c + 7]);
        *(v4u*)(dst + 8 * c) = o; }
}
template <int MODE>
__device__ __forceinline__ void tr_job(Frame& F, const float* W, int K, int N, int nb, bf16* WT) {
    const int tid_ = opaque_tid(F.wv), lane_ = tid_ & 63, wave_ = __builtin_amdgcn_readfirstlane(tid_ >> 6);
    const int gw = F.vcu * NWAVES + wave_, NGW = F.G * NWAVES;
    const int nblk = N / 64, per = (K / 64) * nblk, total = per * nb;
    for (int it = gw; it < total; it += NGW) {
        const int bb = it / per, r = it - bb * per, kb = r / nblk, nbk = r - kb * nblk, k0 = 64 * kb, n0 = 64 * nbk;
        const float* Wb = W + (size_t)bb * K * N;
        bf16* dst; int drow0;
        if (MODE == 0) { dst = WT + (size_t)bb * N * K; drow0 = n0; }
        else if (MODE == 1 || MODE == 2) { dst = WT + (size_t)bb * 2048 * K; drow0 = 256 * (n0 >> 7) + (n0 & 127) + (MODE == 2 ? 128 : 0); }
        else { const int d = bb >> 3, h = bb & 7; dst = WT + (size_t)((h * 2 + (n0 >> 6)) * 256) * K;
            drow0 = 128 * d + 32 * (lane_ >> 4) + (MODE == 4 ? 16 : 0) + (lane_ & 15) - lane_; }
        tr_item(Wb, N, dst, K, k0, n0, drow0 + lane_, lane_);
    }
}
__device__ __forceinline__ void tr_item8(const float* W, int ldw, unsigned char* WT, int ldt, int k0, int n0, int drow0, int lane) {
    const float* src = W + (size_t)k0 * ldw + n0 + lane;
    float v[32];
#pragma unroll
    for (int k = 0; k < 32; ++k) v[k] = __builtin_nontemporal_load(src + (size_t)k * ldw) * W8_SCALE;
    unsigned char* dst = WT + (size_t)(drow0 + lane) * ldt + k0;
#pragma unroll
    for (int c = 0; c < 2; ++c) { v4u o; o.x = pk4_fp8(v[16 * c], v[16 * c + 1], v[16 * c + 2], v[16 * c + 3]); o.y = pk4_fp8(v[16 * c + 4], v[16 * c + 5], v[16 * c + 6], v[16 * c + 7]);
        o.z = pk4_fp8(v[16 * c + 8], v[16 * c + 9], v[16 * c + 10], v[16 * c + 11]); o.w = pk4_fp8(v[16 * c + 12], v[16 * c + 13], v[16 * c + 14], v[16 * c + 15]);
        *(v4u*)(dst + 16 * c) = o; }
}
template <int MODE>
__device__ __forceinline__ void tr_job8(Frame& F, const float* W, int K, int N, int nb, unsigned char* WT) {
    const int tid_ = opaque_tid(F.wv), lane_ = tid_ & 63, wave_ = __builtin_amdgcn_readfirstlane(tid_ >> 6);
    const int gw = F.vcu * NWAVES + wave_, NGW = F.G * NWAVES;
    const int nblk = N / 64, per = (K / 32) * nblk, total = per * nb;
    for (int it = gw; it < total; it += NGW) {
        const int bb = it / per, r = it - bb * per, kb = r / nblk, nbk = r - kb * nblk, k0 = 32 * kb, n0 = 64 * nbk;
        const float* Wb = W + (size_t)bb * K * N;
        unsigned char* dst; int drow0;
        if (MODE == 0) { dst = WT + (size_t)bb * N * K; drow0 = n0; }
        else { dst = WT + (size_t)bb * 2048 * K; drow0 = 256 * (n0 >> 7) + (n0 & 127) + (MODE == 2 ? 128 : 0); }
        tr_item8(Wb, N, dst, K, k0, n0, drow0, lane_);
    }
}
__device__ __forceinline__ void convert_moe(Frame& F, int L) {
    const size_t so = (size_t)(L & 1) * WSET;
    tr_job8<1>(F, INP(I_WG) + (size_t)L * 16 * 1024 * 1024, 1024, 1024, 16, WSP(unsigned char, WS_WGU + so));
    tr_job8<2>(F, INP(I_WU) + (size_t)L * 16 * 1024 * 1024, 1024, 1024, 16, WSP(unsigned char, WS_WGU + so));
    tr_job8<0>(F, INP(I_WDN) + (size_t)L * 16 * 1024 * 1024, 1024, 1024, 16, WSP(unsigned char, WS_WD + so));
}
struct ConvSide {
    const float *wg, *wu, *wd;
    unsigned char *gu8, *d8;
    __device__ __forceinline__ bool issue(int item, int lane, float (&v)[32]) const {
        if (wg == nullptr || item >= 3 * 8192) return false;
        const int m = item >> 13, r = item & 8191, bb = r >> 9, kb = (r >> 4) & 31, nbk = r & 15;
        const float* src = (m == 0 ? wg : (m == 1 ? wu : wd)) + (size_t)bb * 1024 * 1024 + (size_t)(32 * kb) * 1024 + 64 * nbk + lane;
#pragma unroll
        for (int k = 0; k < 32; ++k) v[k] = __builtin_nontemporal_load(src + (size_t)k * 1024);
        return true;
    }
    __device__ __forceinline__ void finish(int item, int lane, const float (&v)[32]) const {
        const int m = item >> 13, r = item & 8191, bb = r >> 9, kb = (r >> 4) & 31, nbk = r & 15, n0 = 64 * nbk;
        unsigned char* dst = (m < 2) ? gu8 + ((size_t)bb * 2048 + 256 * (n0 >> 7) + (n0 & 127) + (m == 1 ? 128 : 0) + lane) * 1024 + 32 * kb
                                     : d8 + ((size_t)bb * 1024 + n0 + lane) * 1024 + 32 * kb;
#pragma unroll
        for (int c = 0; c < 2; ++c) { v4u o; o.x = pk4_fp8(v[16 * c] * W8_SCALE, v[16 * c + 1] * W8_SCALE, v[16 * c + 2] * W8_SCALE, v[16 * c + 3] * W8_SCALE);
            o.y = pk4_fp8(v[16 * c + 4] * W8_SCALE, v[16 * c + 5] * W8_SCALE, v[16 * c + 6] * W8_SCALE, v[16 * c + 7] * W8_SCALE);
            o.z = pk4_fp8(v[16 * c + 8] * W8_SCALE, v[16 * c + 9] * W8_SCALE, v[16 * c + 10] * W8_SCALE, v[16 * c + 11] * W8_SCALE);
            o.w = pk4_fp8(v[16 * c + 12] * W8_SCALE, v[16 * c + 13] * W8_SCALE, v[16 * c + 14] * W8_SCALE, v[16 * c + 15] * W8_SCALE);
            *(v4u*)(dst + 16 * c) = o; }
    }
};

__device__ __forceinline__ void phase_prologue(Frame& F) {
    const int tid_ = opaque_tid(F.wv), lane_ = tid_ & 63, wave_ = __builtin_amdgcn_readfirstlane(tid_ >> 6); (void)lane_; (void)wave_;
    tr_job<0>(F, INP(I_POOLW), 256, 256, 4, WSP(bf16, WS_PW));
    tr_job<0>(F, INP(I_LIN), 1024, 2048, 1, WSP(bf16, WS_LIN));
    tr_job<3>(F, INP(I_WA), 128, 128, 16, WSP(bf16, WS_LG));
    tr_job<4>(F, INP(I_WX), 128, 128, 16, WSP(bf16, WS_LG));
    tr_job<0>(F, INP(I_LOUT), 1024, 1024, 1, WSP(bf16, WS_LOUT));
    tr_job<0>(F, INP(I_QKV), 1024, 1536, 1, WSP(bf16, WS_QKV));
    tr_job<0>(F, INP(I_WO), 1024, 1024, 1, WSP(bf16, WS_WO));
    tr_job8<0>(F, INP(I_GIN), 1024, 6144, 1, WSP(unsigned char, WS_GIN));
    tr_job8<0>(F, INP(I_GOUT), 3072, 1024, 1, WSP(unsigned char, WS_GOUT));
    convert_moe(F, 0);
    {
        const float* s = INP(I_WS); bf16* d = WSP(bf16, WS_GS);
        for (int i = (int)blockIdx.x * 512 + tid_; i < 4 * 128 * 128 / 2; i += F.G * 512) ((unsigned*)d)[i] = pk2(s[2 * i], s[2 * i + 1]);
    }
    if (blockIdx.x == 0) {
        float* rt = WSP(float, WS_ROPE);
        for (int i = tid_; i < 1024; i += 512) { const int pos = i >> 4, f = i & 15; const float inv = powf(10000.0f, -(float)f / 16.0f); const float ang = (float)pos * inv;
            rt[2 * i] = cosf(ang); rt[2 * i + 1] = sinf(ang); }
        float* spt = WSP(float, WS_SPT);
        for (int i = tid_; i < 2048; i += 512) spt[i] = -8.0f * 1.4426950409f * log1pf(expf(-INP(I_LAM)[i]));
    }
    __syncthreads();
    LAS float* S = (LAS float*)F.lds;
    LAS float* RED = (LAS float*)(F.lds + 40960);
    { float cv[18];
#pragma unroll
      for (int q = 0; q < 18; ++q) { const int i = tid_ + 512 * q, r = i >> 10, k = i & 1023; cv[q] = (r < 8) ? INP(I_C)[r * 1024 + k] : INP(I_CCTX)[k]; }
#pragma unroll
      for (int q = 0; q < 18; ++q) S[tid_ + 512 * q] = cv[q] * sigmoid_f(cv[q]); }
    __syncthreads();
    for (int u = (int)blockIdx.x; u < 4 * 96; u += F.G) {
        const int l = u / 96, n0 = (u % 96) * 64;
        const float* Wl = INP(I_MODW) + (size_t)l * 1024 * 6144 + n0 + lane_;
        float a[9];
#pragma unroll
        for (int r = 0; r < 9; ++r) a[r] = 0.f;
        const int kb = wave_ * 128;
#pragma unroll 1
        for (int k0 = 0; k0 < 128; k0 += 16) {
            float w[16];
#pragma unroll
            for (int q = 0; q < 16; ++q) w[q] = __builtin_nontemporal_load(Wl + (size_t)(kb + k0 + q) * 6144);
#pragma unroll
            for (int k = 0; k < 16; k += 4) {
#pragma unroll
                for (int r = 0; r < 9; ++r) { const f32x4 s = *(const LAS f32x4*)(S + r * 1024 + kb + k0 + k); a[r] += s.x * w[k] + s.y * w[k + 1] + s.z * w[k + 2] + s.w * w[k + 3]; }
                __builtin_amdgcn_sched_barrier(0); }
        }
#pragma unroll
        for (int r = 0; r < 9; ++r) RED[(wave_ * 9 + r) * 64 + lane_] = a[r];
        __syncthreads();
        for (int i = tid_; i < 9 * 64; i += 512) { const int r = i >> 6, c = i & 63; float s = 0.f;
#pragma unroll
            for (int w8 = 0; w8 < 8; ++w8) s += RED[(w8 * 9 + r) * 64 + c];
            WSP(float, WS_MOD)[((size_t)l * 9 + r) * 6144 + n0 + c] = s + INP(I_MODB)[l * 6144 + n0 + c]; }
        __syncthreads();
    }
}

template <int L>
__device__ __forceinline__ void phase_n1(Frame& F, const bool dry = false) {
    const int tid_ = opaque_tid(F.wv), lane_ = tid_ & 63, wave_ = __builtin_amdgcn_readfirstlane(tid_ >> 6);
    const int gw = F.vcu * NWAVES + wave_, NGW = F.G * NWAVES;
    constexpr int nrows = (L >= 3) ? RL : RT;
    const int rpw = (nrows + NGW - 1) / NGW, r0 = gw * rpw, r1 = (r0 + rpw < nrows) ? r0 + rpw : nrows;
    bf16* XS = WSP(bf16, WS_XS); bf16* H = WSP(bf16, WS_H); const int* INV = WSP(int, WS_INV); const unsigned char* Y = WSP(unsigned char, SC_Y);
    const float* MOD = WSP(float, WS_MOD);
#define N1_SRC(r) ((r) < RL ? INP(I_X) + (size_t)(r) * D : INP(I_CTX) + (size_t)((r) - RL) * D)
#define N1_LOADX(r) do { if (L == 0) { const f32x4* xr_ = (const f32x4*)N1_SRC(r) + lane_; _Pragma("unroll") for (int j = 0; j < 4; ++j) vn[j] = xr_[64 * j]; } \
        else { const v2u* xr_ = (const v2u*)(XS + (size_t)(r) * D) + lane_; _Pragma("unroll") for (int j = 0; j < 4; ++j) vnb[j] = xr_[64 * j]; } } while (0)
    f32x4 vn[4]; v2u vnb[4]; unsigned ywn[4][4]; int yrn[4]; unsigned mrest_n = 0; int inv_n = -1, inv_nn = -1;
#define N1_ISSUE_Y(invv) do { unsigned m_ = (unsigned)(__ballot((invv) >= 0) & 0xffffull); \
        _Pragma("unroll") for (int k = 0; k < 4; ++k) { yrn[k] = -1; if (m_) { const int e_ = __builtin_ctz(m_); m_ &= m_ - 1; yrn[k] = __builtin_amdgcn_readlane((invv), e_); } } \
        mrest_n = m_; \
        _Pragma("unroll") for (int k = 0; k < 4; ++k) if (yrn[k] >= 0) { const unsigned* yp_ = (const unsigned*)(Y + (size_t)yrn[k] * D) + lane_; _Pragma("unroll") for (int j = 0; j < 4; ++j) ywn[k][j] = yp_[64 * j]; } } while (0)
#pragma unroll
    for (int k = 0; k < 4; ++k) yrn[k] = -1;
    if (r0 < r1) { N1_LOADX(r0);
        if (L > 0) { inv_n = (lane_ < 16) ? INV[r0 * 16 + lane_] : -1; if (r0 + 1 < r1) inv_nn = (lane_ < 16) ? INV[(r0 + 1) * 16 + lane_] : -1; N1_ISSUE_Y(inv_n); } }
    int cb = -1; f32x4 shv[4], scv[4], g2v[4];
#pragma unroll
    for (int j = 0; j < 4; ++j) { shv[j] = (f32x4){0.f, 0.f, 0.f, 0.f}; scv[j] = shv[j]; g2v[j] = shv[j]; }
    for (int row = r0; row < r1; ++row) {
        const int b = row < RL ? (row >> 12) : 8;
        if (b != cb) { cb = b;
            if (L < 4) { const float* sh = MOD + ((size_t)L * 9 + b) * 6144;
#pragma unroll
                for (int j = 0; j < 4; ++j) { shv[j] = *((const f32x4*)sh + 64 * j + lane_); scv[j] = *((const f32x4*)(sh + 1024) + 64 * j + lane_) + 1.0f; } }
            else {
#pragma unroll
                for (int j = 0; j < 4; ++j) scv[j] = *((const f32x4*)INP(I_FG) + 64 * j + lane_); }
            if (L > 0) { const float* g2 = MOD + ((size_t)(L - 1) * 9 + b) * 6144 + 5120;
#pragma unroll
                for (int j = 0; j < 4; ++j) g2v[j] = *((const f32x4*)g2 + 64 * j + lane_) * Y8_INV; } }
        f32x4 v[4]; unsigned yw[4][4]; int yr[4];
#pragma unroll
        for (int j = 0; j < 4; ++j) v[j] = (L == 0) ? vn[j] : bf4(vnb[j]);
#pragma unroll
        for (int k = 0; k < 4; ++k) { yr[k] = yrn[k];
#pragma unroll
            for (int j = 0; j < 4; ++j) yw[k][j] = ywn[k][j]; }
        unsigned mrest = mrest_n; const int inv = inv_n;
        { const int rn = row + 1; if (rn < r1) { N1_LOADX(rn);
            if (L > 0) { inv_n = inv_nn; if (rn + 1 < r1) inv_nn = (lane_ < 16) ? INV[(rn + 1) * 16 + lane_] : -1; N1_ISSUE_Y(inv_n); } } }
        if (L > 0) {
            f32x4 a[4];
#pragma unroll
            for (int j = 0; j < 4; ++j) a[j] = (f32x4){0.f, 0.f, 0.f, 0.f};
#pragma unroll
            for (int k = 0; k < 4; ++k) if (yr[k] >= 0) {
#pragma unroll
                for (int j = 0; j < 4; ++j) { const f32x2 lo = __builtin_amdgcn_cvt_pk_f32_fp8((int)yw[k][j], false), hi = __builtin_amdgcn_cvt_pk_f32_fp8((int)yw[k][j], true); a[j].x += lo.x; a[j].y += lo.y; a[j].z += hi.x; a[j].w += hi.y; } }
            while (mrest) {
                const int e = __builtin_ctz(mrest); mrest &= mrest - 1; const int yq = __builtin_amdgcn_readlane(inv, e);
                const unsigned* yp = (const unsigned*)(Y + (size_t)yq * D) + lane_;
#pragma unroll
                for (int j = 0; j < 4; ++j) { const int w = (int)yp[64 * j]; const f32x2 lo = __builtin_amdgcn_cvt_pk_f32_fp8(w, false), hi = __builtin_amdgcn_cvt_pk_f32_fp8(w, true); a[j].x += lo.x; a[j].y += lo.y; a[j].z += hi.x; a[j].w += hi.y; } }
#pragma unroll
            for (int j = 0; j < 4; ++j) v[j] = v[j] + g2v[j] * a[j];
            if (L < 4 && !dry) { v2u* xo = (v2u*)(XS + (size_t)row * D) + lane_;
#pragma unroll
                for (int j = 0; j < 4; ++j) { v2u w; w.x = pk2(v[j].x, v[j].y); w.y = pk2(v[j].z, v[j].w); xo[64 * j] = w; } }
        }
        float ss = 0.f;
#pragma unroll
        for (int j = 0; j < 4; ++j) ss += (v[j].x * v[j].x + v[j].y * v[j].y) + (v[j].z * v[j].z + v[j].w * v[j].w);
        const float rstd = 1.0f / sqrtf(wave_sum(ss) * (1.0f / D) + EPS);
        if (L == 3) {
            unsigned* ho = (unsigned*)((unsigned char*)H + (size_t)row * D) + lane_;
#pragma unroll
            for (int j = 0; j < 4; ++j) { const f32x4 h = v[j] * rstd * scv[j] + shv[j]; ho[64 * j] = pk4_fp8_sat(h.x, h.y, h.z, h.w); }
        } else if (L < 4) {
            v2u* ho = (v2u*)(H + (size_t)row * D) + lane_;
#pragma unroll
            for (int j = 0; j < 4; ++j) { const f32x4 h = v[j] * rstd * scv[j] + shv[j]; v2u w; w.x = pk2(h.x, h.y); w.y = pk2(h.z, h.w); ho[64 * j] = w; }
        } else {
            f32x4* oo = (f32x4*)(F.out + (size_t)row * D) + lane_;
#pragma unroll
            for (int j = 0; j < 4; ++j) oo[64 * j] = v[j] * rstd * scv[j];
        }
    }
#undef N1_SRC
#undef N1_LOADX
#undef N1_ISSUE_Y
}

template <int L>
__device__ __forceinline__ void phase_n2(Frame& F) {
    const int tid_ = opaque_tid(F.wv), lane_ = tid_ & 63, wave_ = __builtin_amdgcn_readfirstlane(tid_ >> 6);
    const int gw = F.vcu * NWAVES + wave_, NGW = F.G * NWAVES;
    constexpr int nrows = (L >= 2) ? RL : RT;
    const int rpw = (((nrows + NGW - 1) / NGW) + 1) & ~1  , r0 = gw * rpw, r1 = (r0 + rpw < nrows) ? r0 + rpw : nrows;
    LAS float* RW = (LAS float*)F.lds;
    { const float* router = INP(I_ROUTER) + (size_t)L * 1024 * 16 + (size_t)tid_ * 32;
      f32x4 rv[8];
#pragma unroll
      for (int q = 0; q < 8; ++q) rv[q] = *((const f32x4*)router + q);
#pragma unroll
      for (int q = 0; q < 4; ++q)
#pragma unroll
          for (int c = 0; c < 4; ++c) { const int e = 4 * q + c; *(LAS f32x2*)(RW + e * 1024 + 2 * tid_) = (f32x2){rv[q][c], rv[4 + q][c]}; } }
    __syncthreads();
    const bf16* XS = WSP(bf16, WS_XS); unsigned char* H8 = WSP(unsigned char, WS_H); float* AFF = WSP(float, WS_AFF); const float* MOD = WSP(float, WS_MOD);
    const int lane = lane_;
    constexpr int R2 = 2;
    v2u vn[R2][4];
#pragma unroll
    for (int q = 0; q < R2; ++q) if (r0 + q < r1) { const v2u* xr = (const v2u*)(XS + (size_t)(r0 + q) * D) + lane;
#pragma unroll
        for (int j = 0; j < 4; ++j) vn[q][j] = xr[64 * j]; }
    int cb = -1; f32x4 shv[4], scv[4];
#pragma unroll
    for (int j = 0; j < 4; ++j) { shv[j] = (f32x4){0.f, 0.f, 0.f, 0.f}; scv[j] = shv[j]; }
    for (int row = r0; row < r1; row += R2) {
        const int b = row < RL ? (row >> 12) : 8;
        if (b != cb) { cb = b; const float* sh = MOD + ((size_t)L * 9 + b) * 6144 + 3072;
#pragma unroll
            for (int j = 0; j < 4; ++j) { shv[j] = *((const f32x4*)sh + 64 * j + lane); scv[j] = *((const f32x4*)(sh + 1024) + 64 * j + lane) + 1.0f; } }
        f32x4 v[R2][4];
#pragma unroll
        for (int q = 0; q < R2; ++q)
#pragma unroll
            for (int j = 0; j < 4; ++j) v[q][j] = bf4(vn[q][j]);
#pragma unroll
        for (int q = 0; q < R2; ++q) { const int rn = row + R2 + q; if (rn < r1) { const v2u* xr = (const v2u*)(XS + (size_t)rn * D) + lane;
#pragma unroll
            for (int j = 0; j < 4; ++j) vn[q][j] = xr[64 * j]; } }
        float ss[R2];
#pragma unroll
        for (int q = 0; q < R2; ++q) { ss[q] = 0.f;
#pragma unroll
            for (int j = 0; j < 4; ++j) ss[q] += (v[q][j].x * v[q][j].x + v[q][j].y * v[q][j].y) + (v[q][j].z * v[q][j].z + v[q][j].w * v[q][j].w); }
#pragma unroll
        for (int o = 1; o < 64; o <<= 1)
#pragma unroll
            for (int q = 0; q < R2; ++q) ss[q] += __shfl_xor(ss[q], o);
        float p[R2][16];
#pragma unroll
        for (int q = 0; q < R2; ++q) { const float rstd = 1.0f / sqrtf(ss[q] * (1.0f / D) + EPS);
            const bool live = row + q < r1;
            unsigned* ho = (unsigned*)(H8 + (size_t)(row + q) * D) + lane;
#pragma unroll
            for (int j = 0; j < 4; ++j) { v[q][j] = v[q][j] * rstd * scv[j] + shv[j]; if (live) ho[64 * j] = pk4_fp8_sat(v[q][j].x, v[q][j].y, v[q][j].z, v[q][j].w); } }
#pragma unroll
        for (int e = 0; e < 16; ++e) { f32x2 a0 = {0.f, 0.f}, b0 = a0, a1 = a0, b1 = a0;
#pragma unroll
            for (int j = 0; j < 4; ++j) { const f32x4 w = *(const LAS f32x4*)(RW + e * 1024 + 256 * j + 4 * lane); const f32x2 wl = {w.x, w.y}, wh = {w.z, w.w};
                a0 = __builtin_elementwise_fma((f32x2){v[0][j].x, v[0][j].y}, wl, a0); b0 = __builtin_elementwise_fma((f32x2){v[0][j].z, v[0][j].w}, wh, b0);
                a1 = __builtin_elementwise_fma((f32x2){v[1][j].x, v[1][j].y}, wl, a1); b1 = __builtin_elementwise_fma((f32x2){v[1][j].z, v[1][j].w}, wh, b1); }
            a0 = a0 + b0; a1 = a1 + b1;
            p[0][e] = a0.x + a0.y; p[1][e] = a1.x + a1.y; __builtin_amdgcn_sched_barrier(0); }
#pragma unroll
        for (int i = 0; i < 8; ++i)
#pragma unroll
            for (int q = 0; q < R2; ++q) { const bool hi = (lane & 32) != 0; const float send = hi ? p[q][i] : p[q][i + 8], keep = hi ? p[q][i + 8] : p[q][i]; p[q][i] = keep + __shfl_xor(send, 32); }
#pragma unroll
        for (int i = 0; i < 4; ++i)
#pragma unroll
            for (int q = 0; q < R2; ++q) { const bool hi = (lane & 16) != 0; const float send = hi ? p[q][i] : p[q][i + 4], keep = hi ? p[q][i + 4] : p[q][i]; p[q][i] = keep + __shfl_xor(send, 16); }
#pragma unroll
        for (int i = 0; i < 2; ++i)
#pragma unroll
            for (int q = 0; q < R2; ++q) { const bool hi = (lane & 8) != 0; const float send = hi ? p[q][i] : p[q][i + 2], keep = hi ? p[q][i + 2] : p[q][i]; p[q][i] = keep + __shfl_xor(send, 8); }
#pragma unroll
        for (int q = 0; q < R2; ++q) { const bool hi = (lane & 4) != 0; const float send = hi ? p[q][0] : p[q][1], keep = hi ? p[q][1] : p[q][0]; p[q][0] = keep + __shfl_xor(send, 4); }
        float lg[R2], mx[R2], ex[R2], sm[R2];
#pragma unroll
        for (int q = 0; q < R2; ++q) { lg[q] = p[q][0]; lg[q] += __shfl_xor(lg[q], 1); }
#pragma unroll
        for (int q = 0; q < R2; ++q) { lg[q] += __shfl_xor(lg[q], 2); mx[q] = lg[q]; }
#pragma unroll
        for (int o = 4; o < 64; o <<= 1)
#pragma unroll
            for (int q = 0; q < R2; ++q) mx[q] = fmaxf(mx[q], __shfl_xor(mx[q], o));
#pragma unroll
        for (int q = 0; q < R2; ++q) { ex[q] = __expf(lg[q] - mx[q]); sm[q] = ex[q]; }
#pragma unroll
        for (int o = 4; o < 64; o <<= 1)
#pragma unroll
            for (int q = 0; q < R2; ++q) sm[q] += __shfl_xor(sm[q], o);
        if ((lane & 3) == 0) { const int e = ((lane >> 5) & 1) * 8 + ((lane >> 4) & 1) * 4 + ((lane >> 3) & 1) * 2 + ((lane >> 2) & 1);
#pragma unroll
            for (int q = 0; q < R2; ++q) if (row + q < r1) AFF[(size_t)(row + q) * 16 + e] = ex[q] / sm[q]; }
    }
    __syncthreads();
}

__device__ __forceinline__ unsigned block_excl_scan(unsigned v, LAS unsigned* tmp, int tid, unsigned& total) {
    const int lane = tid & 63, w = tid >> 6; unsigned inc = v;
#pragma unroll
    for (int o = 1; o < 64; o <<= 1) { const unsigned t = __shfl_up(inc, o); if (lane >= o) inc += t; }
    if (lane == 63) tmp[w] = inc;
    __syncthreads();
    unsigned pre = 0, tot = 0;
#pragma unroll
    for (int i = 0; i < 8; ++i) { const unsigned t = tmp[i]; if (i < w) pre += t; tot += t; }
    __syncthreads();
    total = tot; return pre + inc - v;
}
template <int NPT>
__device__ __forceinline__ void topk_problem(Frame& F, const float* aff  , int n, int k, int row0  , int e, int ybase) {
    const int tid_ = opaque_tid(F.wv), lane_ = tid_ & 63, wave_ = __builtin_amdgcn_readfirstlane(tid_ >> 6); (void)lane_; (void)wave_;
    LAS unsigned* hist = (LAS unsigned*)F.lds;
    LAS unsigned* sel = hist + 256;
    LAS unsigned* tmp = hist + 272;
    const int tid = tid_;
    unsigned key[NPT];
#pragma unroll
    for (int i = 0; i < NPT; ++i) { const int t = tid * NPT + i; key[i] = (t < n) ? __builtin_bit_cast(unsigned, aff[(size_t)t * 16]) : 0u; }
    unsigned prefix = 0, kk = (unsigned)k;
#pragma unroll
    for (int pass = 0; pass < 4; ++pass) {
        const int shift = 24 - 8 * pass;
        if (tid < 256) hist[tid] = 0u;
        __syncthreads();
#pragma unroll
        for (int i = 0; i < NPT; ++i) { const int t = tid * NPT + i; const bool in = (t < n) && (pass == 0 || (key[i] >> (shift + 8)) == prefix); if (in) __hip_atomic_fetch_add(&hist[(key[i] >> shift) & 255u], 1u, __ATOMIC_RELAXED, __HIP_MEMORY_SCOPE_WORKGROUP); }
        __syncthreads();
        if (tid < 64) {
            unsigned c[4]; unsigned s = 0;
#pragma unroll
            for (int q = 0; q < 4; ++q) { c[q] = hist[255 - 4 * tid - q]; s += c[q]; }
            unsigned inc = s;
#pragma unroll
            for (int o = 1; o < 64; o <<= 1) { const unsigned t = __shfl_up(inc, o); if (tid >= o) inc += t; }
            const unsigned long long m = __ballot(inc >= kk);
            const int first = __ffsll((long long)m) - 1;
            if (tid == first) { unsigned before = inc - s; int q = 0; for (; q < 3; ++q) { if (before + c[q] >= kk) break; before += c[q]; }
                sel[0] = (unsigned)(255 - 4 * tid - q); sel[1] = kk - before; }
        }
        __syncthreads();
        prefix = (prefix << 8) | sel[0]; kk = sel[1];
        __syncthreads();
    }
    const unsigned T = prefix, need_eq = kk;
    unsigned cg = 0, ce = 0;
#pragma unroll
    for (int i = 0; i < NPT; ++i) { const int t = tid * NPT + i; if (t < n) { cg += key[i] > T; ce += key[i] == T; } }
    unsigned total; const unsigned pre = block_excl_scan((ce << 16) | cg, tmp, tid, total);
    unsigned gb = pre & 0xffffu, eb = pre >> 16;
    int* INV = WSP(int, WS_INV); int* IDX = WSP(int, WS_IDX); float* GATE = WSP(float, WS_GATE);
#pragma unroll
    for (int i = 0; i < NPT; ++i) { const int t = tid * NPT + i; if (t < n) {
        const bool g = key[i] > T, q = key[i] == T; const bool s = g || (q && eb < need_eq);
        const int slot = (int)(gb + (eb < need_eq ? eb : need_eq));
        const int row = row0 + t;
        if (s) { IDX[ybase + slot] = row; GATE[ybase + slot] = __builtin_bit_cast(float, key[i]); }
        INV[(size_t)row * 16 + e] = s ? (ybase + slot) : -1;
        gb += g; eb += q; } }
    __syncthreads();
}
template <int L>
__device__ __forceinline__ void phase_topk(Frame& F) {
    constexpr int nprob = (L >= 2) ? 128 : 256;
    const float* AFF = WSP(float, WS_AFF);
    for (int p = (int)blockIdx.x; p < nprob; p += F.G) {
        if (p < 128) { const int b = p >> 4, e = p & 15; topk_problem<8>(F, AFF + (size_t)b * SEQ * 16 + e, SEQ, SEQ / 8, b * SEQ, e, p * 512); }
        else { const int q = p - 128, e = q >> 3, b = q & 7; topk_problem<1>(F, AFF + (size_t)(RL + b * CTX) * 16 + e, CTX, CTX / 8, RL + b * CTX, e, NYL + e * 256 + b * 32); }
    }
}

__device__ __forceinline__ void seq_pos(int row, int& pos, int& len) { if (row < RL) { pos = row & (SEQ - 1); len = SEQ; } else { pos = (row - RL) & (CTX - 1); len = CTX; } }
template <int W>
__device__ __forceinline__ void pool_run(const bf16* H, bf16* P, int r0, int c8) {
    constexpr int RR = 8, NL = RR + W - 1;
    int pos0, len; seq_pos(r0, pos0, len);
    v4u w[NL];
#pragma unroll
    for (int k = 0; k < NL; ++k) { const int p = pos0 - W / 2 + k; const bool ok = (p >= 0 && p < len); w[k] = ok ? *(const v4u*)(H + (size_t)(r0 - W / 2 + k) * D + c8 * 8) : (v4u){0u, 0u, 0u, 0u}; }
    float s[8];
#pragma unroll
    for (int q = 0; q < 8; ++q) s[q] = 0.f;
#pragma unroll
    for (int k = 0; k < W; ++k) { s[0] += bflo(w[k].x); s[1] += bfhi(w[k].x); s[2] += bflo(w[k].y); s[3] += bfhi(w[k].y); s[4] += bflo(w[k].z); s[5] += bfhi(w[k].z); s[6] += bflo(w[k].w); s[7] += bfhi(w[k].w); }
#pragma unroll
    for (int j = 0; j < RR; ++j) {
        const int pos = pos0 + j, lo = max(pos - W / 2, 0), hi = min(pos + W / 2, len);
        const float inv = __builtin_amdgcn_rcpf((float)(hi - lo));
        const v4u c = w[j + W / 2];
        v4u o; o.x = pk2(s[0] * inv - bflo(c.x), s[1] * inv - bfhi(c.x)); o.y = pk2(s[2] * inv - bflo(c.y), s[3] * inv - bfhi(c.y));
        o.z = pk2(s[4] * inv - bflo(c.z), s[5] * inv - bfhi(c.z)); o.w = pk2(s[6] * inv - bflo(c.w), s[7] * inv - bfhi(c.w));
        *(v4u*)(P + (size_t)(r0 + j) * D + c8 * 8) = o;
        if (j + 1 < RR) { const v4u a = w[j + W], d = w[j];
            s[0] += bflo(a.x) - bflo(d.x); s[1] += bfhi(a.x) - bfhi(d.x); s[2] += bflo(a.y) - bflo(d.y); s[3] += bfhi(a.y) - bfhi(d.y);
            s[4] += bflo(a.z) - bflo(d.z); s[5] += bfhi(a.z) - bfhi(d.z); s[6] += bflo(a.w) - bflo(d.w); s[7] += bfhi(a.w) - bfhi(d.w); }
    }
}
__device__ __forceinline__ void phase_pool(Frame& F) {
    const int tid_ = opaque_tid(F.wv), lane_ = tid_ & 63, wave_ = __builtin_amdgcn_readfirstlane(tid_ >> 6);
    const bf16* H = WSP(bf16, WS_H); bf16* P = WSP(bf16, SC_P);
    const int gw = F.vcu * NWAVES + wave_, NGW = F.G * NWAVES;
    for (int it = gw; it < 4 * (RT / 16); it += NGW) {
        const int g = it & 3, r0 = ((it >> 2) * 2 + (lane_ >> 5)) * 8, c8 = g * 32 + (lane_ & 31);
        if (g == 0) pool_run<2>(H, P, r0, c8); else if (g == 1) pool_run<4>(H, P, r0, c8); else if (g == 2) pool_run<8>(H, P, r0, c8); else pool_run<16>(H, P, r0, c8);
    }
}
__device__ __forceinline__ void phase_conv(Frame& F) {
    const int tid_ = opaque_tid(F.wv);
    const bf16* ZX = WSP(bf16, SC_ZX); bf16* XR = WSP(bf16, SC_XR); const float* cw = INP(I_CONVW); const float* cb = INP(I_CONVB);
    constexpr int U = 4;
    for (int j = (int)blockIdx.x * 512 + tid_; j < (RT / U) * 128; j += F.G * 512) {
        const int rg = j >> 7, c8 = j & 127, row0 = rg * U; int pos0, len; seq_pos(row0, pos0, len);
        v4u w[U + 3];
#pragma unroll
        for (int k = 0; k < U + 3; ++k) { const int p = pos0 + k - 2; const bool ok = p >= 0 && p < len; w[k] = ok ? *(const v4u*)(ZX + (size_t)(row0 + k - 2) * D + c8 * 8) : (v4u){0u, 0u, 0u, 0u}; }
        f32x4 w0[4], w1[4];
#pragma unroll
        for (int k = 0; k < 4; ++k) { w0[k] = *(const f32x4*)(cw + k * 1024 + c8 * 8); w1[k] = *(const f32x4*)(cw + k * 1024 + c8 * 8 + 4); }
        const f32x4 b0 = *(const f32x4*)(cb + c8 * 8), b1 = *(const f32x4*)(cb + c8 * 8 + 4);
#pragma unroll
        for (int u = 0; u < U; ++u) {
            float s[8] = {b0.x, b0.y, b0.z, b0.w, b1.x, b1.y, b1.z, b1.w};
#pragma unroll
            for (int k = 0; k < 4; ++k) { const v4u x = w[u + k];
                s[0] += bflo(x.x) * w0[k].x; s[1] += bfhi(x.x) * w0[k].y; s[2] += bflo(x.y) * w0[k].z; s[3] += bfhi(x.y) * w0[k].w;
                s[4] += bflo(x.z) * w1[k].x; s[5] += bfhi(x.z) * w1[k].y; s[6] += bflo(x.w) * w1[k].z; s[7] += bfhi(x.w) * w1[k].w; }
            v4u o; o.x = pk2(s[0], s[1]); o.y = pk2(s[2], s[3]); o.z = pk2(s[4], s[5]); o.w = pk2(s[6], s[7]);
            *(v4u*)(XR + (size_t)(row0 + u) * D + c8 * 8) = o; }
    }
}
__device__ __forceinline__ int scan_chunk(int d, int b, int s) { return d == 0 ? (s < 4 ? 512 + b * 4 + s : b * 64 + (s - 4)) : (s < 4 ? 512 + b * 4 + (3 - s) : b * 64 + (63 - (s - 4))); }
__device__ __forceinline__ void phase_carry(Frame& F) {
    const int tid_ = opaque_tid(F.wv), lane_ = tid_ & 63, wave_ = __builtin_amdgcn_readfirstlane(tid_ >> 6); (void)lane_; (void)wave_;
    const f32x2* AGG = WSP(f32x2, WS_AGG); float* CARRY = WSP(float, WS_CARRY);
    for (int gid = (int)blockIdx.x * 512 + tid_; gid < 2 * 8 * 1024; gid += F.G * 512) {
        const int d = gid >> 13, b = (gid >> 10) & 7, ch = gid & 1023;
        float st = 0.f;
#pragma unroll 17
        for (int s = 0; s < 68; ++s) { const int c = scan_chunk(d, b, s); const size_t o = ((size_t)d * 544 + c) * 1024 + ch;
            const f32x2 ah = AGG[o]; CARRY[o] = st; st = ah.x * st + ah.y; }
    }
}
__device__ __forceinline__ void phase_lruc(Frame& F) {
    const int tid_ = opaque_tid(F.wv);
    const bf16 *HL0 = WSP(bf16, SC_HL0), *AC0 = WSP(bf16, SC_AC0), *AC1 = WSP(bf16, SC_AC1); bf16* G = WSP(bf16, SC_G);
    const float* CARRY = WSP(float, WS_CARRY);
    constexpr int U = 4;
    for (int j = (int)blockIdx.x * 512 + tid_; j < (RT / U) * 128; j += F.G * 512) {
        const int rg = j >> 7, c8 = j & 127, row0 = rg * U, chunk = row0 >> 6;
        v4u h0[U], a0[U], a1[U];
        const float* c0 = CARRY + ((size_t)chunk) * 1024 + c8 * 8; const float* c1 = CARRY + ((size_t)544 + chunk) * 1024 + c8 * 8;
        const f32x4 p0 = *(const f32x4*)c0, p1 = *(const f32x4*)(c0 + 4), q0 = *(const f32x4*)c1, q1 = *(const f32x4*)(c1 + 4);
#pragma unroll
        for (int u = 0; u < U; ++u) { const size_t o = (size_t)(row0 + u) * D + c8 * 8; h0[u] = *(const v4u*)(HL0 + o); a0[u] = *(const v4u*)(AC0 + o); a1[u] = *(const v4u*)(AC1 + o); }
#pragma unroll
        for (int u = 0; u < U; ++u) { const size_t o = (size_t)(row0 + u) * D + c8 * 8;
            float r[8];
            r[0] = bflo(h0[u].x) + bflo(a0[u].x) * p0.x + bflo(a1[u].x) * q0.x; r[1] = bfhi(h0[u].x) + bfhi(a0[u].x) * p0.y + bfhi(a1[u].x) * q0.y;
            r[2] = bflo(h0[u].y) + bflo(a0[u].y) * p0.z + bflo(a1[u].y) * q0.z; r[3] = bfhi(h0[u].y) + bfhi(a0[u].y) * p0.w + bfhi(a1[u].y) * q0.w;
            r[4] = bflo(h0[u].z) + bflo(a0[u].z) * p1.x + bflo(a1[u].z) * q1.x; r[5] = bfhi(h0[u].z) + bfhi(a0[u].z) * p1.y + bfhi(a1[u].z) * q1.y;
            r[6] = bflo(h0[u].w) + bflo(a0[u].w) * p1.z + bflo(a1[u].w) * q1.z; r[7] = bfhi(h0[u].w) + bfhi(a0[u].w) * p1.w + bfhi(a1[u].w) * q1.w;
            v4u w; w.x = pk2(r[0], r[1]); w.y = pk2(r[2], r[3]); w.z = pk2(r[4], r[5]); w.w = pk2(r[6], r[7]);
            *(v4u*)(G + o) = w; }
    }
}

using pg8::Unit;
struct SchedMN {
    int nM, nN, G, c, ash; const char* A; const char* B; size_t a_tile, a_pn, b_tile;
    __device__ __forceinline__ bool next(int i, Unit& u) const {
        const int nwg = nM * nN, R = nwg / G, T = nwg - R * G;
        int pm, pn, hf = 0, ro = 0;
        if (i == R && T > 0 && 2 * T <= G) { if (c >= 2 * T) return false; if (!pg8::static_order_l((long)R * G + (c >> 1), nM, nN, pm, pn)) return false; hf = 1; ro = (c & 1) * 128; }
        else if (!pg8::static_order(i, G, c, nM, nN, pm, pn)) return false;
        u.pm = pm; u.pn = pn; u.rows = nullptr; u.half = hf; u.row0 = pm * 256 + ro;
        u.A = A + (size_t)pm * a_tile + (size_t)ro * (a_tile >> 8) + (size_t)(pn >> ash) * a_pn; u.B = B + (size_t)pn * b_tile; return true;
    }
};
__device__ __forceinline__ int moe_expert(int t) { return t < 256 ? ((t >> 1) & 15) : (t - 256); }
struct SchedMoeUp {
    int G, c, nct; const char* Hb; const char* W; const int* IDX;
    __device__ __forceinline__ bool next(int i, Unit& u) const {
        int t, pn;
        if (G == 256) {
            const int x = c & 7, j = c >> 3;
            if (i < 8) { const int e = 2 * x + (i >> 2), a = (i & 3) * 4 + (j >> 3); pn = j & 7; t = ((a >> 1) * 16 + e) * 2 + (a & 1); }
            else if (i == 8 && c < nct) { t = 256 + (c >> 3); pn = c & 7; }
            else return false;
        } else { const int L = i * G + c; const int tot = 2048 + nct; if (L >= tot) return false; t = L >> 3; pn = L & 7; }
        u.pm = t; u.pn = pn; u.rows = IDX + t * 256; u.half = 0; u.row0 = t * 256; u.A = Hb; u.B = W + ((size_t)moe_expert(t) * 2048 + (size_t)pn * 256) * 1024; return true;
    }
};
struct SchedMoeDown {
    int G, c, ntile; const char* ACT; const char* W;
    __device__ __forceinline__ bool next(int i, Unit& u) const {
        int pm, pn;
        if (G == 256) {
            const int x = c & 7, j = c >> 3;
            if (i < 4) { const int e = 2 * x + (i >> 1), a = (i & 1) * 8 + (j >> 2); pn = j & 3; pm = ((a >> 1) * 16 + e) * 2 + (a & 1); }
            else if (i == 4 && ntile > 256 && c < 64) { pm = 256 + (c >> 2); pn = c & 3; }
            else return false;
        } else if (!pg8::static_order(i, G, c, ntile, 4, pm, pn)) return false;
        u.pm = pm; u.pn = pn; u.rows = nullptr; u.half = 0; u.row0 = pm * 256; u.A = ACT + (size_t)pm * 256 * 1024; u.B = W + ((size_t)moe_expert(pm) * 1024 + (size_t)pn * 256) * 1024; return true;
    }
};

using f32x4_t = f32x4;
typedef const f32x4 (&AccRef)[2][2][4][2];
__device__ __forceinline__ v4u pack8(const f32x4& v0, const f32x4& v1) { v4u w; w.x = pk2(v0.x, v0.y); w.y = pk2(v0.z, v0.w); w.z = pk2(v1.x, v1.y); w.w = pk2(v1.z, v1.w); return w; }
template <bool LAYER0, bool SCALE>
struct EpiRes {
    bf16* XS; const float* x_in; const float* ctx_in; const float* g1base  ; const float* scale; bf16* DST; int ctx_shift; float mul;
    __device__ __forceinline__ void operator()(AccRef acc, const Unit& u, int wr, int wc, int fr, int fq) const {
        asm volatile("" : "+v"(fr), "+v"(fq));
        const int b = u.pm < 128 ? (u.pm >> 4) : 8; const float* g1 = g1base + (size_t)b * 6144;
        const int col0 = u.pn * 256 + wc * 32 + 8 * fq;
        f32x4 gv[2][2];
#pragma unroll
        for (int bj = 0; bj < 2; ++bj)
#pragma unroll
            for (int n = 0; n < 2; ++n) { gv[bj][n] = *(const f32x4*)(g1 + col0 + bj * 128 + n * 4) * mul; if (SCALE) gv[bj][n] = gv[bj][n] * *(const f32x4*)(scale + col0 + bj * 128 + n * 4); }
#pragma unroll
        for (int ai = 0; ai < 2; ++ai) {
            if (ai == 1 && u.half) continue;
            f32x4 xv[4][2][2]; v4u xb[4][2];
#pragma unroll
            for (int m = 0; m < 4; ++m) {
                const int row = u.row0 + ai * 128 + wr * 64 + m * 16 + fr;
#pragma unroll
                for (int bj = 0; bj < 2; ++bj) {
                    if (LAYER0) { const float* src = (row < RL ? x_in + (size_t)row * D : ctx_in + (size_t)(row - RL) * D) + col0 + bj * 128; xv[m][bj][0] = *(const f32x4*)src; xv[m][bj][1] = *(const f32x4*)(src + 4); }
                    else xb[m][bj] = *(const v4u*)(XS + (size_t)row * D + col0 + bj * 128); } }
#pragma unroll
            for (int m = 0; m < 4; ++m) {
                const int row = u.row0 + ai * 128 + wr * 64 + m * 16 + fr;
                bf16* dst = DST + (size_t)(row - (u.pm >= 128 ? ctx_shift : 0)) * D;
#pragma unroll
                for (int bj = 0; bj < 2; ++bj) {
                    f32x4 x0, x1;
                    if (LAYER0) { x0 = xv[m][bj][0]; x1 = xv[m][bj][1]; } else { x0 = bf4((v2u){xb[m][bj].x, xb[m][bj].y}); x1 = bf4((v2u){xb[m][bj].z, xb[m][bj].w}); }
                    *(v4u*)(dst + col0 + bj * 128) = pack8(x0 + gv[bj][0] * acc[ai][bj][m][0], x1 + gv[bj][1] * acc[ai][bj][m][1]); } }
            __builtin_amdgcn_sched_barrier(0);
        }
    }
};
struct EpiLruIn {
    bf16* YG; bf16* ZX;
    __device__ __forceinline__ void operator()(AccRef acc, const Unit& u, int wr, int wc, int fr, int fq) const {
        asm volatile("" : "+v"(fr), "+v"(fq));
        const bool isy = u.pn < 4; bf16* base = isy ? YG + u.pn * 256 : ZX + (u.pn - 4) * 256;
#pragma unroll
        for (int ai = 0; ai < 2; ++ai) { if (ai == 1 && u.half) continue;
#pragma unroll
            for (int m = 0; m < 4; ++m) { const int row = u.row0 + ai * 128 + wr * 64 + m * 16 + fr;
#pragma unroll
                for (int bj = 0; bj < 2; ++bj) { f32x4 v0 = acc[ai][bj][m][0], v1 = acc[ai][bj][m][1];
                    if (isy) {
#pragma unroll
                        for (int e = 0; e < 1; ++e) { gelu4(v0); gelu4(v1); } }
                    *(v4u*)(base + (size_t)row * D + bj * 128 + wc * 32 + 8 * fq) = pack8(v0, v1); } } }
    }
};
template <int CTRL> __device__ __forceinline__ float dpp_f(float oldv, float src) {
    return __builtin_bit_cast(float, __builtin_amdgcn_update_dpp(__builtin_bit_cast(int, oldv), __builtin_bit_cast(int, src), CTRL, 0xf, 0xf, false)); }
struct EpiGates {
    const bf16* XR; const bf16* YG; bf16 *HS, *AC0, *AC1; f32x2* AGG; const float *ba, *bx, *lam;
    __device__ __forceinline__ void operator()(AccRef acc, const Unit& u, int wr, int wc, int fr_, int fq_) const {
        const int lz = opaque_tid(0), fr = lz & 15, fq = lz >> 4;
        const int chb = (u.pn >> 1) * 128 + (u.pn & 1) * 64 + wc * 16 + 4 * fq;
        v2u xwp[2][4];
#pragma unroll
        for (int ai = 0; ai < 2; ++ai)
#pragma unroll
            for (int m = 0; m < 4; ++m) xwp[ai][m] = *(const v2u*)(XR + (size_t)(u.row0 + (u.half ? 0 : ai * 128) + wr * 64 + m * 16 + fr) * D + chb);
#pragma unroll
        for (int ai = 0; ai < 2; ++ai) {
            if (ai == 1 && u.half) continue;
            v2u ywp[4];
#pragma unroll
            for (int m = 0; m < 4; ++m) ywp[m] = *(const v2u*)(YG + (size_t)(u.row0 + ai * 128 + wr * 64 + m * 16 + fr) * D + chb);
            float hs[4][4];
            dir<0>(acc, u, ai, wr, fr, chb, xwp[ai], ywp, hs);
            dir<1>(acc, u, ai, wr, fr, chb, xwp[ai], ywp, hs);
        }
    }
    template <int d>
    __device__ __forceinline__ void dir(AccRef acc, const Unit& u, const int ai, const int wr, const int fr, const int chb, const v2u (&xwa)[4], const v2u (&ywa)[4], float (&hs)[4][4]) const {
        bf16* AC = d ? AC1 : AC0;
        constexpr int SH = d ? 0x100 : 0x110;
        constexpr int BC = d ? 0x150 : 0x15F;
        const f32x4 bav = *(const f32x4*)(ba + d * 1024 + chb), bxv = *(const f32x4*)(bx + d * 1024 + chb), c8 = *(const f32x4*)(lam + d * 1024 + chb);
        float Ac[4], Hc[4];
#pragma unroll
        for (int e = 0; e < 4; ++e) { Ac[e] = 1.f; Hc[e] = 0.f; }
#pragma unroll
        for (int mm = 0; mm < 4; ++mm) { constexpr int dd = d; const int m = dd ? 3 - mm : mm;
            const int row = u.row0 + ai * 128 + wr * 64 + m * 16 + fr;
            const v2u xw = xwa[m];
            const float xr[4] = {bflo(xw.x), bfhi(xw.x), bflo(xw.y), bfhi(xw.y)};
            float hl[4], ac[4], av[4], hv[4];
#pragma unroll
            for (int e = 0; e < 4; ++e) { const float r = sigmoid_f(acc[ai][d][m][0][e] + bav[e]), ig = sigmoid_f(acc[ai][d][m][1][e] + bxv[e]);
                const float l2 = r * c8[e];
                const float a = __builtin_amdgcn_exp2f(l2);
                const float om = fmaxf(1.0f - a * a, 0.f);
                av[e] = a; hv[e] = xr[e] * ig * __builtin_amdgcn_sqrtf(om); }
#define GSCAN(SHF) asm volatile("s_nop 1\n\t" \
                "v_fmac_f32_dpp %0, %0, %4 " SHF " row_mask:0xf bank_mask:0xf bound_ctrl:0\n\tv_mul_f32_dpp %4, %4, %4 " SHF " row_mask:0xf bank_mask:0xf\n\t" \
                "v_fmac_f32_dpp %1, %1, %5 " SHF " row_mask:0xf bank_mask:0xf bound_ctrl:0\n\tv_mul_f32_dpp %5, %5, %5 " SHF " row_mask:0xf bank_mask:0xf\n\t" \
                "v_fmac_f32_dpp %2, %2, %6 " SHF " row_mask:0xf bank_mask:0xf bound_ctrl:0\n\tv_mul_f32_dpp %6, %6, %6 " SHF " row_mask:0xf bank_mask:0xf\n\t" \
                "v_fmac_f32_dpp %3, %3, %7 " SHF " row_mask:0xf bank_mask:0xf bound_ctrl:0\n\tv_mul_f32_dpp %7, %7, %7 " SHF " row_mask:0xf bank_mask:0xf" \
                : "+v"(hv[0]), "+v"(hv[1]), "+v"(hv[2]), "+v"(hv[3]), "+v"(av[0]), "+v"(av[1]), "+v"(av[2]), "+v"(av[3]))
            if constexpr (dd == 0) { GSCAN("row_shr:1"); GSCAN("row_shr:2"); GSCAN("row_shr:4"); GSCAN("row_shr:8"); }
            else { GSCAN("row_shl:1"); GSCAN("row_shl:2"); GSCAN("row_shl:4"); GSCAN("row_shl:8"); }
#undef GSCAN
#pragma unroll
            for (int e = 0; e < 4; ++e) { const float a = av[e], hh = hv[e];
                const float fa = dpp_f<BC>(0.0f, a), fh = dpp_f<BC>(0.0f, hh);
                hl[e] = hh + a * Hc[e]; ac[e] = a * Ac[e];
                Hc[e] = fa * Hc[e] + fh; Ac[e] = fa * Ac[e]; }
            if (dd == 0) {
#pragma unroll
                for (int e = 0; e < 4; ++e) hs[m][e] = hl[e]; }
            const v2u yw = ywa[m]; const float yg[4] = {bflo(yw.x), bfhi(yw.x), bflo(yw.y), bfhi(yw.y)};
            if (dd == 1) { v2u w; w.x = pk2((hs[m][0] + hl[0]) * yg[0], (hs[m][1] + hl[1]) * yg[1]); w.y = pk2((hs[m][2] + hl[2]) * yg[2], (hs[m][3] + hl[3]) * yg[3]); *(v2u*)(HS + (size_t)row * D + chb) = w; }
            v2u q; q.x = pk2(ac[0] * yg[0], ac[1] * yg[1]); q.y = pk2(ac[2] * yg[2], ac[3] * yg[3]); *(v2u*)(AC + (size_t)row * D + chb) = q;
            __builtin_amdgcn_sched_barrier(0); }
        if (fr == 0) { const int chunk = (u.row0 >> 6) + ai * 2 + wr; f32x2* ag = AGG + ((size_t)d * 544 + chunk) * 1024 + chb;
#pragma unroll
            for (int e = 0; e < 4; ++e) ag[e] = (f32x2){Ac[e], Hc[e]}; }
    }
};
struct EpiQKV {
    bf16 *Q, *KA, *VA; const float *qg, *kg; const f32x2* rope;
    __device__ __forceinline__ void operator()(AccRef acc, const Unit& u, int wr, int wc, int fr, int fq) const {
        asm volatile("" : "+v"(fr), "+v"(fq));
        const int kind = u.pn < 4 ? 0 : (u.pn == 4 ? 1 : 2);
        const float* gp = kind == 0 ? qg : kg;
        f32x4 g[2][2];
#pragma unroll
        for (int bj = 0; bj < 2; ++bj)
#pragma unroll
            for (int n = 0; n < 2; ++n) g[bj][n] = (kind == 2) ? (f32x4){1.f, 1.f, 1.f, 1.f} : *(const f32x4*)(gp + bj * 32 + 8 * fq + 4 * n);
        const float post = kind == 0 ? attn_body::C2 : 1.0f;
#pragma unroll
        for (int ai = 0; ai < 2; ++ai)
#pragma unroll
            for (int m = 0; m < 4; ++m) {
                if (ai == 1 && u.half) continue;
                const int row = u.row0 + ai * 128 + wr * 64 + m * 16 + fr;
                const bool lat = row < RL; const int bb = lat ? (row >> 12) : ((row - RL) >> 8), nn = lat ? (row & (SEQ - 1)) : ((row - RL) & (CTX - 1));
                f32x4 v[2][2];
#pragma unroll
                for (int bj = 0; bj < 2; ++bj)
#pragma unroll
                    for (int n = 0; n < 2; ++n) v[bj][n] = acc[ai][bj][m][n];
                if (kind != 2) {
                    float ss = 0.f;
#pragma unroll
                    for (int bj = 0; bj < 2; ++bj)
#pragma unroll
                        for (int n = 0; n < 2; ++n) ss += (v[bj][n].x * v[bj][n].x + v[bj][n].y * v[bj][n].y) + (v[bj][n].z * v[bj][n].z + v[bj][n].w * v[bj][n].w);
                    ss += __shfl_xor(ss, 16); ss += __shfl_xor(ss, 32);
                    const float rstd = 1.0f / sqrtf(ss * (1.0f / 64.0f) + EPS);
#pragma unroll
                    for (int bj = 0; bj < 2; ++bj)
#pragma unroll
                        for (int n = 0; n < 2; ++n) v[bj][n] = v[bj][n] * rstd * g[bj][n];
                    if (lat) {
#pragma unroll
                        for (int bj = 0; bj < 2; ++bj) { const int pos = bj ? (nn & 63) : (nn >> 6);
#pragma unroll
                            for (int n = 0; n < 2; ++n) { const f32x2 cs0 = rope[pos * 16 + 4 * fq + 2 * n], cs1 = rope[pos * 16 + 4 * fq + 2 * n + 1];
                                const f32x4 t = v[bj][n];
                                v[bj][n].x = t.x * cs0.x - t.y * cs0.y; v[bj][n].y = t.x * cs0.y + t.y * cs0.x;
                                v[bj][n].z = t.z * cs1.x - t.w * cs1.y; v[bj][n].w = t.z * cs1.y + t.w * cs1.x; } }
                    }
                }
                if (kind == 0) {
                    bf16* dst = Q + (size_t)row * D + (u.pn * 4 + wc) * 64 + 8 * fq;
#pragma unroll
                    for (int bj = 0; bj < 2; ++bj) *(v4u*)(dst + bj * 32) = pack8(v[bj][0] * post, v[bj][1] * post);
                } else {
                    const size_t krow = (size_t)bb * KVLEN + (lat ? CTX + nn : nn);
                    bf16* dst = (kind == 1 ? KA : VA) + krow * 256 + wc * 64 + 8 * fq;
#pragma unroll
                    for (int bj = 0; bj < 2; ++bj) *(v4u*)(dst + bj * 32) = pack8(v[bj][0], v[bj][1]);
                }
                __builtin_amdgcn_sched_barrier(0);
            }
    }
};
struct EpiGmlpIn {
    bf16 *U, *V; f32x2* PSUM;
    __device__ __forceinline__ void operator()(AccRef acc, const Unit& u, int wr, int wc, int fr, int fq) const {
        const int lz = opaque_tid(0); fr = lz & 15; fq = lz >> 4;
        const int x16 = (lz ^ 16) << 2, x32 = (lz ^ 32) << 2;
#define GX(v, a) __builtin_bit_cast(float, __builtin_amdgcn_ds_bpermute((a), __builtin_bit_cast(int, (v))))
        const bool isu = u.pn < 12; bf16* base = isu ? U + u.pn * 256 : V + (u.pn - 12) * 256;
#pragma unroll
        for (int ai = 0; ai < 2; ++ai)
#pragma unroll
            for (int m = 0; m < 4; ++m) { const int row = u.pm * 256 + ai * 128 + wr * 64 + m * 16 + fr; float s1, s2;
                asm volatile("v_mov_b32 %0, 0\n\tv_mov_b32 %1, 0" : "=v"(s1), "=v"(s2));
#pragma unroll
                for (int bj = 0; bj < 2; ++bj) { f32x4 v0 = acc[ai][bj][m][0] * W8_INV;
                    gelu4(v0); { const f32x4 qv = v0 * v0; s1 += (v0.x + v0.y) + (v0.z + v0.w); s2 += (qv.x + qv.y) + (qv.z + qv.w); }
                    __builtin_amdgcn_sched_barrier(0);
                    f32x4 v1 = acc[ai][bj][m][1] * W8_INV;
                    gelu4(v1); { const f32x4 qv = v1 * v1; s1 += (v1.x + v1.y) + (v1.z + v1.w); s2 += (qv.x + qv.y) + (qv.z + qv.w); }
                    *(v4u*)((char*)base + (unsigned)(row * 6144 + (bj * 128 + wc * 32 + 8 * fq) * 2)) = pack8(v0, v1);
                    __builtin_amdgcn_sched_barrier(0); }
                if (!isu) { s1 += GX(s1, x16); s1 += GX(s1, x32); s2 += GX(s2, x16); s2 += GX(s2, x32);
                    if (fq == 0) PSUM[(size_t)row * 48 + (u.pn - 12) * 4 + wc] = (f32x2){s1, s2}; }
                __builtin_amdgcn_sched_barrier(0); }
#undef GX
    }
};
struct EpiMoeUp {
    unsigned char* ACT;
    ConvSide cs;
    __device__ __forceinline__ void operator()(AccRef acc, const Unit& u, int wr, int wc, int fr, int fq) const {
        asm volatile("" : "+v"(fr), "+v"(fq));
        const int cs_item = (u.pm * 8 + u.pn) * 8 + wr * 4 + wc; float csv[32];
        const bool cs_on = cs.issue(cs_item, fq * 16 + fr, csv);
        __builtin_amdgcn_sched_barrier(0);
#pragma unroll
        for (int ai = 0; ai < 2; ++ai)
#pragma unroll
            for (int m = 0; m < 4; ++m) { const size_t yrow = (size_t)u.pm * 256 + ai * 128 + wr * 64 + m * 16 + fr;
                f32x4 o[2];
#pragma unroll
                for (int n = 0; n < 2; ++n)
#pragma unroll
                    for (int e = 0; e < 4; ++e) { const float gt = acc[ai][0][m][n][e] * W8_INV, up = acc[ai][1][m][n][e] * W8_INV; o[n][e] = gt * sigmoid_f(gt) * up; }
                v2u w; w.x = pk4_fp8_sat(o[0].x, o[0].y, o[0].z, o[0].w); w.y = pk4_fp8_sat(o[1].x, o[1].y, o[1].z, o[1].w);
                *(v2u*)(ACT + yrow * D + u.pn * 128 + wc * 32 + 8 * fq) = w; }
        __builtin_amdgcn_sched_barrier(0);
        if (cs_on) cs.finish(cs_item, fq * 16 + fr, csv);
    }
};
struct EpiMoeDown {
    unsigned char* Y; const float* GATE;
    ConvSide cs; int ctx_remap;
    __device__ __forceinline__ void operator()(AccRef acc, const Unit& u, int wr, int wc, int fr, int fq) const {
        asm volatile("" : "+v"(fr), "+v"(fq));
        const int cs_item = ((ctx_remap && u.pm >= 224) ? (2048 + (u.pm - 224) * 4 + u.pn) : (2176 + u.pm * 4 + u.pn)) * 8 + wr * 4 + wc; float csv[32];
        const bool cs_on = cs.issue(cs_item, fq * 16 + fr, csv);
        __builtin_amdgcn_sched_barrier(0);
        float gtv[2][4];
#pragma unroll
        for (int ai = 0; ai < 2; ++ai)
#pragma unroll
            for (int m = 0; m < 4; ++m) gtv[ai][m] = GATE[(size_t)u.pm * 256 + ai * 128 + wr * 64 + m * 16 + fr] * (W8_INV * Y8_SCALE);
#pragma unroll
        for (int ai = 0; ai < 2; ++ai)
#pragma unroll
            for (int m = 0; m < 4; ++m) { const size_t yrow = (size_t)u.pm * 256 + ai * 128 + wr * 64 + m * 16 + fr; const float gt = gtv[ai][m];
#pragma unroll
                for (int bj = 0; bj < 2; ++bj) { const f32x4 y0 = acc[ai][bj][m][0] * gt, y1 = acc[ai][bj][m][1] * gt; v2u w; w.x = pk4_fp8_sat(y0.x, y0.y, y0.z, y0.w); w.y = pk4_fp8_sat(y1.x, y1.y, y1.z, y1.w);
                    *(v2u*)(Y + yrow * D + u.pn * 256 + bj * 128 + wc * 32 + 8 * fq) = w; }  __builtin_amdgcn_sched_barrier(0); }
        if (cs_on) cs.finish(cs_item, fq * 16 + fr, csv);
    }
};

typedef short v4i16_tr __attribute__((ext_vector_type(4)));
__device__ __forceinline__ void phase_spatial(Frame& F, unsigned char* Gdst) {
    const int tid_ = opaque_tid(F.wv), lane_ = tid_ & 63, wave_ = __builtin_amdgcn_readfirstlane(tid_ >> 6); (void)lane_; (void)wave_;
    constexpr int WLS = 136;
    constexpr int VP = 160;
    LAS bf16* WL = (LAS bf16*)F.lds;
    LAS unsigned char* VS = F.lds + 128 * WLS * 2;
    LAS float* ST = (LAS float*)(F.lds + 128 * WLS * 2 + 2 * 128 * VP);
    const int tid = tid_, lane = lane_, wave = wave_, fr = lane & 15, fq = lane >> 4;
    const bf16* U = WSP(bf16, SC_U); const bf16* V = WSP(bf16, SC_V); const f32x2* PSUM = WSP(f32x2, SC_PSUM);
    const bf16* WS = WSP(bf16, WS_GS); const float* lng = INP(I_LNG); const float* lnb = INP(I_LNB); const float* bs = INP(I_BS);
    for (int unit = (int)blockIdx.x; unit < 8 * 32 * 4; unit += F.G) {
        const int g = unit & 3, ck = unit >> 2;
        const size_t row0 = (size_t)ck * 128;
        __syncthreads();
        { const int q = tid >> 2, part = tid & 3; float s1 = 0.f, s2 = 0.f;
#pragma unroll
          for (int i = 0; i < 12; ++i) { const f32x2 p = PSUM[(row0 + q) * 48 + part * 12 + i]; s1 += p.x; s2 += p.y; }
          s1 += __shfl_xor(s1, 1); s1 += __shfl_xor(s1, 2); s2 += __shfl_xor(s2, 1); s2 += __shfl_xor(s2, 2);
          const float mean = s1 * (1.0f / 3072.0f); const float var = fmaxf(s2 * (1.0f / 3072.0f) - mean * mean, 0.f);
          if (part == 0) { ST[2 * q] = mean; ST[2 * q + 1] = 1.0f / sqrtf(var + EPS); } }
        { v4u wv4[4];
#pragma unroll
          for (int q = 0; q < 4; ++q) { const int i = tid + 512 * q; wv4[q] = *(const v4u*)(WS + (size_t)g * 16384 + (i >> 4) * 128 + (i & 15) * 8); }
#pragma unroll
          for (int q = 0; q < 4; ++q) { const int i = tid + 512 * q; *(LAS v4u*)(WL + (i >> 4) * WLS + (i & 15) * 8) = wv4[q]; } }
        __syncthreads();
        const float bsp = bs[g * 128 + wave * 16 + fr];
        const int tq = tid >> 3, tf8 = (tid & 7) * 8;
        float tmean[2], trstd[2];
#pragma unroll
        for (int pass = 0; pass < 2; ++pass) { tmean[pass] = ST[2 * (tq + 64 * pass)]; trstd[pass] = ST[2 * (tq + 64 * pass) + 1]; }
        v4u vw[2]; v2u uwn[4];
#pragma unroll
        for (int pass = 0; pass < 2; ++pass) vw[pass] = *(const v4u*)(V + (row0 + tq + 64 * pass) * 3072 + g * 768 + tf8);
#pragma unroll
        for (int nf = 0; nf < 4; ++nf) uwn[nf] = *(const v2u*)(U + (row0 + wave * 16 + fr) * 3072 + g * 768 + 4 * fq + nf * 16);
        const int trb = (8 * fq + (fr >> 2)) * VP + 8 * (fr & 3);
        for (int s = 0; s < 12; ++s) {
            const int f0 = g * 768 + s * 64;
            LAS unsigned char* vs = VS + (s & 1) * 128 * VP;
#pragma unroll
            for (int pass = 0; pass < 2; ++pass) {
                const v4u w = vw[pass];
                const f32x4 g0 = *(const f32x4*)(lng + f0 + tf8), g1 = *(const f32x4*)(lng + f0 + tf8 + 4), b0 = *(const f32x4*)(lnb + f0 + tf8), b1 = *(const f32x4*)(lnb + f0 + tf8 + 4);
                const f32x4 x0 = (bf4((v2u){w.x, w.y}) - tmean[pass]) * trstd[pass] * g0 + b0, x1 = (bf4((v2u){w.z, w.w}) - tmean[pass]) * trstd[pass] * g1 + b1;
                *(LAS v4u*)(vs + (tq + 64 * pass) * VP + tf8 * 2) = pack8(x0, x1); }
            if (s + 1 < 12) {
#pragma unroll
                for (int pass = 0; pass < 2; ++pass) vw[pass] = *(const v4u*)(V + (row0 + tq + 64 * pass) * 3072 + f0 + 64 + tf8); }
            const bf16* urow = U + (row0 + wave * 16 + fr) * 3072 + f0 + 4 * fq; unsigned char* grow = Gdst + (row0 + wave * 16 + fr) * 3072 + f0 + 4 * fq;
            v2u uw[4];
#pragma unroll
            for (int nf = 0; nf < 4; ++nf) uw[nf] = uwn[nf];
            if (s + 1 < 12) {
#pragma unroll
                for (int nf = 0; nf < 4; ++nf) uwn[nf] = *(const v2u*)(urow + 64 + nf * 16); }
            __syncthreads();
            f32x4 acc[4];
#pragma unroll
            for (int nf = 0; nf < 4; ++nf) acc[nf] = (f32x4){0.f, 0.f, 0.f, 0.f};
#pragma unroll
            for (int ks = 0; ks < 4; ++ks) {
                const bf16x8 wfrag = *(const LAS bf16x8*)(WL + (wave * 16 + fr) * WLS + ks * 32 + fq * 8);
#pragma unroll
                for (int nf = 0; nf < 4; ++nf) {
                    const v4i16_tr r0 = __builtin_amdgcn_ds_read_tr16_b64_v4i16((LAS v4i16_tr*)(vs + trb + (32 * ks) * VP + nf * 32));
                    const v4i16_tr r1 = __builtin_amdgcn_ds_read_tr16_b64_v4i16((LAS v4i16_tr*)(vs + trb + (32 * ks + 4) * VP + nf * 32));
                    const bf16x8 vfrag = (bf16x8){r0[0], r0[1], r0[2], r0[3], r1[0], r1[1], r1[2], r1[3]};
                    acc[nf] = __builtin_amdgcn_mfma_f32_16x16x32_bf16(vfrag, wfrag, acc[nf], 0, 0, 0); }
            }
#pragma unroll
            for (int nf = 0; nf < 4; ++nf) {
                *(unsigned*)(grow + nf * 16) = pk4_fp8_sat(bflo(uw[nf].x) * (acc[nf].x + bsp), bfhi(uw[nf].x) * (acc[nf].y + bsp), bflo(uw[nf].y) * (acc[nf].z + bsp), bfhi(uw[nf].y) * (acc[nf].w + bsp)); }
        }
    }
    __syncthreads();
}

__device__ __forceinline__ void phase_attn(Frame& F, char* lds, bf16* Obuf) {
    const attn_body::bf16* Q = (const attn_body::bf16*)WSP(bf16, SC_Q); const attn_body::bf16* KA = (const attn_body::bf16*)WSP(bf16, SC_KA); const attn_body::bf16* VA = (const attn_body::bf16*)WSP(bf16, SC_VA);
    attn_body::bf16* O = (attn_body::bf16*)Obuf;
    for (int un = F.vcu; un < 2048; un += F.G) {
        int b, h, NT; size_t qrow;
        if (un < 2048) { const int bh = un >> 4, qb = un & 15; b = bh >> 4; h = bh & 15; qrow = (size_t)b * SEQ + qb * 256; NT = KVLEN / 64; }
        else { const int q = un - 2048; b = q >> 4; h = q & 15; qrow = (size_t)RL + b * CTX; NT = CTX / 64; }
        const size_t kvoff = (size_t)b * KVLEN * 256 + (h >> 2) * 64;
        attn_body::attn_unit<8>(F.wv, Q + qrow * D + h * 64, KA + kvoff, VA + kvoff, O + qrow * D + h * 64, NT, lds);
    }
}

struct Args { const float* in[N_IN]; float* out; unsigned char* ws; int ph_lo, ph_hi; };
constexpr int N_PHASES = 36;
__global__ void __launch_bounds__(NWAVES * 64, 2) hyb_fwd(Args args) {
    extern __shared__ __attribute__((aligned(16))) unsigned char lds[];
    Frame F;
    F.lds = (LAS unsigned char*)lds;
    F.MISC = (volatile LAS unsigned*)(F.lds + MISC_OFF);
    F.G = gridDim.x; { const int bx = blockIdx.x; F.vcu = (F.G % 8 == 0) ? (bx % 8) * (F.G / 8) + bx / 8 : bx; }
    F.wv = __builtin_amdgcn_readfirstlane((int)threadIdx.x >> 6);
    F.in = args.in; F.ws = args.ws; F.out = args.out; F.ctl = (gu32*)(args.ws + WS_CTL);
    for (int u = threadIdx.x; u < (LDS_BYTES - LDSCTL_OFF) / 4; u += NWAVES * 64) ((LAS unsigned*)(F.lds + LDSCTL_OFF))[u] = 0u;
    __syncthreads();
    XcdBarrier bar; bar.bar = (unsigned*)(F.ctl + CW_BAR); bar.x = 0; bar.st = nullptr; bar.wv = F.wv;
    const int lo = args.ph_lo, hi = args.ph_hi;
    if (hi - lo > 1) bar = xcd_barrier_post((unsigned*)(F.ctl + CW_BAR), F.MISC + 8, F.wv);
#ifndef PH_LO
#define PH_LO 0
#define PH_HI 99
#endif
#define IN(k) ((k) >= PH_LO && (k) <= PH_HI && lo <= (k) && (k) < hi)
#if defined(PROBE_MASK_A) || defined(PROBE_DELAY_MASK)
#define STAMP(k) do { if (xb_thread0(F.wv)) ((volatile LAS unsigned long long*)(F.lds + LDSCTL_OFF))[k] = __builtin_amdgcn_s_memrealtime(); } while (0)
#else
#define STAMP(k) do { } while (0)
#endif
    STAMP(0);
#define SEAM(k) do { if (IN(k) && IN((k) + 1)) xcd_barrier(bar); STAMP((k) + 1); } while (0)
    LAS unsigned char* ring = F.lds;
    const int cblk = (int)blockIdx.x;
    bf16* XS = WSP(bf16, WS_XS); const float* MOD = WSP(float, WS_MOD);
    const char* Hb = (const char*)WSP(bf16, WS_H);

#ifdef PROBE_REP_MASK
#define NREP(k) (1 + (int)(((unsigned long long)(PROBE_REP_MASK) >> (k)) & 1ull))
#else
#define NREP(k) 1
#endif
#define PH(k, ...) if (IN(k)) { for (int r_ = NREP(k) - 1; r_ >= 0; --r_) { const bool dry = r_ > 0; (void)dry; __VA_ARGS__ if (r_ > 0) xcd_barrier(bar); } } SEAM(k);
#define CONV_SIDE(L) ((L) < 3 ? ConvSide{INP(I_WG) + (size_t)((L) + 1) * 16 * 1024 * 1024, INP(I_WU) + (size_t)((L) + 1) * 16 * 1024 * 1024, INP(I_WDN) + (size_t)((L) + 1) * 16 * 1024 * 1024, \
        WSP(unsigned char, WS_WGU + (((L) + 1) & 1) * WSET), WSP(unsigned char, WS_WD + (((L) + 1) & 1) * WSET)} : ConvSide{nullptr, nullptr, nullptr, nullptr, nullptr})
#define MOE_PHASES(L, base) \
    PH(base, phase_n2<L>(F); ) \
    PH((base) + 1, phase_topk<L>(F); ) \
    PH((base) + 2, { SchedMoeUp S{F.G, cblk, (L) >= 2 ? 0 : 128, Hb, (const char*)WSP(unsigned char, WS_WGU + ((L) & 1) * WSET), WSP(int, WS_IDX)}; \
        EpiMoeUp E{WSP(unsigned char, SC_ACT), CONV_SIDE(L)}; \
        pg8::gemm_phase<EpiMoeUp, SchedMoeUp, 1, true, true>(F.wv, ring, 1024, 1024, 1024, S, E); } ) \
    PH((base) + 3, { SchedMoeDown S{F.G, cblk, (L) >= 2 ? 256 : 272, (const char*)WSP(bf16, SC_ACT), (const char*)WSP(unsigned char, WS_WD + ((L) & 1) * WSET)}; \
        EpiMoeDown E{WSP(unsigned char, SC_Y), WSP(float, WS_GATE), CONV_SIDE(L), (L) == 2}; \
        pg8::gemm_phase<EpiMoeDown, SchedMoeDown, 1, false, true>(F.wv, ring, 1024, 1024, 1024, S, E); } )
#define RES_GEMM(k, L, Aoff, Boff, nM, Kdim) \
    PH(k, { SchedMN S{nM, 4, F.G, cblk, 0, (const char*)WSP(bf16, Aoff), (const char*)WSP(bf16, Boff), (size_t)256 * (Kdim) * 2, 0, (size_t)256 * (Kdim) * 2}; \
        EpiRes<false, false> E{XS, nullptr, nullptr, MOD + (L) * 9 * 6144 + 2048, nullptr, dry ? (bf16*)F.out : XS, dry ? RL : 0, 1.0f}; \
        pg8::gemm_phase<EpiRes<false, false>, SchedMN, 1, false>(F.wv, ring, Kdim, (Kdim) * 2, (Kdim) * 2, S, E); } )

    PH(0, phase_prologue(F); )
    PH(1, phase_n1<0>(F); )
    PH(2, phase_pool(F); )
    PH(3, { SchedMN S{136, 4, F.G, cblk, 0, (const char*)WSP(bf16, SC_P), (const char*)WSP(bf16, WS_PW), (size_t)256 * 2048, 512, (size_t)65536 * 2};
        EpiRes<true, true> E{XS, INP(I_X), INP(I_CTX), MOD + 0 * 9 * 6144 + 2048, INP(I_POOLS), XS, 0, 1.0f};
        pg8::gemm_phase<EpiRes<true, true>, SchedMN, 1, false>(F.wv, ring, 256, 2048, 512, S, E); } )
    MOE_PHASES(0, 4)
    PH(8, phase_n1<1>(F, dry); )
    PH(9, { SchedMN S{136, 8, F.G, cblk, 0, Hb, (const char*)WSP(bf16, WS_LIN), (size_t)256 * 2048, 0, (size_t)256 * 2048};
        EpiLruIn E{WSP(bf16, SC_YG), WSP(bf16, SC_ZX)};
        pg8::gemm_phase<EpiLruIn, SchedMN, 1, false>(F.wv, ring, 1024, 2048, 2048, S, E); } )
    PH(10, phase_conv(F); )
    PH(11, { SchedMN S{136, 16, F.G, cblk, 1, (const char*)WSP(bf16, SC_XR), (const char*)WSP(bf16, WS_LG), (size_t)256 * 2048, 256, (size_t)256 * 256};
        EpiGates E{WSP(bf16, SC_XR), WSP(bf16, SC_YG), WSP(bf16, SC_HL0), WSP(bf16, SC_AC0), WSP(bf16, SC_AC1), WSP(f32x2, WS_AGG), INP(I_BA), INP(I_BX), WSP(float, WS_SPT)};
        pg8::gemm_phase<EpiGates, SchedMN, 0, false>(F.wv, ring, 128, 2048, 256, S, E); } )
    PH(12, phase_carry(F); )
    PH(13, phase_lruc(F); )
    RES_GEMM(14, 1, SC_G, WS_LOUT, 136, 1024)
    MOE_PHASES(1, 15)
    PH(19, phase_n1<2>(F, dry); )
    PH(20, { SchedMN S{136, 6, F.G, cblk, 0, Hb, (const char*)WSP(bf16, WS_QKV), (size_t)256 * 2048, 0, (size_t)256 * 2048};
        EpiQKV E{WSP(bf16, SC_Q), WSP(bf16, SC_KA), WSP(bf16, SC_VA), INP(I_QG), INP(I_KG), WSP(f32x2, WS_ROPE)};
        pg8::gemm_phase<EpiQKV, SchedMN, 2, false>(F.wv, ring, 1024, 2048, 2048, S, E); } )
    PH(21, phase_attn(F, (char*)lds, dry ? WSP(bf16, WS_H) : WSP(bf16, SC_Q)); )
    RES_GEMM(22, 2, SC_Q, WS_WO, 128, 1024)
    MOE_PHASES(2, 23)
    PH(27, phase_n1<3>(F, dry); )
    PH(28, { SchedMN S{128, 24, F.G, cblk, 0, Hb, (const char*)WSP(bf16, WS_GIN), (size_t)256 * 1024, 0, (size_t)256 * 1024};
        EpiGmlpIn E{WSP(bf16, SC_U), WSP(bf16, SC_V), WSP(f32x2, SC_PSUM)};
        pg8::gemm_phase<EpiGmlpIn, SchedMN, 1, false, true>(F.wv, ring, 1024, 1024, 1024, S, E); } )
    PH(29, phase_spatial(F, (unsigned char*)F.out); )
    PH(30, { SchedMN S{128, 4, F.G, cblk, 0, (const char*)F.out, (const char*)WSP(bf16, WS_GOUT), (size_t)256 * 3072, 0, (size_t)256 * 3072};
        EpiRes<false, false> E{XS, nullptr, nullptr, MOD + 3 * 9 * 6144 + 2048, nullptr, XS, 0, W8_INV};
        pg8::gemm_phase<EpiRes<false, false>, SchedMN, 1, false, true>(F.wv, ring, 3072, 3072, 3072, S, E); } )
    MOE_PHASES(3, 31)
#ifdef PROBE_MASK_A
    if (IN(35)) { __syncthreads(); float TA = 0.f, TB = 0.f;
        for (int k = 0; k < 35; ++k) { const volatile LAS unsigned long long* st = (const volatile LAS unsigned long long*)(F.lds + LDSCTL_OFF); const float dt = (float)(st[k + 1] - st[k]) * 0.01f;
            if ((PROBE_MASK_A >> k) & 1ull) TA += dt; if ((PROBE_MASK_B >> k) & 1ull) TB += dt; }
        const float va = sqrtf(TA);
        for (size_t i = (size_t)blockIdx.x * 512 + threadIdx.x; i < (size_t)RL * D; i += (size_t)F.G * 512) F.out[i] = (i == 0) ? TB : va; }
#else
    if (IN(35)) { phase_n1<4>(F); }
#endif
#ifdef PROBE_DELAY_MASK
    STAMP(36);
    if (blockIdx.x == 0 && xb_thread0(F.wv)) {
        const volatile LAS unsigned long long* st = (const volatile LAS unsigned long long*)(F.lds + LDSCTL_OFF);
        unsigned long long T = 0;
        for (int k = 0; k < 36; ++k) if (((unsigned long long)(PROBE_DELAY_MASK) >> k) & 1ull) T += st[k + 1] - st[k];
        T *= (unsigned long long)(PROBE_DELAY_MULT);
        const unsigned long long t0 = __builtin_amdgcn_s_memrealtime();
        while (__builtin_amdgcn_s_memrealtime() - t0 < T) __builtin_amdgcn_s_sleep(32);
    }
#endif
#undef IN
#undef SEAM
#undef MOE_PHASES
#undef CONV_SIDE
#undef RES_GEMM
#undef PH
}

extern "C" void kernel_launch(void* const* d_in, const int* in_sizes, int n_in, void* d_out, int out_size, void* d_ws, size_t ws_size, hipStream_t stream) {
    static int grid = 0;
    if (grid == 0) {
        if (n_in != N_IN || out_size != RL * D || ws_size < WS_END) { fprintf(stderr, "kernel_launch: unexpected shapes (n_in %d out %d ws %zu need %zu)\n", n_in, out_size, ws_size, (size_t)WS_END); grid = -1; return; }
        int dev = 0, cus = 0, per_cu = 0;
        if (hipGetDevice(&dev) != hipSuccess || hipDeviceGetAttribute(&cus, hipDeviceAttributeMultiprocessorCount, dev) != hipSuccess) { grid = -1; return; }
        if (hipFuncSetAttribute((const void*)hyb_fwd, hipFuncAttributeMaxDynamicSharedMemorySize, LDS_BYTES) != hipSuccess) { fprintf(stderr, "kernel_launch: hipFuncSetAttribute failed\n"); grid = -1; return; }
        if (hipOccupancyMaxActiveBlocksPerMultiprocessor(&per_cu, (const void*)hyb_fwd, NWAVES * 64, LDS_BYTES) != hipSuccess || per_cu < 1) { fprintf(stderr, "kernel_launch: occupancy query reports %d\n", per_cu); }
        (void)hipGetLastError();
        grid = cus;
    }
    if (grid < 0) return;
    (void)hipMemsetAsync((char*)d_ws + WS_CTL, 0, CTL_ZERO_BYTES, stream);
    Args a{};
    for (int i = 0; i < N_IN; ++i) a.in[i] = (const float*)d_in[i];
    a.out = (float*)d_out; a.ws = (unsigned char*)d_ws;
#if MK_PER_PHASE
    for (int p = 0; p < N_PHASES; ++p) { a.ph_lo = p; a.ph_hi = p + 1; hipLaunchKernelGGL(hyb_fwd, dim3(grid), dim3(NWAVES * 64), LDS_BYTES, stream, a); }
#else
    a.ph_lo = 0; a.ph_hi = N_PHASES;
    hipLaunchKernelGGL(hyb_fwd, dim3(grid), dim3(NWAVES * 64), LDS_BYTES, stream, a);
#endif
    const hipError_t le = hipPeekAtLastError();
    if (le != hipSuccess) fprintf(stderr, "kernel_launch: launch failed: %s\n", hipGetErrorName(le));
}
```
